# Optimizing an MI355X kernel written in HIP

```python
import math
import jax, jax.numpy as jnp
from jax import lax
import numpy as np

D_MODEL = 1024
BATCH = 32
SEQ = 2048
DEPTH = 2

N_MEM = 256
EPS = 1e-6

POOL_WINDOWS = (2, 4, 8, 16)
POOL_MAX_W = max(POOL_WINDOWS)
POOL_GROUPS = len(POOL_WINDOWS)
POOL_WIDTH = D_MODEL // 2
POOL_GROUP_DIM = POOL_WIDTH // POOL_GROUPS
SGU_WIDTH = D_MODEL // 2
SGU_GROUPS = 4
SGU_GROUP_DIM = SGU_WIDTH // SGU_GROUPS
SGU_CHUNK = 128
EVEN_IN = POOL_WIDTH + 2 * SGU_WIDTH

DIL_HEADS = 8
DIL_HEAD_DIM = 64
DIL_WIDTH = DIL_HEADS * DIL_HEAD_DIM
DIL_PAIRS = ((128, 1), (512, 4), (2048, 16))
DIL_BLOCK = 128
ROPE_THETA = 500000.0
ROPE_DIM = DIL_HEAD_DIM // 4
RET_HEADS = 4
RET_HEAD_DIM = 128
RET_WIDTH = RET_HEADS * RET_HEAD_DIM
RET_CHUNK = 128
RET_THETA = 10000.0
ODD_SIZES = (DIL_WIDTH, DIL_WIDTH, DIL_WIDTH, RET_WIDTH, RET_WIDTH, RET_WIDTH, RET_WIDTH)
ODD_IN = sum(ODD_SIZES)

XATTN_HEADS = 4
XATTN_HEAD_DIM = D_MODEL // XATTN_HEADS
D_FF = -(-8 * D_MODEL // (3 * 256)) * 256

N_EVEN = (DEPTH + 1) // 2
N_ODD = DEPTH // 2

kernel_name = "hybrid_pool_sgu_dilated_retention_block"


def rmsnorm(x, g):
    xf = x.astype(jnp.float32)
    y = xf * lax.rsqrt(jnp.mean(xf * xf, axis=-1, keepdims=True) + EPS)
    return (y * g.astype(jnp.float32)).astype(x.dtype)


def rotary(x, pos, rot_dim, theta):
    half = rot_dim // 2
    inv = 1.0 / jnp.power(jnp.float32(theta), jnp.arange(half, dtype=jnp.float32) / half)
    ang = pos.astype(jnp.float32)[:, None] * inv[None, :]
    cos = jnp.cos(ang)[None, :, None, :]
    sin = jnp.sin(ang)[None, :, None, :]
    xr = x[..., :rot_dim].astype(jnp.float32)
    x1, x2 = xr[..., :half], xr[..., half:]
    rot = jnp.concatenate([x1 * cos - x2 * sin, x1 * sin + x2 * cos], axis=-1).astype(x.dtype)
    return jnp.concatenate([rot, x[..., rot_dim:]], axis=-1)


def pool_mixer(a, w, scale):
    B, S, _ = a.shape
    ag = a.reshape(B, S, POOL_GROUPS, POOL_GROUP_DIM).astype(jnp.float32)
    cs = jnp.pad(jnp.cumsum(ag, axis=1), ((0, 0), (POOL_MAX_W, 0), (0, 0), (0, 0)))
    t = jnp.arange(S)
    outs = []
    for g, win in enumerate(POOL_WINDOWS):
        csg = cs[:, :, g]
        wsum = csg[:, POOL_MAX_W:] - csg[:, POOL_MAX_W - win:POOL_MAX_W - win + S]
        cnt = jnp.minimum(t + 1, win).astype(jnp.float32)[None, :, None]
        outs.append(wsum / cnt - ag[:, :, g])
    d = jnp.stack(outs, axis=2).astype(a.dtype)
    y = jnp.einsum('bsgc,gcd->bsgd', d, w)
    return y.reshape(B, S, POOL_WIDTH) * scale


def sgu_mixer(u, v, norm_g, w_s, b_s):
    B, S, _ = u.shape
    n = S // SGU_CHUNK
    vc = rmsnorm(v, norm_g).reshape(B, n, SGU_CHUNK, SGU_GROUPS, SGU_GROUP_DIM)
    causal = jnp.tril(jnp.ones((SGU_CHUNK, SGU_CHUNK), dtype=bool))
    ws = jnp.where(causal[None], w_s, jnp.zeros_like(w_s))
    mixed = jnp.einsum('gts,bnsgc->bntgc', ws, vc) + jnp.transpose(b_s)[None, None, :, :, None]
    return u * mixed.reshape(B, S, SGU_WIDTH)


def even_mixer(h, w_in, pool_w, pool_scale, sgu_norm, sgu_w, sgu_b, w_out):
    z = h @ w_in
    a = z[..., :POOL_WIDTH]
    uv = jax.nn.gelu(z[..., POOL_WIDTH:])
    u, v = uv[..., :SGU_WIDTH], uv[..., SGU_WIDTH:]
    ya = pool_mixer(a, pool_w, pool_scale)
    yb = sgu_mixer(u, v, sgu_norm, sgu_w, sgu_b)
    return jnp.concatenate([ya, yb], axis=-1) @ w_out


def dilated_branch(q, k, v, dil, steps):
    B, S, H, dh = q.shape
    L = -(-S // dil)
    L = -(-L // DIL_BLOCK) * DIL_BLOCK
    nb = L // DIL_BLOCK
    S_pad = L * dil
    pad = ((0, 0), (0, S_pad - S), (0, 0), (0, 0))

    def sub(t):
        t = jnp.pad(t, pad).reshape(B, L, dil, H, dh)
        return jnp.moveaxis(t, 2, 1).reshape(B, dil, nb, DIL_BLOCK, H, dh)

    def with_prev(t):
        prev = jnp.pad(t, ((0, 0), (0, 0), (1, 0), (0, 0), (0, 0), (0, 0)))[:, :, :-1]
        return jnp.concatenate([prev, t], axis=3)

    qs = sub(q)
    kk = with_prev(sub(k))
    vv = with_prev(sub(v))
    scores = jnp.einsum('brnqhd,brnkhd->brnhqk', qs, kk).astype(jnp.float32) * (dh ** -0.5)
    qi = jnp.arange(DIL_BLOCK)[:, None] + DIL_BLOCK
    ki = jnp.arange(2 * DIL_BLOCK)[None, :]
    dist = qi - ki
    band = (dist >= 0) & (dist <= steps)
    has_prev = (jnp.arange(nb) > 0)[:, None, None]
    mask = band[None] & (has_prev | (ki >= DIL_BLOCK)[None])
    scores = jnp.where(mask[None, None, :, None], scores, -jnp.inf)
    m = jnp.max(scores, axis=-1, keepdims=True)
    p = jnp.exp(scores - m)
    s = jnp.sum(p, axis=-1)
    o = jnp.einsum('brnhqk,brnkhd->brnqhd', p, vv.astype(jnp.float32))
    o = o / jnp.swapaxes(s, 3, 4)[..., None]
    lse = jnp.swapaxes(m[..., 0] + jnp.log(s), 3, 4)

    def unsub(t):
        t = t.reshape((B, dil, L) + t.shape[4:])
        t = jnp.moveaxis(t, 1, 2)
        return t.reshape((B, S_pad) + t.shape[3:])[:, :S]

    return unsub(o), unsub(lse)


def dilated_mixture(q, k, v, pos):
    q = rotary(q, pos, ROPE_DIM, ROPE_THETA)
    k = rotary(k, pos, ROPE_DIM, ROPE_THETA)
    outs, lses = [], []
    for window, dil in DIL_PAIRS:
        o, lse = dilated_branch(q, k, v, dil, window // dil)
        outs.append(o)
        lses.append(lse)
    wts = jax.nn.softmax(jnp.stack(lses, axis=0), axis=0)
    return jnp.einsum('gbsh,gbshd->bshd', wts, jnp.stack(outs, axis=0))


def retention(q, k, v, pos):
    B, S, H, dk = q.shape
    dv = v.shape[-1]
    C = RET_CHUNK
    n = S // C
    q = rotary(q, pos, dk, RET_THETA).astype(jnp.float32)
    k = rotary(k, pos, dk, RET_THETA).astype(jnp.float32) * (dk ** -0.5)
    v = v.astype(jnp.float32)
    gamma = 1.0 - jnp.power(2.0, -5.0 - jnp.arange(H, dtype=jnp.float32))
    log_g = jnp.log(gamma)
    qc = q.reshape(B, n, C, H, dk)
    kc = k.reshape(B, n, C, H, dk)
    vc = v.reshape(B, n, C, H, dv)
    idx = jnp.arange(C, dtype=jnp.float32)
    rel = idx[:, None] - idx[None, :]
    decay = jnp.where(rel[None] >= 0, jnp.exp(jnp.maximum(rel, 0.0)[None] * log_g[:, None, None]), 0.0)
    inner = jnp.einsum('bnihd,bnjhd->bnhij', qc, kc) * decay[None, None]
    y_inner = jnp.einsum('bnhij,bnjhe->bnihe', inner, vc)
    k_decay = jnp.exp((C - 1 - idx)[None, :] * log_g[:, None])
    q_decay = jnp.exp((idx + 1)[None, :] * log_g[:, None])
    chunk_kv = jnp.einsum('bnjhd,hj,bnjhe->bnhde', kc, k_decay, vc)
    g_chunk = jnp.exp(C * log_g)[None, :, None, None]

    def step(state, kv):
        return state * g_chunk + kv, state

    init = jnp.zeros((B, H, dk, dv), jnp.float32)
    _, prev = lax.scan(step, init, jnp.moveaxis(chunk_kv, 1, 0))
    prev = jnp.moveaxis(prev, 0, 1)
    y_cross = jnp.einsum('bnihd,bnhde,hi->bnihe', qc, prev, q_decay)
    y = (y_inner + y_cross).reshape(B, S, H, dv)
    mu = jnp.mean(y, axis=-1, keepdims=True)
    var = jnp.mean(jnp.square(y - mu), axis=-1, keepdims=True)
    return (y - mu) * lax.rsqrt(var + EPS)


def odd_mixer(h, pos, w_in, w_out):
    B, S, _ = h.shape
    z = h @ w_in
    cuts = [int(c) for c in np.cumsum(ODD_SIZES)[:-1]]
    cq, ck, cv, rq, rk, rv, rg = jnp.split(z, cuts, axis=-1)
    dshape = (B, S, DIL_HEADS, DIL_HEAD_DIM)
    rshape = (B, S, RET_HEADS, RET_HEAD_DIM)
    yc = dilated_mixture(cq.reshape(dshape), ck.reshape(dshape), cv.reshape(dshape), pos)
    yc = yc.reshape(B, S, DIL_WIDTH).astype(h.dtype)
    yr = retention(rq.reshape(rshape), rk.reshape(rshape), rv.reshape(rshape), pos)
    yd = jax.nn.silu(rg) * yr.reshape(B, S, RET_WIDTH).astype(h.dtype)
    return jnp.concatenate([yc, yd], axis=-1) @ w_out


def memory_cross_attention(h, mem_n, wq, wkv, wo):
    B, S, _ = h.shape
    M = mem_n.shape[1]
    q = (h @ wq).reshape(B, S, XATTN_HEADS, XATTN_HEAD_DIM)
    kv = (mem_n @ wkv).reshape(B, M, 2, XATTN_HEADS, XATTN_HEAD_DIM)
    k, v = kv[:, :, 0], kv[:, :, 1]
    s = jnp.einsum('bqhd,bkhd->bhqk', q, k).astype(jnp.float32) * (XATTN_HEAD_DIM ** -0.5)
    p = jax.nn.softmax(s, axis=-1).astype(v.dtype)
    o = jnp.einsum('bhqk,bkhd->bqhd', p, v).reshape(B, S, D_MODEL)
    return o @ wo


def swiglu(h, w_gate_up, w_down):
    gu = h @ w_gate_up
    g, u = gu[..., :D_FF], gu[..., D_FF:]
    return (jax.nn.silu(g) * u) @ w_down


def setup_inputs(seed: int = 0) -> dict:
    key = jax.random.key(seed)
    ks = iter(jax.random.split(key, 32))
    f32 = jnp.float32

    def normal(shape, fan_in):
        return jax.random.normal(next(ks), shape, f32) * (fan_in ** -0.5)

    def gain(shape):
        return 1.0 + 0.02 * jax.random.normal(next(ks), shape, f32)

    return {
        "x": jax.random.normal(next(ks), (BATCH, SEQ, D_MODEL), f32),
        "mem": jax.random.normal(next(ks), (BATCH, N_MEM, D_MODEL), f32),
        "even_mix_norm": gain((N_EVEN, D_MODEL)),
        "even_w_in": normal((N_EVEN, D_MODEL, EVEN_IN), D_MODEL),
        "pool_w": normal((N_EVEN, POOL_GROUPS, POOL_GROUP_DIM, POOL_GROUP_DIM), POOL_GROUP_DIM),
        "pool_scale": gain((N_EVEN, POOL_WIDTH)),
        "sgu_norm": gain((N_EVEN, SGU_WIDTH)),
        "sgu_w": normal((N_EVEN, SGU_GROUPS, SGU_CHUNK, SGU_CHUNK), SGU_CHUNK),
        "sgu_b": gain((N_EVEN, SGU_GROUPS, SGU_CHUNK)),
        "even_w_out": normal((N_EVEN, POOL_WIDTH + SGU_WIDTH, D_MODEL), POOL_WIDTH + SGU_WIDTH),
        "odd_mix_norm": gain((N_ODD, D_MODEL)),
        "odd_w_in": normal((N_ODD, D_MODEL, ODD_IN), D_MODEL),
        "odd_w_out": normal((N_ODD, DIL_WIDTH + RET_WIDTH, D_MODEL), DIL_WIDTH + RET_WIDTH),
        "xattn_norm": gain((DEPTH, D_MODEL)),
        "mem_norm": gain((DEPTH, D_MODEL)),
        "xattn_wq": normal((DEPTH, D_MODEL, D_MODEL), D_MODEL),
        "xattn_wkv": normal((DEPTH, D_MODEL, 2 * D_MODEL), D_MODEL),
        "xattn_wo": normal((DEPTH, D_MODEL, D_MODEL), D_MODEL),
        "ffn_norm": gain((DEPTH, D_MODEL)),
        "ffn_w_gate_up": normal((DEPTH, D_MODEL, 2 * D_FF), D_MODEL),
        "ffn_w_down": normal((DEPTH, D_FF, D_MODEL), D_FF),
        "final_norm": gain((D_MODEL,)),
    }


def reference(x, mem, even_mix_norm, even_w_in, pool_w, pool_scale, sgu_norm, sgu_w, sgu_b,
              even_w_out, odd_mix_norm, odd_w_in, odd_w_out, xattn_norm, mem_norm, xattn_wq,
              xattn_wkv, xattn_wo, ffn_norm, ffn_w_gate_up, ffn_w_down, final_norm):
    pos = jnp.arange(x.shape[1], dtype=jnp.int32)
    h = x
    for layer in range(DEPTH):
        i = layer // 2
        if layer % 2 == 0:
            h = h + even_mixer(rmsnorm(h, even_mix_norm[i]), even_w_in[i], pool_w[i], pool_scale[i],
                               sgu_norm[i], sgu_w[i], sgu_b[i], even_w_out[i])
        else:
            h = h + odd_mixer(rmsnorm(h, odd_mix_norm[i]), pos, odd_w_in[i], odd_w_out[i])
        h = h + memory_cross_attention(rmsnorm(h, xattn_norm[layer]), rmsnorm(mem, mem_norm[layer]),
                                       xattn_wq[layer], xattn_wkv[layer], xattn_wo[layer])
        h = h + swiglu(rmsnorm(h, ffn_norm[layer]), ffn_w_gate_up[layer], ffn_w_down[layer])
    return rmsnorm(h, final_norm)
```

```cpp
#include <hip/hip_runtime.h>
#include <hip/hip_cooperative_groups.h>
#include <cstdio>
#include <cmath>
namespace cg = cooperative_groups;
#include <cstring>
namespace pg8 {
#define PG8_LAS __attribute__((address_space(3)))
typedef unsigned short bf16_t;
typedef short bf16x8 __attribute__((ext_vector_type(8)));
typedef float f32x4 __attribute__((ext_vector_type(4)));
typedef unsigned u32x4 __attribute__((ext_vector_type(4)));
constexpr int BM = 256, BK = 64, HALF = 128, HTB = HALF * BK * 2  , STAGE_BYTES = 8 * HTB, NXCD = 8, WGM = 8;

__host__ __device__ __forceinline__ int lds_byte(int r, int c) { const int st = (r >> 4) * 2 + (c >> 5), rr = r & 15, cc = c & 31, ob = rr * 64 + cc * 2; return st * 1024 + (ob ^ (((ob >> 9) & 1) << 5)); }
__host__ __device__ __forceinline__ void stage_rc(int b, int& R, int& C) { const int st = b / 1024, sb = b % 1024, swz = sb ^ (((sb >> 9) & 1) << 5); R = (st >> 1) * 16 + swz / 64; C = (st & 1) * 32 + (swz % 64) / 2; }
__host__ __device__ __forceinline__ int perm32(int rho) { const int n = rho >> 4, i = rho & 15; return 8 * (i >> 2) + 4 * n + (i & 3); }

struct Unit { int pm, pn; };
struct Gemm { const bf16_t* A; const bf16_t* Bt; int M, N, K; };

struct StaticOrder {
    int nM, nN, nwg, G, c;
    __host__ __device__ void init(int M, int N, int G_, int c_) { nM = M / BM; nN = N / BM; nwg = nM * nN; G = G_; c = c_; }
    __host__ __device__ bool next(int i, Unit& u) const {
        const long L = (long)i * G + c; if (L >= nwg) return false;
        int wgid = (int)L; { const int q = nwg / NXCD, r = nwg % NXCD, xcd = wgid % NXCD, off = wgid / NXCD; wgid = (xcd < r ? xcd * (q + 1) : r * (q + 1) + (xcd - r) * q) + off; }
        const int nig = WGM * nN, gid = wgid / nig, fm = gid * WGM, gsz = (nM - fm) < WGM ? (nM - fm) : WGM;
        u.pm = fm + ((wgid % nig) % gsz); u.pn = (wgid % nig) / gsz; return true;
    }
    __device__ __forceinline__ void a_ready(const Unit&) const {}
    __device__ __forceinline__ void done(const Unit&) const {}
};
__device__ __forceinline__ unsigned cvt_pk_bf16(float lo, float hi) { unsigned r; asm volatile("v_cvt_pk_bf16_f32 %0, %1, %2" : "=v"(r) : "v"(lo), "v"(hi)); return r; }
typedef float f32x2 __attribute__((ext_vector_type(2)));
template <class Epi, class Sched, bool ALIGN_EPI = false, bool SP2 = false>
__device__ __forceinline__ void gemm_phase(PG8_LAS unsigned char* lds, const Gemm g, const Sched& S, const Epi& E) {
    int tid_o = threadIdx.x; asm volatile("" : "+v"(tid_o));
    const int tid = tid_o, wid = __builtin_amdgcn_readfirstlane(tid >> 6), lane = tid & 63, wr = wid >> 2, wc = wid & 3, fr = lane & 15, fq = lane >> 4;
    const int K = g.K, nt = K / BK;
    unsigned voffA[2], voffB[2];
#pragma unroll
    for (int i = 0; i < 2; ++i) { int R, C; stage_rc(tid * 16 + i * 8192, R, C); const int Rb = Epi::PERM ? ((R & ~31) + perm32(R & 31)) : R;
        voffA[i] = (unsigned)(R * K + C) * 2u; voffB[i] = (unsigned)(Rb * K + C) * 2u; }
    const size_t kstep = (size_t)(BK * 2);
    const size_t hstep = (size_t)HALF * K * 2;
    const size_t tstep = 2 * hstep;
    const unsigned ldsw = (unsigned)wid * 1024u;
    const int aoff = lds_byte(wr * 64 + fr, fq * 8), boff = lds_byte(wc * 32 + fr, fq * 8);
#define PG8_SA(b, h) (((b) * 2 + (h)) * HTB)
#define PG8_SB(b, h) ((4 + (b) * 2 + (h)) * HTB)
#define PG8_STAGE(bufoff, gbase, voff) do { const char* _gb = (const char*)(gbase); asm volatile("" : "+s"(_gb)); _Pragma("unroll") for (int _i = 0; _i < 2; ++_i) \
        __builtin_amdgcn_global_load_lds((const unsigned*)(_gb + (voff)[_i]), (PG8_LAS unsigned*)(lds + (bufoff) + ldsw + _i * 8192), 16, 0, 0); } while (0)
#define PG8_LDA(dst, b, h) do { _Pragma("unroll") for (int m = 0; m < 4; ++m) _Pragma("unroll") for (int k = 0; k < 2; ++k) dst[m][k] = *(const PG8_LAS bf16x8*)(lds + PG8_SA(b, h) + aoff + m * 2048 + k * 1024); } while (0)
#define PG8_LDB(dst, b, h) do { _Pragma("unroll") for (int n = 0; n < 2; ++n) _Pragma("unroll") for (int k = 0; k < 2; ++k) dst[n][k] = *(const PG8_LAS bf16x8*)(lds + PG8_SB(b, h) + boff + n * 2048 + k * 1024); } while (0)
#define PG8_MMA(ai, bj, At, Bt) do { __builtin_amdgcn_s_setprio(1); _Pragma("unroll") for (int m = 0; m < 4; ++m) _Pragma("unroll") for (int n = 0; n < 2; ++n) _Pragma("unroll") for (int k = 0; k < 2; ++k) \
        acc[ai][bj][m][n] = __builtin_amdgcn_mfma_f32_16x16x32_bf16(Bt[n][k], At[m][k], acc[ai][bj][m][n], 0, 0, 0); __builtin_amdgcn_s_setprio(0); } while (0)
#define PG8_WAIT_V(n) asm volatile("s_waitcnt vmcnt(" #n ")" ::: "memory")
#define PG8_WAIT_L(n) asm volatile("s_waitcnt lgkmcnt(" #n ")" ::: "memory")
#define PG8_BAR __builtin_amdgcn_s_barrier()
#define PG8_SCHED __builtin_amdgcn_sched_barrier(0)
    Unit cur, nxt; int ui = 0;
    if (!S.next(0, cur)) return;
    f32x4 acc[2][2][4][2];
#pragma unroll
    for (int a = 0; a < 2; ++a)
#pragma unroll
        for (int b = 0; b < 2; ++b)
#pragma unroll
            for (int m = 0; m < 4; ++m)
#pragma unroll
                for (int n = 0; n < 2; ++n) acc[a][b][m][n] = (f32x4){0.f, 0.f, 0.f, 0.f};
    bf16x8 At[4][2], B0[2][2], B1[2][2];
    const char* cA = (const char*)g.A + (size_t)cur.pm * tstep; const char* cB = (const char*)g.Bt + (size_t)cur.pn * tstep;
    S.a_ready(cur);
    if constexpr (SP2) {
        PG8_STAGE(PG8_SB(0, 0), cB, voffB); PG8_STAGE(PG8_SB(0, 1), cB + hstep, voffB); PG8_STAGE(PG8_SA(0, 0), cA, voffA); PG8_STAGE(PG8_SA(0, 1), cA + hstep, voffA);
        if (wr == 1) PG8_BAR;
        PG8_WAIT_V(2); PG8_BAR;
        PG8_STAGE(PG8_SB(1, 0), cB + kstep, voffB); PG8_STAGE(PG8_SA(1, 0), cA + kstep, voffA); PG8_STAGE(PG8_SB(1, 1), cB + hstep + kstep, voffB);
        PG8_WAIT_V(6); PG8_BAR;
    } else {
        PG8_STAGE(PG8_SB(0, 0), cB, voffB); PG8_STAGE(PG8_SA(0, 0), cA, voffA); PG8_STAGE(PG8_SB(0, 1), cB + hstep, voffB); PG8_STAGE(PG8_SA(0, 1), cA + hstep, voffA);
        if (wr == 1) PG8_BAR;
        PG8_WAIT_V(4); PG8_BAR;
        PG8_STAGE(PG8_SB(1, 0), cB + kstep, voffB); PG8_STAGE(PG8_SA(1, 0), cA + kstep, voffA); PG8_STAGE(PG8_SB(1, 1), cB + hstep + kstep, voffB);
        PG8_WAIT_V(6); PG8_BAR;
    }
    for (;;) {
        const bool has_next = S.next(ui + 1, nxt);
        const char* nA = has_next ? (const char*)g.A + (size_t)nxt.pm * tstep : cA; const char* nB = has_next ? (const char*)g.Bt + (size_t)nxt.pn * tstep : cB;
        for (int t = 0; t < nt; t += 2) {
            const bool last = (t == nt - 2);
            const char* a1 = cA + (size_t)(t + 1) * kstep;
            const char* a2 = last ? nA : cA + (size_t)(t + 2) * kstep; const char* b2 = last ? nB : cB + (size_t)(t + 2) * kstep;
            const char* a3 = a2 + kstep; const char* b3 = b2 + kstep;
            if (last && has_next) S.a_ready(nxt);
            if constexpr (SP2) {
            PG8_LDB(B0, 0, 0); PG8_LDB(B1, 0, 1); PG8_SCHED; PG8_LDA(At, 0, 0); PG8_STAGE(PG8_SA(1, 1), a1 + hstep, voffA);
            PG8_WAIT_V(8); PG8_WAIT_L(0); PG8_BAR; PG8_MMA(0, 0, At, B0); PG8_MMA(0, 1, At, B1); PG8_BAR; PG8_SCHED;
            PG8_LDA(At, 0, 1); PG8_STAGE(PG8_SB(0, 0), b2, voffB); PG8_STAGE(PG8_SB(0, 1), b2 + hstep, voffB); PG8_STAGE(PG8_SA(0, 0), a2, voffA);
            PG8_WAIT_V(8); PG8_WAIT_L(0); PG8_BAR; PG8_MMA(1, 0, At, B0); PG8_MMA(1, 1, At, B1); PG8_BAR; PG8_SCHED;
            PG8_LDB(B0, 1, 0); PG8_LDB(B1, 1, 1); PG8_SCHED; PG8_LDA(At, 1, 0); PG8_STAGE(PG8_SA(0, 1), a2 + hstep, voffA);
            PG8_WAIT_V(8); PG8_WAIT_L(0); PG8_BAR; PG8_MMA(0, 0, At, B0); PG8_MMA(0, 1, At, B1); PG8_BAR; PG8_SCHED;
            PG8_LDA(At, 1, 1); PG8_STAGE(PG8_SB(1, 0), b3, voffB); PG8_STAGE(PG8_SB(1, 1), b3 + hstep, voffB); PG8_STAGE(PG8_SA(1, 0), a3, voffA);
            PG8_WAIT_V(8); PG8_WAIT_L(0); PG8_BAR; PG8_MMA(1, 0, At, B0); PG8_MMA(1, 1, At, B1); PG8_BAR; PG8_SCHED;
            } else {
            PG8_LDB(B0, 0, 0); PG8_SCHED; PG8_LDA(At, 0, 0); PG8_STAGE(PG8_SA(1, 1), a1 + hstep, voffA);
            PG8_WAIT_L(8); PG8_BAR; PG8_WAIT_L(0); PG8_MMA(0, 0, At, B0); PG8_BAR; PG8_SCHED;
            PG8_LDB(B1, 0, 1); PG8_STAGE(PG8_SB(0, 0), b2, voffB);
            PG8_BAR; PG8_WAIT_L(0); PG8_MMA(0, 1, At, B1); PG8_BAR;
            PG8_LDA(At, 0, 1); PG8_STAGE(PG8_SA(0, 0), a2, voffA);
            PG8_BAR; PG8_WAIT_L(0); PG8_MMA(1, 0, At, B0); PG8_BAR; PG8_SCHED;
            PG8_STAGE(PG8_SB(0, 1), b2 + hstep, voffB);
            PG8_WAIT_V(6); PG8_BAR; PG8_MMA(1, 1, At, B1); PG8_BAR;
            PG8_LDB(B0, 1, 0); PG8_SCHED; PG8_LDA(At, 1, 0); PG8_STAGE(PG8_SA(0, 1), a2 + hstep, voffA);
            PG8_WAIT_L(8); PG8_BAR; PG8_WAIT_L(0); PG8_MMA(0, 0, At, B0); PG8_BAR; PG8_SCHED;
            PG8_LDB(B1, 1, 1); PG8_STAGE(PG8_SB(1, 0), b3, voffB);
            PG8_BAR; PG8_WAIT_L(0); PG8_MMA(0, 1, At, B1); PG8_BAR;
            PG8_LDA(At, 1, 1); PG8_STAGE(PG8_SA(1, 0), a3, voffA);
            PG8_BAR; PG8_WAIT_L(0); PG8_MMA(1, 0, At, B0); PG8_BAR; PG8_SCHED;
            PG8_STAGE(PG8_SB(1, 1), b3 + hstep, voffB);
            PG8_WAIT_V(6); PG8_BAR; PG8_MMA(1, 1, At, B1); PG8_BAR;
            }
        }
        if constexpr (ALIGN_EPI) { if (wr == 0) PG8_BAR; }
        if constexpr (!Epi::AFTER_DRAIN) { E(acc, cur, wr, wc, fr, fq); S.done(cur); }
        if (!has_next) break;
#pragma unroll
        for (int a = 0; a < 2; ++a)
#pragma unroll
            for (int b = 0; b < 2; ++b)
#pragma unroll
                for (int m = 0; m < 4; ++m)
#pragma unroll
                    for (int n = 0; n < 2; ++n) acc[a][b][m][n] = (f32x4){0.f, 0.f, 0.f, 0.f};
        cur = nxt; cA = nA; cB = nB; ++ui;
        if constexpr (ALIGN_EPI) { if (wr == 1) PG8_BAR; }
    }
    PG8_WAIT_V(0);
    if constexpr (!ALIGN_EPI) { if (wr == 0) PG8_BAR; }
    PG8_BAR;
    if constexpr (Epi::AFTER_DRAIN) { E.fused(acc, cur, wr, wc, fr, fq, lds, wid, lane); S.done(cur); }
#undef PG8_SA
#undef PG8_SB
#undef PG8_STAGE
#undef PG8_LDA
#undef PG8_LDB
#undef PG8_MMA
#undef PG8_WAIT_V
#undef PG8_WAIT_L
#undef PG8_BAR
#undef PG8_SCHED
}
}

using pg8::bf16_t; using pg8::f32x4; using pg8::Unit; using pg8::cvt_pk_bf16;
#define LAS __attribute__((address_space(3)))
constexpr int T = 65536, DM = 1024, SEQ = 2048, MROWS = 8192;
constexpr int EVEN_IN = 1536, ODD_IN = 3584, DFF = 2816, GU = 5632;
constexpr size_t MiB = 1024ull * 1024ull;
constexpr size_t WS_HB = 0, WS_Z = 128 * MiB, WS_Y = 576 * MiB, WS_W = 704 * MiB, WS_MEMN = 768 * MiB, WS_KV = 800 * MiB, WS_SS = 864 * MiB, WS_TAB = 896 * MiB, WS_SIDE = 898 * MiB, WS_RET = 906 * MiB, WS_BAR = 970 * MiB, WS_END = 971 * MiB;
constexpr size_t W_EIN = 0, W_EOUT = W_EIN + 1536ull * 1024, W_OIN = W_EOUT + 1024ull * 1024, W_OOUT = W_OIN + 3584ull * 1024, W_L0 = W_OOUT + 1024ull * 1024;
constexpr size_t WL_Q = 0, WL_KV = 1024ull * 1024, WL_O = WL_KV + 2048ull * 1024, WL_GU = WL_O + 1024ull * 1024, WL_DN = WL_GU + 5632ull * 1024, WL_SIZE = WL_DN + 1024ull * 2816;
static_assert((W_L0 + 2 * WL_SIZE) * 2 <= 64 * MiB, "weights region");
constexpr size_t SS_STRIDE = (size_t)T * 16;
constexpr size_t TAB_DC = 0, TAB_DS = 2048 * 8, TAB_RC = 2 * 2048 * 8, TAB_RS = TAB_RC + 2048 * 64;
constexpr size_t SD_H = 0, SD_Z = SD_H + 1024 * 32, SD_Q = SD_Z + 5632 * 32, SD_R = SD_Q + 1024 * 32, SD_P = SD_R + 32 * 4 * 1024, SD_M = SD_P + 32 * 4 * 256, SD_T = SD_M + 32 * 256, SD_O = SD_T + 4 * 1024 * 32, SD_END = SD_O + 1024 * 32;
static_assert(SD_END * 4 <= 8 * MiB, "side region");

typedef short bf16x8_t __attribute__((ext_vector_type(8)));
typedef unsigned u32x4_t __attribute__((ext_vector_type(4)));
typedef unsigned u32x2_t __attribute__((ext_vector_type(2)));
struct Params {
    const float* in[22];
    float* out;
    unsigned char* ws;
    double inv_dil[8];
    double inv_ret[64];
};

__device__ __forceinline__ int opaque_tid() { int t = threadIdx.x; asm volatile("" : "+v"(t)); return t; }
__shared__ int g_vblk;
__device__ __forceinline__ int vblk() { return __builtin_amdgcn_readfirstlane(g_vblk); }
__device__ __forceinline__ int xcd_unit(int it, int total) {
    const int G = (int)gridDim.x, bx = vblk();
    if ((G & 7) || (total & 7)) { const int u = it * G + bx; return u < total ? u : -1; }
    const int per = total >> 3, ny = G >> 3, idx = it * ny + (bx >> 3);
    return idx < per ? (bx & 7) * per + idx : -1;
}
#define LDS_BARRIER() do { asm volatile("s_waitcnt lgkmcnt(0)" ::: "memory"); __builtin_amdgcn_s_barrier(); asm volatile("" ::: "memory"); } while (0)
__device__ __forceinline__ float bf2f(unsigned short v) { return __uint_as_float((unsigned)v << 16); }
__device__ __forceinline__ float bflo(unsigned v) { return __uint_as_float(v << 16); }
__device__ __forceinline__ float bfhi(unsigned v) { return __uint_as_float(v & 0xffff0000u); }
__device__ __forceinline__ unsigned short f2bf(float f) { return (unsigned short)(cvt_pk_bf16(f, 0.f) & 0xffffu); }
__device__ __forceinline__ float dot8(const uint4 a, const uint4 b) {
    float s = bflo(a.x) * bflo(b.x); s += bfhi(a.x) * bfhi(b.x);
    s += bflo(a.y) * bflo(b.y); s += bfhi(a.y) * bfhi(b.y);
    s += bflo(a.z) * bflo(b.z); s += bfhi(a.z) * bfhi(b.z);
    s += bflo(a.w) * bflo(b.w); s += bfhi(a.w) * bfhi(b.w);
    return s;
}
__device__ __forceinline__ float wave_sum(float v) {
#pragma unroll
    for (int o = 32; o >= 1; o >>= 1) v += __shfl_xor(v, o);
    return v;
}
__device__ __forceinline__ float wave_max(float v) {
#pragma unroll
    for (int o = 32; o >= 1; o >>= 1) v = fmaxf(v, __shfl_xor(v, o));
    return v;
}
__device__ __forceinline__ float silu_f(float x) { return x * __builtin_amdgcn_rcpf(1.0f + __builtin_amdgcn_exp2f(-1.4426950408889634f * x)); }
__device__ __forceinline__ float gelu_tanh_f(float x) {
    const float y = 1.5957691216057308f * (x + 0.044715f * x * x * x);
    return x * __builtin_amdgcn_rcpf(1.0f + __builtin_amdgcn_exp2f(-1.4426950408889634f * y));
}
__device__ __forceinline__ float row_rstd(const float* ss, int nslot, int row, float inv_dim) {
    float s = 0.f;
    for (int i = 0; i < nslot; i += 4) { const float4 v = *(const float4*)(ss + (size_t)row * 16 + i); s += (v.x + v.y) + (v.z + v.w); }
    return rsqrtf(s * inv_dim + 1e-6f);
}
__device__ __forceinline__ float coop_rstd(const float* ss, int nslot, int row, int fq, float inv_dim) {
    float s = 0.f;
    if (4 * fq < nslot) { const float4 v = *(const float4*)(ss + (size_t)row * 16 + 4 * fq); s = (v.x + v.y) + (v.z + v.w); }
    s += __shfl_xor(s, 16); s += __shfl_xor(s, 32);
    return rsqrtf(s * inv_dim + 1e-6f);
}

enum { EP_EVEN_IN = 0, EP_RES = 1, EP_SCALE = 2, EP_GU = 3, EP_ODD_IN = 4, EP_PLAIN = 5 };
template <int MODE> struct Epi {
    static constexpr bool PERM = true, AFTER_DRAIN = false;
    bf16_t* O; int ldo;
    const float* ss_in; int ns_in;
    const bf16_t* res; float* hout;
    float* ss_out;
    __device__ __forceinline__ void operator()(const f32x4 (&acc)[2][2][4][2], const Unit& u, int wr, int wc, int fr_in, int fq_in) const {
        int fr = fr_in, fq = fq_in;
        asm volatile("" : "+v"(fr), "+v"(fq));
        const int row00 = u.pm * 256 + wr * 64 + fr;
        float rsv[2][4];
        if (MODE == EP_EVEN_IN || MODE == EP_SCALE || MODE == EP_GU || MODE == EP_ODD_IN) {
            float part[2][4];
#pragma unroll
            for (int ai = 0; ai < 2; ++ai)
#pragma unroll
                for (int m = 0; m < 4; ++m) {
                    float sp = 0.f;
                    if (4 * fq < ns_in) { const float4 v = *(const float4*)(ss_in + (size_t)(row00 + ai * 128 + m * 16) * 16 + 4 * fq); sp = (v.x + v.y) + (v.z + v.w); }
                    part[ai][m] = sp;
                }
#pragma unroll
            for (int ai = 0; ai < 2; ++ai)
#pragma unroll
                for (int m = 0; m < 4; ++m) { float sp = part[ai][m]; sp += __shfl_xor(sp, 16); sp += __shfl_xor(sp, 32); rsv[ai][m] = rsqrtf(sp * (1.0f / 1024.0f) + 1e-6f); }
        } else {
#pragma unroll
            for (int ai = 0; ai < 2; ++ai)
#pragma unroll
                for (int m = 0; m < 4; ++m) rsv[ai][m] = 1.0f;
        }
#pragma unroll
        for (int ai = 0; ai < 2; ++ai) {
            u32x4_t rres[4][2];
            if (MODE == EP_RES) {
#pragma unroll
                for (int m = 0; m < 4; ++m)
#pragma unroll
                    for (int bj = 0; bj < 2; ++bj) rres[m][bj] = *(const u32x4_t*)(res + (size_t)(row00 + ai * 128 + m * 16) * 1024 + u.pn * 256 + bj * 128 + wc * 32 + fq * 8);
            }
#pragma unroll
            for (int m = 0; m < 4; ++m) {
                const int row = row00 + ai * 128 + m * 16;
                const float rs = rsv[ai][m];
                if (MODE == EP_GU) {
                    const f32x4 g0 = acc[ai][0][m][0] * rs, g1 = acc[ai][0][m][1] * rs, u0 = acc[ai][1][m][0] * rs, u1 = acc[ai][1][m][1] * rs;
                    uint4 w;
                    w.x = cvt_pk_bf16(silu_f(g0[0]) * u0[0], silu_f(g0[1]) * u0[1]); w.y = cvt_pk_bf16(silu_f(g0[2]) * u0[2], silu_f(g0[3]) * u0[3]);
                    w.z = cvt_pk_bf16(silu_f(g1[0]) * u1[0], silu_f(g1[1]) * u1[1]); w.w = cvt_pk_bf16(silu_f(g1[2]) * u1[2], silu_f(g1[3]) * u1[3]);
                    *(uint4*)(O + (size_t)row * ldo + u.pn * 128 + wc * 32 + fq * 8) = w;
                } else {
                    float sq = 0.f;
#pragma unroll
                    for (int bj = 0; bj < 2; ++bj) {
                        const int col0 = u.pn * 256 + bj * 128 + wc * 32 + fq * 8;
                        f32x4 v0 = acc[ai][bj][m][0] * rs, v1 = acc[ai][bj][m][1] * rs;
                        if (MODE == EP_EVEN_IN) {
                            if (u.pn >= 2) {
#pragma unroll
                                for (int j = 0; j < 4; ++j) { v0[j] = gelu_tanh_f(v0[j]); v1[j] = gelu_tanh_f(v1[j]); }
                            }
                            if (u.pn >= 4) sq += (v0[0] * v0[0] + v0[1] * v0[1]) + (v0[2] * v0[2] + v0[3] * v0[3]) + (v1[0] * v1[0] + v1[1] * v1[1]) + (v1[2] * v1[2] + v1[3] * v1[3]);
                        }
                        if (MODE == EP_ODD_IN) {
                            if (u.pn >= 12) {
#pragma unroll
                                for (int j = 0; j < 4; ++j) { v0[j] = silu_f(v0[j]); v1[j] = silu_f(v1[j]); }
                            }
                        }
                        if (MODE == EP_RES) {
                            { const u32x4_t rr = rres[m][bj];
                              v0[0] += bflo(rr[0]); v0[1] += bfhi(rr[0]); v0[2] += bflo(rr[1]); v0[3] += bfhi(rr[1]); v1[0] += bflo(rr[2]); v1[1] += bfhi(rr[2]); v1[2] += bflo(rr[3]); v1[3] += bfhi(rr[3]); }
                            sq += (v0[0] * v0[0] + v0[1] * v0[1]) + (v0[2] * v0[2] + v0[3] * v0[3]) + (v1[0] * v1[0] + v1[1] * v1[1]) + (v1[2] * v1[2] + v1[3] * v1[3]);
                        }
                        uint4 w;
                        w.x = cvt_pk_bf16(v0[0], v0[1]); w.y = cvt_pk_bf16(v0[2], v0[3]); w.z = cvt_pk_bf16(v1[0], v1[1]); w.w = cvt_pk_bf16(v1[2], v1[3]);
                        *(uint4*)(O + (size_t)row * ldo + col0) = w;
                    }
                    if (MODE == EP_RES) {
                        sq += __shfl_xor(sq, 16); sq += __shfl_xor(sq, 32);
                        if (fq == 0) ss_out[(size_t)row * 16 + u.pn * 4 + wc] = sq;
                    }
                    if (MODE == EP_EVEN_IN) {
                        if (u.pn >= 4) {
                            sq += __shfl_xor(sq, 16); sq += __shfl_xor(sq, 32);
                            if (fq == 0) ss_out[(size_t)row * 16 + (u.pn - 4) * 4 + wc] = sq;
                        }
                    }
                }
            }
            asm volatile("" ::: "memory");
        }
    }
};

#ifndef GEMM_ALIGN
#define GEMM_ALIGN true
#endif
#ifndef GEMM_SP2
#define GEMM_SP2 true
#endif
template <int MODE>
__device__ __forceinline__ void run_gemm(LAS unsigned char* lds, const bf16_t* A, const bf16_t* Bt, int M, int N, int K, const Epi<MODE>& E, int rot = 0) {
#if defined(T_ONLYMODE)
    if (MODE != T_ONLYMODE) return;
#endif
    pg8::Gemm g{A, Bt, M, N, K};
    pg8::StaticOrder S; S.init(M, N, (int)gridDim.x, (int)((vblk() + rot) % (int)gridDim.x));
    pg8::gemm_phase<Epi<MODE>, pg8::StaticOrder, GEMM_ALIGN, GEMM_SP2>(lds, g, S, E);
}

__device__ __forceinline__ void conv_weight(const float* W, const float* gain, bf16_t* Bt, int K, int Nsrc, int N, int mode, LAS float*) {
    const int tid = opaque_tid(), nkt = K / 64, nnt = N / 64;
    const int tx = tid & 63, kq = tid >> 6;
    for (int tix = blockIdx.x; tix < nkt * nnt; tix += gridDim.x) {
        const int kt = tix % nkt, ntl = tix / nkt, k0 = kt * 64 + kq * 8, np = ntl * 64 + tx;
        int src = np; float cs = 1.0f;
        if (mode == 1) { if (np < 512) cs = 0.125f; else if (np >= 2048 && np < 2560) cs = 0.08838834764831845f; }
        else if (mode == 2) cs = 0.0625f;
        else if (mode == 3) { const int pn = np >> 8, r = np & 255; src = (r < 128) ? (pn * 128 + r) : (DFF + pn * 128 + (r - 128)); }
        float v[8];
#pragma unroll
        for (int j = 0; j < 8; ++j) v[j] = W[(size_t)(k0 + j) * Nsrc + src];
        if (gain) {
            const float4 g0 = *(const float4*)(gain + k0), g1 = *(const float4*)(gain + k0 + 4);
            v[0] *= g0.x; v[1] *= g0.y; v[2] *= g0.z; v[3] *= g0.w; v[4] *= g1.x; v[5] *= g1.y; v[6] *= g1.z; v[7] *= g1.w;
        }
        uint4 w;
        w.x = cvt_pk_bf16(v[0] * cs, v[1] * cs); w.y = cvt_pk_bf16(v[2] * cs, v[3] * cs); w.z = cvt_pk_bf16(v[4] * cs, v[5] * cs); w.w = cvt_pk_bf16(v[6] * cs, v[7] * cs);
        *(uint4*)(Bt + (size_t)np * K + k0) = w;
    }
}

__device__ __forceinline__ void sincos_d(double a, float& s_out, float& c_out) {
    const double k = rint(a * 0.63661977236758134308);
    const double r = (a - k * 1.57079632679489655800) - k * 6.12323399573676603587e-17;
    const double r2 = r * r;
    double sp = -1.0 / 1307674368000.0;
    sp = sp * r2 + 1.0 / 6227020800.0; sp = sp * r2 - 1.0 / 39916800.0; sp = sp * r2 + 1.0 / 362880.0; sp = sp * r2 - 1.0 / 5040.0; sp = sp * r2 + 1.0 / 120.0; sp = sp * r2 - 1.0 / 6.0; sp = sp * r2 + 1.0;
    const double sn = sp * r;
    double cp = 1.0 / 20922789888000.0;
    cp = cp * r2 - 1.0 / 87178291200.0; cp = cp * r2 + 1.0 / 479001600.0; cp = cp * r2 - 1.0 / 3628800.0; cp = cp * r2 + 1.0 / 40320.0; cp = cp * r2 - 1.0 / 720.0; cp = cp * r2 + 1.0 / 24.0; cp = cp * r2 - 0.5; cp = cp * r2 + 1.0;
    const int q = ((int)k) & 3;
    double s, c;
    if (q == 0) { s = sn; c = cp; } else if (q == 1) { s = cp; c = -sn; } else if (q == 2) { s = -sn; c = -cp; } else { s = -cp; c = sn; }
    s_out = (float)s; c_out = (float)c;
}


constexpr int SRED_RSTD = 512;
constexpr int SRED_GEMV = 1024;
__device__ __forceinline__ void side_rstd(const float* v_t, int K, float inv_dim, LAS float* red) {
    const int tid = opaque_tid(), b = tid & 31, part = tid >> 5;
    float s = 0.f;
    for (int k = part; k < K; k += 16) { const float xv = v_t[k * 32 + b]; s += xv * xv; }
    red[tid] = s;
    __syncthreads();
    if (tid < 32) { float t = 0.f; for (int q = 0; q < 16; ++q) t += red[q * 32 + tid]; red[SRED_RSTD + tid] = rsqrtf(t * inv_dim + 1e-6f); }
    __syncthreads();
}
constexpr int SRED_IN = SRED_GEMV + 8 * 32 * 64;
template <class InF, class EpiF>
__device__ __forceinline__ void side_gemv(const float* W, int ldw, int K, int N, const InF& in, const EpiF& epi, LAS float* red) {
    const int tid = opaque_tid(), lane = tid & 63;
    const int kg = __builtin_amdgcn_readfirstlane(tid >> 6);
    const int ns = K >> 8;
    for (int c = blockIdx.x; c < (N >> 6); c += gridDim.x) {
        float acc[32];
#pragma unroll
        for (int b = 0; b < 32; ++b) acc[b] = 0.f;
        float xs[16];
        int t0 = tid; asm volatile("" : "+v"(t0));
#pragma unroll
        for (int i = 0; i < 16; ++i) { const int idx = t0 + 512 * i, k = idx >> 5; xs[i] = in.v(k, idx & 31, c) * in.ws(k); }
        __syncthreads();
#pragma unroll
        for (int i = 0; i < 16; ++i) red[SRED_IN + t0 + 512 * i] = xs[i];
        __syncthreads();
        for (int sl = 0; sl < ns; ++sl) {
            const int ks = sl << 8;
            LAS float* xin = red + SRED_IN + (sl & 1) * 8192;
            const float* wp = W + (size_t)(ks + 32 * kg) * ldw + c * 64 + lane;
            float w[32];
#pragma unroll
            for (int i = 0; i < 32; ++i) w[i] = wp[(size_t)i * ldw];
            LAS float* wl = red + SRED_GEMV + (kg * 32) * 64 + lane;
#pragma unroll
            for (int i = 0; i < 32; ++i) wl[i * 64] = w[i];
            asm volatile("" ::: "memory");
            int t1 = tid; asm volatile("" : "+v"(t1));
            if (sl + 1 < ns) {
#pragma unroll
                for (int i = 0; i < 16; ++i) { const int idx = t1 + 512 * i, k = ks + 256 + (idx >> 5); xs[i] = in.v(k, idx & 31, c) * in.ws(k); }
            }
#pragma unroll 1
            for (int k4 = 0; k4 < 8; ++k4) {
                const LAS f32x4* xv = (const LAS f32x4*)(xin + (32 * kg + k4 * 4) * 32);
                const float w0 = wl[(k4 * 4) * 64], w1 = wl[(k4 * 4 + 1) * 64], w2 = wl[(k4 * 4 + 2) * 64], w3 = wl[(k4 * 4 + 3) * 64];
#pragma unroll
                for (int q = 0; q < 8; ++q) {
                    const f32x4 x0 = xv[q], x1 = xv[8 + q], x2 = xv[16 + q], x3 = xv[24 + q];
                    acc[4 * q] += x0[0] * w0 + x1[0] * w1 + x2[0] * w2 + x3[0] * w3; acc[4 * q + 1] += x0[1] * w0 + x1[1] * w1 + x2[1] * w2 + x3[1] * w3;
                    acc[4 * q + 2] += x0[2] * w0 + x1[2] * w1 + x2[2] * w2 + x3[2] * w3; acc[4 * q + 3] += x0[3] * w0 + x1[3] * w1 + x2[3] * w2 + x3[3] * w3;
                }
            }
            if (sl + 1 < ns) {
                LAS float* xnx = red + SRED_IN + ((sl + 1) & 1) * 8192;
#pragma unroll
                for (int i = 0; i < 16; ++i) xnx[t1 + 512 * i] = xs[i];
            }
            __syncthreads();
        }
#pragma unroll
        for (int b = 0; b < 32; ++b) red[SRED_GEMV + (kg * 32 + b) * 64 + lane] = acc[b];
        __syncthreads();
#pragma unroll
        for (int i = 0; i < 4; ++i) {
            const int idx = tid + 512 * i, col = idx & 63, b = idx >> 6;
            float sum = 0.f;
#pragma unroll
            for (int g = 0; g < 8; ++g) sum += red[SRED_GEMV + (g * 32 + b) * 64 + col];
            epi(c * 64 + col, b, sum);
        }
        __syncthreads();
    }
}
template <class InF>
__device__ __forceinline__ void side_gemv_ks(const float* W, int ldw, int K, int N, const InF& in, float* h_t, LAS float* red) {
    const int tid = opaque_tid(), lane = tid & 63;
    const int kg = __builtin_amdgcn_readfirstlane(tid >> 6);
    const int ns = K >> 8, items = (N >> 6) * ns;
    for (int item = blockIdx.x; item < items; item += gridDim.x) {
        const int c = item / ns, ks = (item - c * ns) << 8;
        float xs[16];
        int t0 = tid; asm volatile("" : "+v"(t0));
#pragma unroll
        for (int i = 0; i < 16; ++i) { const int idx = t0 + 512 * i, k = ks + (idx >> 5); xs[i] = in.v(k, idx & 31, c) * in.ws(k); }
        float w[32];
        {
            const float* wp = W + (size_t)(ks + 32 * kg) * ldw + c * 64 + lane;
#pragma unroll
            for (int i = 0; i < 32; ++i) w[i] = wp[(size_t)i * ldw];
        }
        __syncthreads();
#pragma unroll
        for (int i = 0; i < 16; ++i) red[SRED_IN + t0 + 512 * i] = xs[i];
        LAS float* wl = red + SRED_GEMV + (kg * 32) * 64 + lane;
#pragma unroll
        for (int i = 0; i < 32; ++i) wl[i * 64] = w[i];
        __syncthreads();
        float acc[32];
#pragma unroll
        for (int b = 0; b < 32; ++b) acc[b] = 0.f;
        LAS float* xin = red + SRED_IN;
#pragma unroll 1
        for (int k4 = 0; k4 < 8; ++k4) {
            const LAS f32x4* xv = (const LAS f32x4*)(xin + (32 * kg + k4 * 4) * 32);
            const float w0 = wl[(k4 * 4) * 64], w1 = wl[(k4 * 4 + 1) * 64], w2 = wl[(k4 * 4 + 2) * 64], w3 = wl[(k4 * 4 + 3) * 64];
#pragma unroll
            for (int q = 0; q < 8; ++q) {
                const f32x4 x0 = xv[q], x1 = xv[8 + q], x2 = xv[16 + q], x3 = xv[24 + q];
                acc[4 * q] += x0[0] * w0 + x1[0] * w1 + x2[0] * w2 + x3[0] * w3; acc[4 * q + 1] += x0[1] * w0 + x1[1] * w1 + x2[1] * w2 + x3[1] * w3;
                acc[4 * q + 2] += x0[2] * w0 + x1[2] * w1 + x2[2] * w2 + x3[2] * w3; acc[4 * q + 3] += x0[3] * w0 + x1[3] * w1 + x2[3] * w2 + x3[3] * w3;
            }
        }
        __syncthreads();
#pragma unroll
        for (int b = 0; b < 32; ++b) red[SRED_GEMV + (kg * 32 + b) * 64 + lane] = acc[b];
        __syncthreads();
#pragma unroll
        for (int i = 0; i < 4; ++i) {
            const int idx = tid + 512 * i, col = idx & 63, b = idx >> 6;
            float sum = 0.f;
#pragma unroll
            for (int g = 0; g < 8; ++g) sum += red[SRED_GEMV + (g * 32 + b) * 64 + col];
            atomicAdd(h_t + (c * 64 + col) * 32 + b, sum);
        }
        __syncthreads();
    }
}
struct InPlain { const float* v_t; const float* gain; __device__ __forceinline__ float ws(int k) const { return gain ? gain[k] : 1.0f; } __device__ __forceinline__ float v(int k, int b, int) const { return v_t[k * 32 + b]; } };
struct InSgu { const float* z_t; const float* sgu_w; const float* sgu_b; const float* sgu_norm; const LAS float* rstdv;
    __device__ __forceinline__ float ws(int) const { return 1.0f; }
    __device__ __forceinline__ float v(int k, int b, int) const { const int g = k >> 7; return z_t[k * 32 + b] * (sgu_w[(size_t)g * 16384] * z_t[(512 + k) * 32 + b] * rstdv[b] * sgu_norm[k] + sgu_b[g * 128]); } };
struct InHead { const float* t_t; __device__ __forceinline__ float ws(int) const { return 1.0f; } __device__ __forceinline__ float v(int k, int b, int c) const { return t_t[((size_t)(c >> 2) * 1024 + k) * 32 + b]; } };
struct InSwiglu { const float* z_t; __device__ __forceinline__ float ws(int) const { return 1.0f; } __device__ __forceinline__ float v(int k, int b, int) const { return silu_f(z_t[k * 32 + b]) * z_t[(DFF + k) * 32 + b]; } };
struct EpStore { float* o_t; const LAS float* rstd; float scale; int act;
    __device__ __forceinline__ void operator()(int n, int b, float s) const { float v = s * scale * (rstd ? rstd[b] : 1.0f); if (act == 1) v = gelu_tanh_f(v); o_t[n * 32 + b] = v; } };
struct EpAdd { float* h_t; __device__ __forceinline__ void operator()(int n, int b, float s) const { h_t[n * 32 + b] += s; } };


__device__ __forceinline__ void xattn_phase(LAS unsigned char* lds, bf16_t* Yq, const bf16_t* Kmat, const bf16_t* VT) {
    const int tid = opaque_tid(), lane = tid & 63, r = lane & 15, qp = lane >> 4;
    const int wave = __builtin_amdgcn_readfirstlane(tid >> 6);
    constexpr int KS = 528;
    for (int trip = 0;; ++trip) {
        const int unit = xcd_unit(trip, 1024);
        if (unit < 0) break;
        const int b = unit >> 5, h = (unit >> 3) & 3, qb = unit & 7;
        __syncthreads();
        int tk = tid; asm volatile("" : "+v"(tk));
#pragma unroll
        for (int half = 0; half < 2; ++half) {
            u32x4_t tv[8];
#pragma unroll
            for (int i = 0; i < 8; ++i) { const int c = tk + 512 * (half * 8 + i), row = c >> 5, ch = c & 31; tv[i] = *(const u32x4_t*)(Kmat + (size_t)(b * 256 + row) * 1024 + h * 256 + ch * 8); }
#pragma unroll
            for (int i = 0; i < 8; ++i) { const int c = tk + 512 * (half * 8 + i), row = c >> 5, ch = c & 31; *(LAS u32x4_t*)(lds + row * KS + ch * 16) = tv[i]; }
        }
        __syncthreads();
        const int q0 = b * 2048 + qb * 256 + wave * 32;
        bf16x8_t pf[2][8];
        float inv[2];
        {
            f32x4 sacc[2][16];
#pragma unroll
            for (int kt = 0; kt < 16; ++kt) { sacc[0][kt] = (f32x4){0.f, 0.f, 0.f, 0.f}; sacc[1][kt] = (f32x4){0.f, 0.f, 0.f, 0.f}; }
            const bf16_t* qrow = Yq + (size_t)(q0 + r) * 1024 + h * 256 + qp * 8;
            const LAS unsigned char* kb = lds + r * KS + qp * 16; const LAS unsigned char* kb2 = kb + 8 * 16 * KS; asm volatile("" : "+v"(kb2));
            bf16x8_t qa = *(const bf16x8_t*)qrow, qb = *(const bf16x8_t*)(qrow + 16 * 1024);
#pragma unroll
            for (int ks = 0; ks < 8; ++ks) {
                const bf16x8_t qf0 = qa, qf1 = qb;
                if (ks < 7) { qa = *(const bf16x8_t*)(qrow + (ks + 1) * 32); qb = *(const bf16x8_t*)(qrow + 16 * 1024 + (ks + 1) * 32); }
#pragma unroll
                for (int kt = 0; kt < 16; ++kt) {
                    const bf16x8_t a = *(const LAS bf16x8_t*)((kt < 8 ? kb : kb2) + (kt & 7) * 16 * KS + ks * 64);
                    sacc[0][kt] = __builtin_amdgcn_mfma_f32_16x16x32_bf16(a, qf0, sacc[0][kt], 0, 0, 0);
                    sacc[1][kt] = __builtin_amdgcn_mfma_f32_16x16x32_bf16(a, qf1, sacc[1][kt], 0, 0, 0);
                }
            }
#pragma unroll
            for (int qt = 0; qt < 2; ++qt) {
                float mx = -INFINITY;
#pragma unroll
                for (int kt = 0; kt < 16; ++kt) mx = fmaxf(mx, fmaxf(fmaxf(sacc[qt][kt][0], sacc[qt][kt][1]), fmaxf(sacc[qt][kt][2], sacc[qt][kt][3])));
                mx = fmaxf(mx, __shfl_xor(mx, 16)); mx = fmaxf(mx, __shfl_xor(mx, 32));
                float sum = 0.f;
#pragma unroll
                for (int kt = 0; kt < 16; ++kt) {
#pragma unroll
                    for (int j = 0; j < 4; ++j) { const float e = __builtin_amdgcn_exp2f((sacc[qt][kt][j] - mx) * 1.4426950408889634f); sacc[qt][kt][j] = e; sum += e; }
                }
                sum += __shfl_xor(sum, 16); sum += __shfl_xor(sum, 32);
                inv[qt] = 1.0f / sum;
#pragma unroll
                for (int u = 0; u < 8; ++u) {
                    u32x4_t w;
                    w[0] = cvt_pk_bf16(sacc[qt][2 * u][0], sacc[qt][2 * u][1]); w[1] = cvt_pk_bf16(sacc[qt][2 * u][2], sacc[qt][2 * u][3]);
                    w[2] = cvt_pk_bf16(sacc[qt][2 * u + 1][0], sacc[qt][2 * u + 1][1]); w[3] = cvt_pk_bf16(sacc[qt][2 * u + 1][2], sacc[qt][2 * u + 1][3]);
                    pf[qt][u] = __builtin_bit_cast(bf16x8_t, w);
                }
            }
        }
        __syncthreads();
        int tv2 = tid; asm volatile("" : "+v"(tv2));
#pragma unroll 1
        for (int qd = 0; qd < 4; ++qd) {
            u32x4_t tv[4];
#pragma unroll
            for (int i = 0; i < 4; ++i) { const int c = tv2 + 512 * (qd * 4 + i), row = c >> 5, ch = c & 31; tv[i] = *(const u32x4_t*)(VT + (size_t)(h * 256 + row) * MROWS + b * 256 + ch * 8); }
#pragma unroll
            for (int i = 0; i < 4; ++i) { const int c = tv2 + 512 * (qd * 4 + i), row = c >> 5, ch = c & 31; *(LAS u32x4_t*)(lds + (((row & 15) << 4) | (row >> 4)) * KS + ch * 16) = tv[i]; }
        }
        __syncthreads();
        {
            f32x4 oacc[2][16];
#pragma unroll
            for (int nt = 0; nt < 16; ++nt) { oacc[0][nt] = (f32x4){0.f, 0.f, 0.f, 0.f}; oacc[1][nt] = (f32x4){0.f, 0.f, 0.f, 0.f}; }
            const LAS unsigned char* vb = lds + r * KS + qp * 8; const LAS unsigned char* vb2 = vb + 8 * 16 * KS; asm volatile("" : "+v"(vb2));
#pragma unroll
            for (int u = 0; u < 8; ++u)
#pragma unroll
                for (int nt = 0; nt < 16; ++nt) {
                    const LAS unsigned char* bp = (nt < 8 ? vb : vb2) + (nt & 7) * 16 * KS + u * 64;
                    const u32x2_t lo = *(const LAS u32x2_t*)bp, hi = *(const LAS u32x2_t*)(bp + 32);
                    u32x4_t w; w[0] = lo[0]; w[1] = lo[1]; w[2] = hi[0]; w[3] = hi[1];
                    const bf16x8_t bv = __builtin_bit_cast(bf16x8_t, w);
                    oacc[0][nt] = __builtin_amdgcn_mfma_f32_16x16x32_bf16(pf[0][u], bv, oacc[0][nt], 0, 0, 0);
                    oacc[1][nt] = __builtin_amdgcn_mfma_f32_16x16x32_bf16(pf[1][u], bv, oacc[1][nt], 0, 0, 0);
                }
            int r2 = r, qp2 = qp; asm volatile("" : "+v"(r2), "+v"(qp2));
#pragma unroll
            for (int qt = 0; qt < 2; ++qt)
#pragma unroll
                for (int j = 0; j < 4; ++j) {
                    const float is = __shfl(inv[qt], qp2 * 4 + j);
                    bf16_t* op = Yq + (size_t)(q0 + qt * 16 + qp2 * 4 + j) * 1024 + h * 256 + r2 * 16;
                    u32x4_t w0, w1;
#pragma unroll
                    for (int e = 0; e < 4; ++e) { w0[e] = cvt_pk_bf16(oacc[qt][2 * e][j] * is, oacc[qt][2 * e + 1][j] * is); w1[e] = cvt_pk_bf16(oacc[qt][8 + 2 * e][j] * is, oacc[qt][9 + 2 * e][j] * is); }
                    *(u32x4_t*)op = w0; *(u32x4_t*)(op + 8) = w1;
                }
        }
    }
    __syncthreads();
}

constexpr int RP = 272;
constexpr int RTILE = 128 * RP;
__device__ __forceinline__ float ret_lg2(int h) { return log2f(1.0f - exp2f(-5.0f - (float)h)); }
template <int TR>
__device__ __forceinline__ void ret_stage_rot(LAS unsigned char* dst, const bf16_t* Z1, int tok0, int col0, const float* TAB, float lg2, float sgn, int tid) {
    for (int it = tid; it < 1024; it += 512) {
        const int row = TR ? (it & 127) : (it >> 3), c8 = TR ? ((it >> 7) * 8) : ((it & 7) * 8);
        const bf16_t* zp = Z1 + (size_t)(tok0 + row) * ODD_IN + col0 + c8;
        const u32x4_t a = *(const u32x4_t*)zp, bq = *(const u32x4_t*)(zp + 64);
        const int pos = (tok0 + row) & 2047;
        const float4 c0 = *(const float4*)(TAB + TAB_RC + pos * 64 + c8), c1 = *(const float4*)(TAB + TAB_RC + pos * 64 + c8 + 4);
        const float4 s0 = *(const float4*)(TAB + TAB_RS + pos * 64 + c8), s1 = *(const float4*)(TAB + TAB_RS + pos * 64 + c8 + 4);
        const float sc = exp2f(sgn * (float)(row + 1) * lg2);
        const float x1[8] = {bflo(a[0]), bfhi(a[0]), bflo(a[1]), bfhi(a[1]), bflo(a[2]), bfhi(a[2]), bflo(a[3]), bfhi(a[3])};
        const float x2[8] = {bflo(bq[0]), bfhi(bq[0]), bflo(bq[1]), bfhi(bq[1]), bflo(bq[2]), bfhi(bq[2]), bflo(bq[3]), bfhi(bq[3])};
        const float cs[8] = {c0.x, c0.y, c0.z, c0.w, c1.x, c1.y, c1.z, c1.w};
        const float sn[8] = {s0.x, s0.y, s0.z, s0.w, s1.x, s1.y, s1.z, s1.w};
        float o1[8], o2[8];
#pragma unroll
        for (int e = 0; e < 8; ++e) { o1[e] = (x1[e] * cs[e] - x2[e] * sn[e]) * sc; o2[e] = (x1[e] * sn[e] + x2[e] * cs[e]) * sc; }
        if (TR == 0) {
            u32x4_t w1, w2;
#pragma unroll
            for (int e = 0; e < 4; ++e) { w1[e] = cvt_pk_bf16(o1[2 * e], o1[2 * e + 1]); w2[e] = cvt_pk_bf16(o2[2 * e], o2[2 * e + 1]); }
            *(LAS u32x4_t*)(dst + row * RP + c8 * 2) = w1; *(LAS u32x4_t*)(dst + row * RP + (64 + c8) * 2) = w2;
        } else {
#pragma unroll
            for (int e = 0; e < 8; ++e) {
                const int d1 = c8 + e, d2 = 64 + c8 + e;
                *(LAS unsigned short*)(dst + ((d1 & 7) * 16 + (d1 >> 3)) * RP + row * 2) = f2bf(o1[e]); *(LAS unsigned short*)(dst + ((d2 & 7) * 16 + (d2 >> 3)) * RP + row * 2) = f2bf(o2[e]);
            }
        }
    }
}
template <int PERM8>
__device__ __forceinline__ void stage_tr128(LAS unsigned char* dst, const bf16_t* src, int ld, int tok0, int col0, int tid) {
    for (int it = tid; it < 2048; it += 512) {
        const int row = it & 127, c8 = (it >> 7) * 8;
        const u32x4_t a = *(const u32x4_t*)(src + (size_t)(tok0 + row) * ld + col0 + c8);
#pragma unroll
        for (int e = 0; e < 4; ++e) {
            const int e0 = c8 + 2 * e, e1 = e0 + 1;
            *(LAS unsigned short*)(dst + (PERM8 ? ((e0 & 7) * 16 + (e0 >> 3)) : e0) * RP + row * 2) = (unsigned short)(a[e] & 0xffffu);
            *(LAS unsigned short*)(dst + (PERM8 ? ((e1 & 7) * 16 + (e1 >> 3)) : e1) * RP + row * 2) = (unsigned short)(a[e] >> 16);
        }
    }
}
__device__ __forceinline__ void ret_r1(LAS unsigned char* lds, const bf16_t* Z1, const float* TAB, bf16_t* RET) {
    const int tid = opaque_tid(), lane = tid & 63, r = lane & 15, qp = lane >> 4;
    const int wave = __builtin_amdgcn_readfirstlane(tid >> 6);
    LAS unsigned char* KT = lds; LAS unsigned char* VTL = lds + RTILE;
    for (int unit = blockIdx.x; unit < 2048; unit += gridDim.x) {
        const int b = unit >> 6, h = (unit >> 4) & 3, n = unit & 15, tok0 = b * 2048 + n * 128;
        const float lg2 = ret_lg2(h);
        __syncthreads();
        ret_stage_rot<1>(KT, Z1, tok0, 2048 + h * 128, TAB, lg2, -1.0f, tid);
        stage_tr128<0>(VTL, Z1, ODD_IN, tok0, 2560 + h * 128, tid);
        __syncthreads();
        f32x4 acc[8];
#pragma unroll
        for (int nt = 0; nt < 8; ++nt) acc[nt] = (f32x4){0.f, 0.f, 0.f, 0.f};
#pragma unroll
        for (int ks = 0; ks < 4; ++ks) {
            const bf16x8_t a = *(const LAS bf16x8_t*)(VTL + (16 * wave + r) * RP + (32 * ks + 8 * qp) * 2);
#pragma unroll
            for (int nt = 0; nt < 8; ++nt) {
                const bf16x8_t bv = *(const LAS bf16x8_t*)(KT + (16 * nt + r) * RP + (32 * ks + 8 * qp) * 2);
                acc[nt] = __builtin_amdgcn_mfma_f32_16x16x32_bf16(a, bv, acc[nt], 0, 0, 0);
            }
        }
        const float g128 = exp2f(128.0f * lg2);
        bf16_t* op = RET + (size_t)unit * 16384;
#pragma unroll
        for (int j = 0; j < 4; ++j) {
            u32x4_t w;
#pragma unroll
            for (int e = 0; e < 4; ++e) w[e] = cvt_pk_bf16(acc[2 * e][j] * g128, acc[2 * e + 1][j] * g128);
            *(u32x4_t*)(op + (16 * wave + 4 * qp + j) * 128 + 8 * r) = w;
        }
    }
    __syncthreads();
}
__device__ __forceinline__ void ret_r2(bf16_t* RET) {
    const int tid = opaque_tid();
    for (int idx = blockIdx.x * 512 + tid; idx < 128 * 8192; idx += gridDim.x * 512) {
        const int bh = idx >> 13, pr = idx & 8191;
        const float g128 = exp2f(128.0f * ret_lg2(bh & 3));
        unsigned* p = (unsigned*)(RET + (size_t)bh * 16 * 16384) + pr;
        float s0 = 0.f, s1 = 0.f;
        for (int n = 0; n < 16; ++n) {
            const unsigned v = p[(size_t)n * 8192];
            p[(size_t)n * 8192] = cvt_pk_bf16(s0, s1);
            s0 = s0 * g128 + bflo(v); s1 = s1 * g128 + bfhi(v);
        }
    }
}
__device__ __forceinline__ void ret_r3(LAS unsigned char* lds, const bf16_t* Z1, const float* TAB, const bf16_t* RET, const float* SDZ, bf16_t* Yo) {
    const int tid = opaque_tid(), lane = tid & 63, r = lane & 15, qp = lane >> 4;
    const int wave = __builtin_amdgcn_readfirstlane(tid >> 6);
    LAS unsigned char* QL = lds; LAS unsigned char* KL = lds + RTILE; LAS unsigned char* VTL = lds + 2 * RTILE; LAS unsigned char* PL = lds + 3 * RTILE;
    for (int unit = blockIdx.x; unit < 2048; unit += gridDim.x) {
        const int b = unit >> 6, h = (unit >> 4) & 3, n = unit & 15, tok0 = b * 2048 + n * 128;
        const float lg2 = ret_lg2(h);
        __syncthreads();
        ret_stage_rot<0>(QL, Z1, tok0, 1536 + h * 128, TAB, lg2, 1.0f, tid);
        ret_stage_rot<0>(KL, Z1, tok0, 2048 + h * 128, TAB, lg2, -1.0f, tid);
        stage_tr128<1>(VTL, Z1, ODD_IN, tok0, 2560 + h * 128, tid);
        for (int it = tid; it < 2048; it += 512) { const int row = it >> 4, c8 = (it & 15) * 8; *(LAS u32x4_t*)(PL + ((row & 7) * 16 + (row >> 3)) * RP + c8 * 2) = *(const u32x4_t*)(RET + (size_t)unit * 16384 + row * 128 + c8); }
        __syncthreads();
        bf16x8_t qf[4];
#pragma unroll
        for (int ks = 0; ks < 4; ++ks) qf[ks] = *(const LAS bf16x8_t*)(QL + (16 * wave + r) * RP + (32 * ks + 8 * qp) * 2);
        f32x4 sacc[8];
#pragma unroll
        for (int jt = 0; jt < 8; ++jt) {
            sacc[jt] = (f32x4){0.f, 0.f, 0.f, 0.f};
            if (jt <= wave) {
#pragma unroll
                for (int ks = 0; ks < 4; ++ks) {
                    const bf16x8_t a = *(const LAS bf16x8_t*)(KL + (16 * jt + r) * RP + (32 * ks + 8 * qp) * 2);
                    sacc[jt] = __builtin_amdgcn_mfma_f32_16x16x32_bf16(a, qf[ks], sacc[jt], 0, 0, 0);
                }
#pragma unroll
                for (int j = 0; j < 4; ++j) if (16 * jt + 4 * qp + j > 16 * wave + r) sacc[jt][j] = 0.f;
            }
        }
        if (n == 0 && wave == 0) {
            const float* zq = SDZ + (size_t)(h * 128) * 32 + b;
            const float c = wave_sum(zq[lane * 32] * zq[(512 + lane) * 32] + zq[(lane + 64) * 32] * zq[(512 + lane + 64) * 32]) * 0.08838834764831845f;
            if (lane == 0) sacc[0][0] = c;
        }
        bf16x8_t pf[4];
#pragma unroll
        for (int u = 0; u < 4; ++u) {
            u32x4_t w;
            w[0] = cvt_pk_bf16(sacc[2 * u][0], sacc[2 * u][1]); w[1] = cvt_pk_bf16(sacc[2 * u][2], sacc[2 * u][3]);
            w[2] = cvt_pk_bf16(sacc[2 * u + 1][0], sacc[2 * u + 1][1]); w[3] = cvt_pk_bf16(sacc[2 * u + 1][2], sacc[2 * u + 1][3]);
            pf[u] = __builtin_bit_cast(bf16x8_t, w);
        }
        f32x4 oacc[8];
#pragma unroll
        for (int nt = 0; nt < 8; ++nt) oacc[nt] = (f32x4){0.f, 0.f, 0.f, 0.f};
#pragma unroll
        for (int u = 0; u < 4; ++u) {
            if (2 * u <= wave) {
#pragma unroll
                for (int nt = 0; nt < 8; ++nt) {
                    const LAS unsigned char* bp = VTL + (16 * nt + r) * RP + (32 * u + 4 * qp) * 2;
                    const u32x2_t lo = *(const LAS u32x2_t*)bp, hi = *(const LAS u32x2_t*)(bp + 32);
                    u32x4_t w; w[0] = lo[0]; w[1] = lo[1]; w[2] = hi[0]; w[3] = hi[1];
                    oacc[nt] = __builtin_amdgcn_mfma_f32_16x16x32_bf16(pf[u], __builtin_bit_cast(bf16x8_t, w), oacc[nt], 0, 0, 0);
                }
            }
        }
#pragma unroll
        for (int ks = 0; ks < 4; ++ks)
#pragma unroll
            for (int nt = 0; nt < 8; ++nt) {
                const bf16x8_t bv = *(const LAS bf16x8_t*)(PL + (16 * nt + r) * RP + (32 * ks + 8 * qp) * 2);
                oacc[nt] = __builtin_amdgcn_mfma_f32_16x16x32_bf16(qf[ks], bv, oacc[nt], 0, 0, 0);
            }
#pragma unroll
        for (int j = 0; j < 4; ++j) {
            float sm = 0.f;
#pragma unroll
            for (int nt = 0; nt < 8; ++nt) sm += oacc[nt][j];
            sm += __shfl_xor(sm, 1); sm += __shfl_xor(sm, 2); sm += __shfl_xor(sm, 4); sm += __shfl_xor(sm, 8);
            const float mu = sm * (1.0f / 128.0f);
            float vr = 0.f;
#pragma unroll
            for (int nt = 0; nt < 8; ++nt) { const float d = oacc[nt][j] - mu; vr += d * d; }
            vr += __shfl_xor(vr, 1); vr += __shfl_xor(vr, 2); vr += __shfl_xor(vr, 4); vr += __shfl_xor(vr, 8);
            const float rs = rsqrtf(vr * (1.0f / 128.0f) + 1e-6f);
            const size_t tok = (size_t)(tok0 + 16 * wave + 4 * qp + j);
            const u32x4_t gg = *(const u32x4_t*)(Z1 + tok * ODD_IN + 3072 + h * 128 + 8 * r);
            u32x4_t w;
#pragma unroll
            for (int e = 0; e < 4; ++e) w[e] = cvt_pk_bf16(bflo(gg[e]) * (oacc[2 * e][j] - mu) * rs, bfhi(gg[e]) * (oacc[2 * e + 1][j] - mu) * rs);
            *(u32x4_t*)(Yo + tok * 1024 + 512 + h * 128 + 8 * r) = w;
        }
    }
    __syncthreads();
}

constexpr int DKP = 144;
constexpr int DVP = 592;
constexpr int DK_BYTES = 256 * DKP;
#define DIL_DECODE(u) const int b = (u) / 384, v = (u) - b * 384, h = v / 48, v2 = v - h * 48, g = v2 >> 4, rb = v2 & 15; \
    const int lognb = 4 - 2 * g, dil = 1 << (2 * g), nbi = rb & ((1 << lognb) - 1), res = rb >> lognb; const int tokb = b * 2048
#define DIL_ISSUE(u) do { DIL_DECODE(u); const int row_ = (wave & 3) * 64 + lane, hh_ = wave >> 2; const int j_ = 128 * nbi - 128 + row_; validr = j_ >= 0; const int pos_ = validr ? j_ * dil + res : 0; \
    const bf16_t* zr_ = Z1 + (size_t)(tokb + pos_) * ODD_IN + h * 64 + hh_ * 32; \
    _Pragma("unroll") for (int i_ = 0; i_ < 4; ++i_) { kvr[i_] = *(const u32x4_t*)(zr_ + 512 + i_ * 8); vvr[i_] = *(const u32x4_t*)(zr_ + 1024 + i_ * 8); } \
    if (hh_ == 0) { const float* tc_ = TAB + TAB_DC + pos_ * 8; const float* ts_ = TAB + TAB_DS + pos_ * 8; kc0 = *(const float4*)tc_; kc1 = *(const float4*)(tc_ + 4); ks0 = *(const float4*)ts_; ks1 = *(const float4*)(ts_ + 4); } \
    const int qpos_ = (128 * nbi + 16 * wave + r) * dil + res; const bf16_t* qrow_ = Z1 + (size_t)(tokb + qpos_) * ODD_IN + h * 64 + qp * 8; \
    qr0 = *(const u32x4_t*)qrow_; qr1 = *(const u32x4_t*)(qrow_ + 32); \
    { const float* tc_ = TAB + TAB_DC + qpos_ * 8; const float* ts_ = TAB + TAB_DS + qpos_ * 8; qc0 = *(const float4*)tc_; qc1 = *(const float4*)(tc_ + 4); qs0 = *(const float4*)ts_; qs1 = *(const float4*)(ts_ + 4); } } while (0)
__device__ __forceinline__ void dil_units(LAS unsigned char* lds, const bf16_t* Z1, const float* TAB, bf16_t* OB01, bf16_t* Yo, float* LSE) {
    const int tid = opaque_tid(), lane = tid & 63, r = lane & 15, qp = lane >> 4;
    const int wave = __builtin_amdgcn_readfirstlane(tid >> 6);
    LAS unsigned char* KL = lds; LAS unsigned char* VTL = lds + DK_BYTES;
    __syncthreads();
    for (int i = tid; i < 64 * 16; i += 512) { const int d = i >> 4, c = i & 15; *(LAS unsigned*)(VTL + d * DVP + 512 + c * 4) = 0u; }
    u32x4_t kvr[4], vvr[4], qr0, qr1; float4 kc0, kc1, ks0, ks1, qc0, qc1, qs0, qs1; bool validr;
    kc0 = kc1 = ks0 = ks1 = make_float4(0.f, 0.f, 0.f, 0.f);
    int trip = 0, unit = xcd_unit(0, 12288);
    if (unit >= 0) DIL_ISSUE(unit);
    while (unit >= 0) {
        DIL_DECODE(unit);
        __syncthreads();
        {
            const int row = (wave & 3) * 64 + lane, hh = wave >> 2;
            u32x4_t kv[4], vv[4];
#pragma unroll
            for (int i = 0; i < 4; ++i) { kv[i] = validr ? kvr[i] : (u32x4_t){0u, 0u, 0u, 0u}; vv[i] = validr ? vvr[i] : (u32x4_t){0u, 0u, 0u, 0u}; }
#pragma unroll
            for (int i = 0; i < 4; ++i)
#pragma unroll
                for (int e = 0; e < 4; ++e) {
                    *(LAS unsigned short*)(VTL + ((hh * 4 + i) * 8 + 2 * e) * DVP + row * 2) = (unsigned short)(vv[i][e] & 0xffffu);
                    *(LAS unsigned short*)(VTL + ((hh * 4 + i) * 8 + 2 * e + 1) * DVP + row * 2) = (unsigned short)(vv[i][e] >> 16);
                }
            if (hh == 0) {
                const float cs[8] = {kc0.x, kc0.y, kc0.z, kc0.w, kc1.x, kc1.y, kc1.z, kc1.w}, sn[8] = {ks0.x, ks0.y, ks0.z, ks0.w, ks1.x, ks1.y, ks1.z, ks1.w};
                const u32x4_t k1 = kv[0], k2 = kv[1];
                const float x1[8] = {bflo(k1[0]), bfhi(k1[0]), bflo(k1[1]), bfhi(k1[1]), bflo(k1[2]), bfhi(k1[2]), bflo(k1[3]), bfhi(k1[3])};
                const float x2[8] = {bflo(k2[0]), bfhi(k2[0]), bflo(k2[1]), bfhi(k2[1]), bflo(k2[2]), bfhi(k2[2]), bflo(k2[3]), bfhi(k2[3])};
#pragma unroll
                for (int e = 0; e < 4; ++e) {
                    kv[0][e] = cvt_pk_bf16(x1[2 * e] * cs[2 * e] - x2[2 * e] * sn[2 * e], x1[2 * e + 1] * cs[2 * e + 1] - x2[2 * e + 1] * sn[2 * e + 1]);
                    kv[1][e] = cvt_pk_bf16(x1[2 * e] * sn[2 * e] + x2[2 * e] * cs[2 * e], x1[2 * e + 1] * sn[2 * e + 1] + x2[2 * e + 1] * cs[2 * e + 1]);
                }
            }
#pragma unroll
            for (int i = 0; i < 4; ++i) *(LAS u32x4_t*)(KL + row * DKP + (hh * 4 + i) * 16) = kv[i];
        }
        const int qi = 128 * nbi + 16 * wave + r, qpos = qi * dil + res;
        u32x4_t q0 = qr0; const u32x4_t q1 = qr1;
        {
            u32x4_t pr;
#pragma unroll
            for (int e = 0; e < 4; ++e) pr[e] = (unsigned)__shfl_xor((int)q0[e], 16);
            const float cs[8] = {qc0.x, qc0.y, qc0.z, qc0.w, qc1.x, qc1.y, qc1.z, qc1.w}, sn[8] = {qs0.x, qs0.y, qs0.z, qs0.w, qs1.x, qs1.y, qs1.z, qs1.w};
            const float own[8] = {bflo(q0[0]), bfhi(q0[0]), bflo(q0[1]), bfhi(q0[1]), bflo(q0[2]), bfhi(q0[2]), bflo(q0[3]), bfhi(q0[3])};
            const float oth[8] = {bflo(pr[0]), bfhi(pr[0]), bflo(pr[1]), bfhi(pr[1]), bflo(pr[2]), bfhi(pr[2]), bflo(pr[3]), bfhi(pr[3])};
            float o[8];
#pragma unroll
            for (int e = 0; e < 8; ++e) o[e] = (qp == 0) ? (own[e] * cs[e] - oth[e] * sn[e]) : (oth[e] * sn[e] + own[e] * cs[e]);
            if (qp < 2) {
#pragma unroll
                for (int e = 0; e < 4; ++e) q0[e] = cvt_pk_bf16(o[2 * e], o[2 * e + 1]);
            }
        }
        const bf16x8_t qf0 = __builtin_bit_cast(bf16x8_t, q0), qf1 = __builtin_bit_cast(bf16x8_t, q1);
        const int nxt = xcd_unit(++trip, 12288);
        if (nxt >= 0) DIL_ISSUE(nxt);
        __syncthreads();
        f32x4 sacc[9];
        const LAS unsigned char* kb = KL + (16 * wave + r) * DKP + qp * 16;
#pragma unroll
        for (int st = 0; st < 9; ++st) {
            const bf16x8_t a0 = *(const LAS bf16x8_t*)(kb + st * 16 * DKP), a1 = *(const LAS bf16x8_t*)(kb + st * 16 * DKP + 64);
            f32x4 acc = (f32x4){0.f, 0.f, 0.f, 0.f};
            acc = __builtin_amdgcn_mfma_f32_16x16x32_bf16(a0, qf0, acc, 0, 0, 0);
            acc = __builtin_amdgcn_mfma_f32_16x16x32_bf16(a1, qf1, acc, 0, 0, 0);
#pragma unroll
            for (int j = 0; j < 4; ++j) {
                const int dk = 16 * st + 4 * qp + j;
                const bool ok = (dk >= r) && (dk <= r + 128) && (nbi > 0 || 16 * wave + dk >= 128);
                acc[j] = ok ? acc[j] : -INFINITY;
            }
            sacc[st] = acc;
        }
        float mx = -INFINITY;
#pragma unroll
        for (int st = 0; st < 9; ++st) mx = fmaxf(mx, fmaxf(fmaxf(sacc[st][0], sacc[st][1]), fmaxf(sacc[st][2], sacc[st][3])));
        mx = fmaxf(mx, __shfl_xor(mx, 16)); mx = fmaxf(mx, __shfl_xor(mx, 32));
        float sum = 0.f;
#pragma unroll
        for (int st = 0; st < 9; ++st) {
#pragma unroll
            for (int j = 0; j < 4; ++j) { const float e = (sacc[st][j] == -INFINITY) ? 0.f : __expf(sacc[st][j] - mx); sacc[st][j] = e; sum += e; }
        }
        sum += __shfl_xor(sum, 16); sum += __shfl_xor(sum, 32);
        const float inv = 1.0f / sum;
        if (qp == 0) LSE[((size_t)g * T + tokb + qpos) * 8 + h] = mx + __logf(sum);
        f32x4 oacc[4];
#pragma unroll
        for (int nt = 0; nt < 4; ++nt) oacc[nt] = (f32x4){0.f, 0.f, 0.f, 0.f};
        const LAS unsigned char* vb = VTL + r * DVP + (16 * wave + 4 * qp) * 2;
#pragma unroll
        for (int u = 0; u < 5; ++u) {
            u32x4_t w;
            w[0] = cvt_pk_bf16(sacc[2 * u][0], sacc[2 * u][1]); w[1] = cvt_pk_bf16(sacc[2 * u][2], sacc[2 * u][3]);
            if (u < 4) { w[2] = cvt_pk_bf16(sacc[2 * u + 1][0], sacc[2 * u + 1][1]); w[3] = cvt_pk_bf16(sacc[2 * u + 1][2], sacc[2 * u + 1][3]); } else { w[2] = 0u; w[3] = 0u; }
            const bf16x8_t pfr = __builtin_bit_cast(bf16x8_t, w);
#pragma unroll
            for (int nt = 0; nt < 4; ++nt) {
                const LAS unsigned char* bp = vb + nt * 16 * DVP + u * 64;
                const u32x2_t lo = *(const LAS u32x2_t*)bp, hi = *(const LAS u32x2_t*)(bp + 32);
                u32x4_t bw; bw[0] = lo[0]; bw[1] = lo[1]; bw[2] = hi[0]; bw[3] = hi[1];
                oacc[nt] = __builtin_amdgcn_mfma_f32_16x16x32_bf16(pfr, __builtin_bit_cast(bf16x8_t, bw), oacc[nt], 0, 0, 0);
            }
        }
        bf16_t* ob = (g == 2) ? Yo : (OB01 + (size_t)g * T * 512);
        const int opitch = (g == 2) ? 1024 : 512;
#pragma unroll
        for (int j = 0; j < 4; ++j) {
            const float is = __shfl(inv, qp * 4 + j);
            const int tq = tokb + (128 * nbi + 16 * wave + 4 * qp + j) * dil + res;
            bf16_t* op = ob + (size_t)tq * opitch + h * 64 + r;
#pragma unroll
            for (int nt = 0; nt < 4; ++nt) op[16 * nt] = f2bf(oacc[nt][j] * is);
        }
        unit = nxt;
    }
    __syncthreads();
}
#undef DIL_ISSUE
#undef DIL_DECODE
__device__ __forceinline__ void dil_combine(const bf16_t* OB01, bf16_t* Yo, const float* LSE) {
    const int tid = opaque_tid();
    for (int idx = blockIdx.x * 512 + tid; idx < T * 64; idx += gridDim.x * 512) {
        const int t = idx >> 6, c8 = (idx & 63) * 8, h = c8 >> 6;
        const float l0 = LSE[((size_t)0 * T + t) * 8 + h], l1 = LSE[((size_t)1 * T + t) * 8 + h], l2 = LSE[((size_t)2 * T + t) * 8 + h];
        const float m = fmaxf(l0, fmaxf(l1, l2));
        float w0 = __expf(l0 - m), w1 = __expf(l1 - m), w2 = __expf(l2 - m);
        const float is = 1.0f / (w0 + w1 + w2); w0 *= is; w1 *= is; w2 *= is;
        const u32x4_t a = *(const u32x4_t*)(OB01 + (size_t)t * 512 + c8), bq = *(const u32x4_t*)(OB01 + (size_t)T * 512 + (size_t)t * 512 + c8), c = *(const u32x4_t*)(Yo + (size_t)t * 1024 + c8);
        u32x4_t o;
#pragma unroll
        for (int e = 0; e < 4; ++e) o[e] = cvt_pk_bf16(w0 * bflo(a[e]) + w1 * bflo(bq[e]) + w2 * bflo(c[e]), w0 * bfhi(a[e]) + w1 * bfhi(bq[e]) + w2 * bfhi(c[e]));
        *(u32x4_t*)(Yo + (size_t)t * 1024 + c8) = o;
    }
}

constexpr size_t TABB_WSB = 1280 * 1024, TABB_PWT = TABB_WSB + 4 * 128 * 128 * 2;
constexpr int EM_AL = RTILE, EM_DL = RTILE + 144 * RP;
__device__ __forceinline__ void even_mix_units(LAS unsigned char* lds, const bf16_t* Z0, const float* ssv, const bf16_t* WSB, const bf16_t* PWT, const float* sgu_norm, const float* sgu_b, bf16_t* Yo) {
    const int tid = opaque_tid(), lane = tid & 63, r = lane & 15, qp = lane >> 4;
    const int wave = __builtin_amdgcn_readfirstlane(tid >> 6);
    LAS unsigned char* VT = lds; LAS unsigned char* AL = lds + EM_AL; LAS unsigned char* DL = lds + EM_DL;
    for (int unit = blockIdx.x; unit < 2048; unit += gridDim.x) {
        const int chunk = unit >> 2, g = unit & 3, tok0 = chunk * 128, pos0 = tok0 & 2047, win = 2 << g;
        __syncthreads();
        for (int it = tid; it < 2048; it += 512) {
            const int row = it & 127, c8 = (it >> 7) * 8;
            const float rs = row_rstd(ssv, 8, tok0 + row, 1.0f / 512.0f);
            const u32x4_t a = *(const u32x4_t*)(Z0 + (size_t)(tok0 + row) * EVEN_IN + 1024 + g * 128 + c8);
#pragma unroll
            for (int e = 0; e < 4; ++e) {
                *(LAS unsigned short*)(VT + (c8 + 2 * e) * RP + row * 2) = f2bf(bflo(a[e]) * rs);
                *(LAS unsigned short*)(VT + (c8 + 2 * e + 1) * RP + row * 2) = f2bf(bfhi(a[e]) * rs);
            }
        }
        for (int it = tid; it < 143 * 16; it += 512) {
            const int rr = it >> 4, c8 = (it & 15) * 8;
            const bool valid = pos0 - 15 + rr >= 0;
            u32x4_t a = *(const u32x4_t*)(Z0 + (size_t)(valid ? tok0 - 15 + rr : tok0) * EVEN_IN + g * 128 + c8);
            if (!valid) a = (u32x4_t){0u, 0u, 0u, 0u};
            *(LAS u32x4_t*)(AL + rr * RP + c8 * 2) = a;
        }
        __syncthreads();
        for (int it = tid; it < 2048; it += 512) {
            const int t = it >> 4, c8 = (it & 15) * 8;
            float sum[8];
#pragma unroll
            for (int e = 0; e < 8; ++e) sum[e] = 0.f;
            for (int jj = 0; jj < win; ++jj) {
                const u32x4_t a = *(const LAS u32x4_t*)(AL + (t + 15 - jj) * RP + c8 * 2);
#pragma unroll
                for (int e = 0; e < 4; ++e) { sum[2 * e] += bflo(a[e]); sum[2 * e + 1] += bfhi(a[e]); }
            }
            const u32x4_t cur = *(const LAS u32x4_t*)(AL + (t + 15) * RP + c8 * 2);
            const float ic = 1.0f / (float)min(pos0 + t + 1, win);
            u32x4_t w;
#pragma unroll
            for (int e = 0; e < 4; ++e) w[e] = cvt_pk_bf16(sum[2 * e] * ic - bflo(cur[e]), sum[2 * e + 1] * ic - bfhi(cur[e]));
            *(LAS u32x4_t*)(DL + t * RP + c8 * 2) = w;
        }
        __syncthreads();
        {
            f32x4 acc[8];
#pragma unroll
            for (int nt = 0; nt < 8; ++nt) acc[nt] = (f32x4){0.f, 0.f, 0.f, 0.f};
#pragma unroll
            for (int ks = 0; ks < 4; ++ks) {
                if (32 * ks <= 16 * wave + 15) {
                    const bf16x8_t a = *(const bf16x8_t*)(WSB + (size_t)g * 16384 + (16 * wave + r) * 128 + 32 * ks + 8 * qp);
#pragma unroll
                    for (int nt = 0; nt < 8; ++nt) {
                        const bf16x8_t bv = *(const LAS bf16x8_t*)(VT + (16 * nt + r) * RP + (32 * ks + 8 * qp) * 2);
                        acc[nt] = __builtin_amdgcn_mfma_f32_16x16x32_bf16(a, bv, acc[nt], 0, 0, 0);
                    }
                }
            }
#pragma unroll
            for (int j = 0; j < 4; ++j) {
                const int t = 16 * wave + 4 * qp + j;
                const float bb = sgu_b[g * 128 + t];
                const bf16_t* up = Z0 + (size_t)(tok0 + t) * EVEN_IN + 512 + g * 128 + r;
                bf16_t* yp = Yo + (size_t)(tok0 + t) * 1024 + 512 + g * 128 + r;
#pragma unroll
                for (int nt = 0; nt < 8; ++nt) yp[16 * nt] = f2bf(bf2f(up[16 * nt]) * (acc[nt][j] * sgu_norm[g * 128 + 16 * nt + r] + bb));
            }
        }
        {
            f32x4 acc[8];
#pragma unroll
            for (int nt = 0; nt < 8; ++nt) acc[nt] = (f32x4){0.f, 0.f, 0.f, 0.f};
#pragma unroll
            for (int ks = 0; ks < 4; ++ks) {
                const bf16x8_t a = *(const LAS bf16x8_t*)(DL + (16 * wave + r) * RP + (32 * ks + 8 * qp) * 2);
#pragma unroll
                for (int nt = 0; nt < 8; ++nt) {
                    const bf16x8_t bv = *(const bf16x8_t*)(PWT + (size_t)g * 16384 + (16 * nt + r) * 128 + 32 * ks + 8 * qp);
                    acc[nt] = __builtin_amdgcn_mfma_f32_16x16x32_bf16(a, bv, acc[nt], 0, 0, 0);
                }
            }
#pragma unroll
            for (int j = 0; j < 4; ++j) {
                bf16_t* yp = Yo + (size_t)(tok0 + 16 * wave + 4 * qp + j) * 1024 + g * 128 + r;
#pragma unroll
                for (int nt = 0; nt < 8; ++nt) yp[16 * nt] = f2bf(acc[nt][j]);
            }
        }
    }
    __syncthreads();
}
#define PHASE_IDS() const int tid = opaque_tid(), lane = tid & 63, wave = tid >> 6; const int gw = blockIdx.x * 8 + wave, nw = gridDim.x * 8; const int gt = blockIdx.x * 512 + tid, nt = gridDim.x * 512; (void)lane; (void)gw; (void)nw; (void)gt; (void)nt;
#include <vector>

#define XB_TMO      128
#define XB_XCNT(j)  (256  + 64 * (j))
#define XB_XSUB(j)  (1280 + 64 * (j))
#define XB_XGEN(j)  (2304 + 64 * (j))
#define XB_TOP      3328
#define XB_TOPGEN   3392
#define XCD_BAR_WORDS 3456
#define XB_SPIN_CAP (1u << 18)

__device__ __forceinline__ unsigned xb_ld(unsigned* p)              { return __hip_atomic_load(p, __ATOMIC_RELAXED, __HIP_MEMORY_SCOPE_AGENT); }
__device__ __forceinline__ unsigned xb_add(unsigned* p, unsigned v) { return __hip_atomic_fetch_add(p, v, __ATOMIC_RELAXED, __HIP_MEMORY_SCOPE_AGENT); }
__device__ __forceinline__ unsigned xb_xcc_id() { return (unsigned)__builtin_amdgcn_s_getreg((3 << 11) | 20) & 0xFu; }
#define XB_SPIN(cond, bar) do { unsigned _sp = 0; while (cond) { __builtin_amdgcn_s_sleep(1); \
    if ((++_sp & 255u) == 0u) { if (xb_ld(&(bar)[XB_TMO])) break; if (_sp > XB_SPIN_CAP) { atomicAdd(&(bar)[XB_TMO], 1u); break; } } } } while (0)

struct XcdBarrier {
    unsigned* bar; unsigned x;
    volatile LAS unsigned* st;
};

__device__ __forceinline__ XcdBarrier xcd_barrier_post(unsigned* bar, volatile LAS unsigned* st) {
    XcdBarrier b; b.bar = bar; b.x = xb_xcc_id(); b.st = st;
    if (threadIdx.x == 0) (void)xb_add(&bar[XB_XCNT(b.x)], 1u);
    return b;
}
__device__ __forceinline__ void xcd_barrier_complete(unsigned* bar, unsigned x, unsigned& nloc, unsigned& nx) {
    const unsigned G = gridDim.x * gridDim.y * gridDim.z;
    unsigned sum, cnt, mine, sp = 0u;
    for (;;) {
        sum = 0u; cnt = 0u; mine = 0u;
#pragma unroll
        for (unsigned j = 0; j < 16; ++j) { const unsigned c = xb_ld(&bar[XB_XCNT(j)]); sum += c; cnt += (c > 0u) ? 1u : 0u; mine = (j == x) ? c : mine; }
        if (sum == G) break;
        __builtin_amdgcn_s_sleep(1);
        if ((++sp & 255u) == 0u) { if (xb_ld(&bar[XB_TMO])) break; if (sp > XB_SPIN_CAP) { atomicAdd(&bar[XB_TMO], 1u); break; } }
    }
    nloc = mine > 0u ? mine : 1u; nx = cnt > 0u ? cnt : 1u;
}

__device__ __forceinline__ void xcd_barrier(const XcdBarrier& b) {
    asm volatile("s_waitcnt vmcnt(0)" ::: "memory");
    __syncthreads();
    if (threadIdx.x == 0) {
        unsigned* bar = b.bar;
        __builtin_amdgcn_s_waitcnt(0);
        unsigned nloc = b.st[0], nx = b.st[1];
        if (nloc == 0u) { xcd_barrier_complete(bar, b.x, nloc, nx); b.st[0] = nloc; b.st[1] = nx; }
        const unsigned old = xb_add(&bar[XB_XSUB(b.x)], 1u);
        const unsigned gen = old / nloc;
        if (old + 1u == (gen + 1u) * nloc) {
            __builtin_amdgcn_fence(__ATOMIC_RELEASE, "agent");
            asm volatile("s_waitcnt vmcnt(0)" ::: "memory");
            const unsigned og = xb_add(&bar[XB_TOP], 1u);
            const unsigned tg = og / nx;
            if (og + 1u == (tg + 1u) * nx) xb_add(&bar[XB_TOPGEN], 1u);
            else XB_SPIN(xb_ld(&bar[XB_TOPGEN]) == tg, bar);
            __builtin_amdgcn_fence(__ATOMIC_ACQUIRE, "agent");
            xb_add(&bar[XB_XGEN(b.x)], 1u);
            asm volatile("s_waitcnt vmcnt(0)" ::: "memory");
        } else {
            XB_SPIN(xb_ld(&bar[XB_XGEN(b.x)]) == gen, bar);
            __builtin_amdgcn_fence(__ATOMIC_ACQUIRE, "agent");
            asm volatile("s_waitcnt vmcnt(0)" ::: "memory");
        }
    }
    __syncthreads();
}


#ifndef REP_GEMM
#define REP_GEMM 1
#endif
#ifndef REP_EM
#define REP_EM 1
#endif
#ifndef REP_DIL
#define REP_DIL 1
#endif
#ifndef REP_R1
#define REP_R1 1
#endif
#ifndef REP_R3
#define REP_R3 1
#endif
#ifndef REP_PRO
#define REP_PRO 1
#endif
#ifndef REP_SYNC
#define REP_SYNC 1
#endif
#define GSYNC() do { for (int rep_ = 0; rep_ < REP_SYNC; ++rep_) xcd_barrier(xb); } while (0)
constexpr int LDS_BYTES = 144 * 1024;

__global__ void __launch_bounds__(512) fwd_mega(Params p) {
    __shared__ __attribute__((aligned(16))) unsigned char lds_raw[LDS_BYTES];
    LAS unsigned char* lds = (LAS unsigned char*)lds_raw;
    cg::grid_group grid = cg::this_grid();
    __shared__ uint4 xb_words;
    if (threadIdx.x == 0) xb_words = make_uint4(0u, 0u, 0u, 0u);
    __syncthreads();
    const XcdBarrier xb = xcd_barrier_post((unsigned*)(p.ws + WS_BAR), (volatile LAS unsigned*)&xb_words);
    unsigned* XR = (unsigned*)(p.ws + WS_BAR) + XCD_BAR_WORDS;
    unsigned myrank = 0u;
    if (threadIdx.x == 0) { myrank = __hip_atomic_fetch_add(&XR[64 * xb.x], 1u, __ATOMIC_RELAXED, __HIP_MEMORY_SCOPE_AGENT); g_vblk = (int)blockIdx.x; }
    __syncthreads();
    const float* x = p.in[0]; const float* mem = p.in[1];
    const float* even_mix_norm = p.in[2]; const float* even_w_in = p.in[3]; const float* pool_w = p.in[4]; const float* pool_scale = p.in[5];
    const float* sgu_norm = p.in[6]; const float* sgu_w = p.in[7]; const float* sgu_b = p.in[8]; const float* even_w_out = p.in[9];
    const float* odd_mix_norm = p.in[10]; const float* odd_w_in = p.in[11]; const float* odd_w_out = p.in[12];
    const float* xattn_norm = p.in[13]; const float* mem_norm = p.in[14]; const float* xattn_wq = p.in[15]; const float* xattn_wkv = p.in[16]; const float* xattn_wo = p.in[17];
    const float* ffn_norm = p.in[18]; const float* ffn_w_gate_up = p.in[19]; const float* ffn_w_down = p.in[20]; const float* final_norm = p.in[21];
    float* H = p.out;
    bf16_t* HB = (bf16_t*)(p.ws + WS_HB); bf16_t* Z = (bf16_t*)(p.ws + WS_Z); bf16_t* Y = (bf16_t*)(p.ws + WS_Y); bf16_t* WB = (bf16_t*)(p.ws + WS_W);
    bf16_t* MEMN = (bf16_t*)(p.ws + WS_MEMN); bf16_t* KV = (bf16_t*)(p.ws + WS_KV); float* SS = (float*)(p.ws + WS_SS); float* TAB = (float*)(p.ws + WS_TAB); float* SD = (float*)(p.ws + WS_SIDE); bf16_t* RET = (bf16_t*)(p.ws + WS_RET); LAS float* sred = (LAS float*)lds;

    for (int rep_ = 0; rep_ < REP_PRO; ++rep_) {
        LAS float* tile = (LAS float*)lds;
        conv_weight(even_w_in, even_mix_norm, WB + W_EIN, 1024, EVEN_IN, EVEN_IN, 0, tile);
        conv_weight(even_w_out, nullptr, WB + W_EOUT, 1024, 1024, 1024, 0, tile);
        conv_weight(odd_w_in, odd_mix_norm, WB + W_OIN, 1024, ODD_IN, ODD_IN, 1, tile);
        conv_weight(odd_w_out, nullptr, WB + W_OOUT, 1024, 1024, 1024, 0, tile);
        for (int l = 0; l < 2; ++l) {
            bf16_t* wl = WB + W_L0 + (size_t)l * WL_SIZE;
            conv_weight(xattn_wq + (size_t)l * 1024 * 1024, xattn_norm + l * 1024, wl + WL_Q, 1024, 1024, 1024, 2, tile);
            conv_weight(xattn_wkv + (size_t)l * 1024 * 2048, nullptr, wl + WL_KV, 1024, 2048, 2048, 0, tile);
            conv_weight(xattn_wo + (size_t)l * 1024 * 1024, nullptr, wl + WL_O, 1024, 1024, 1024, 0, tile);
            conv_weight(ffn_w_gate_up + (size_t)l * 1024 * GU, ffn_norm + l * 1024, wl + WL_GU, 1024, GU, GU, 3, tile);
            conv_weight(ffn_w_down + (size_t)l * DFF * 1024, nullptr, wl + WL_DN, DFF, 1024, 1024, 0, tile);
        }
        PHASE_IDS();
        for (int row0 = gw * 4; row0 < T; row0 += nw * 4) {
            float4 v[4][4];
#pragma unroll
            for (int rr = 0; rr < 4; ++rr)
#pragma unroll
                for (int i = 0; i < 4; ++i) v[rr][i] = ((const float4*)(x + (size_t)(row0 + rr) * 1024))[lane + 64 * i];
#pragma unroll
            for (int rr = 0; rr < 4; ++rr) {
                float s = 0.f;
#pragma unroll
                for (int i = 0; i < 4; ++i) {
                    const float4 q = v[rr][i];
                    s += (q.x * q.x + q.y * q.y) + (q.z * q.z + q.w * q.w);
                    uint2 w; w.x = cvt_pk_bf16(q.x, q.y); w.y = cvt_pk_bf16(q.z, q.w);
                    *(uint2*)(HB + (size_t)(row0 + rr) * 1024 + 4 * (lane + 64 * i)) = w;
                }
                s = wave_sum(s);
                if (lane < 4) SS[(size_t)(row0 + rr) * 16 + lane] = (lane == 0) ? s : 0.f;
            }
        }
        for (int row = gw; row < MROWS; row += nw) {
            const float4* xr = (const float4*)(mem + (size_t)row * 1024);
            float4 v[4]; float s = 0.f;
#pragma unroll
            for (int i = 0; i < 4; ++i) { v[i] = xr[lane + 64 * i]; s += (v[i].x * v[i].x + v[i].y * v[i].y) + (v[i].z * v[i].z + v[i].w * v[i].w); }
            s = wave_sum(s);
            const float rs = rsqrtf(s * (1.0f / 1024.0f) + 1e-6f);
#pragma unroll
            for (int l = 0; l < 2; ++l)
#pragma unroll
                for (int i = 0; i < 4; ++i) {
                    const float4 g = *(const float4*)(mem_norm + l * 1024 + 4 * (lane + 64 * i));
                    uint2 w; w.x = cvt_pk_bf16(v[i].x * rs * g.x, v[i].y * rs * g.y); w.y = cvt_pk_bf16(v[i].z * rs * g.z, v[i].w * rs * g.w);
                    *(uint2*)(MEMN + (size_t)l * MROWS * 1024 + (size_t)row * 1024 + 4 * (lane + 64 * i)) = w;
                }
        }
        for (int i = gt; i < 32 * 1024; i += nt) { const int b = i >> 10, k = i & 1023; SD[SD_H + k * 32 + b] = x[(size_t)b * 2048 * 1024 + k]; }
        {
            bf16_t* WSBw = (bf16_t*)(p.ws + WS_TAB + TABB_WSB); bf16_t* PWTw = (bf16_t*)(p.ws + WS_TAB + TABB_PWT);
            for (int i = gt; i < 4 * 128 * 128; i += nt) {
                const int g = i >> 14, a = (i >> 7) & 127, c = i & 127;
                WSBw[i] = f2bf(c <= a ? sgu_w[i] : 0.f);
                PWTw[i] = f2bf(pool_w[(size_t)g * 16384 + c * 128 + a] * pool_scale[g * 128 + a]);
            }
        }
        for (int i = gt; i < 2048 * 8; i += nt) { float s, c; sincos_d((double)(i >> 3) * p.inv_dil[i & 7], s, c); TAB[TAB_DC + i] = c; TAB[TAB_DS + i] = s; }
        for (int i = gt; i < 2048 * 64; i += nt) { float s, c; sincos_d((double)(i >> 6) * p.inv_ret[i & 63], s, c); TAB[TAB_RC + i] = c; TAB[TAB_RS + i] = s; }
    }
    grid.sync();
    if (threadIdx.x == 0) {
        bool okc = (gridDim.x % 8u) == 0u && xb.x < 8u; const unsigned per = gridDim.x / 8u;
        for (int j = 0; j < 16; ++j) { const unsigned cj = __hip_atomic_load(&XR[64 * j], __ATOMIC_RELAXED, __HIP_MEMORY_SCOPE_AGENT); okc = okc && (cj == (j < 8 ? per : 0u)); }
        g_vblk = okc ? (int)(myrank * 8u + xb.x) : (int)blockIdx.x;
    }
    __syncthreads();

    {
        side_rstd(SD + SD_H, 1024, 1.0f / 1024.0f, sred);
        InPlain in{SD + SD_H, even_mix_norm}; EpStore ep{SD + SD_Z, sred + SRED_RSTD, 1.0f, 1};
        side_gemv(even_w_in + 512, EVEN_IN, 1024, 1024, in, ep, sred);
    }
    for (int g4 = 0; g4 < 4; ++g4) {
        const int l = g4 >> 1, isv = g4 & 1;
        const bf16_t* mn = MEMN + (size_t)l * MROWS * 1024; const bf16_t* wk = WB + W_L0 + (size_t)l * WL_SIZE + WL_KV;
        Epi<EP_PLAIN> E{KV + (size_t)l * MROWS * 2048 + (size_t)isv * MROWS * 1024, isv ? MROWS : 1024, nullptr, 0, nullptr, nullptr, nullptr};
        for (int rep_ = 0; rep_ < REP_GEMM; ++rep_) run_gemm<EP_PLAIN>(lds, isv ? wk + (size_t)1024 * 1024 : mn, isv ? mn : wk, isv ? 1024 : MROWS, isv ? MROWS : 1024, 1024, E, isv ? (int)(gridDim.x >> 1) : 0);
    }

    for (int layer = 0; layer < 2; ++layer) {
        const bf16_t* wl = WB + W_L0 + (size_t)layer * WL_SIZE;
        float* ss_base = SS + (size_t)(layer * 3 + 2) * SS_STRIDE;
        const float* ss_prev = (layer == 0) ? SS : SS + (size_t)4 * SS_STRIDE;
        const int ns_prev = (layer == 0) ? 4 : 16;
        if (layer == 0) {
            { Epi<EP_EVEN_IN> E{Z, EVEN_IN, ss_prev, ns_prev, nullptr, nullptr, SS + SS_STRIDE};
              for (int rep_ = 0; rep_ < REP_GEMM; ++rep_) run_gemm<EP_EVEN_IN>(lds, HB, WB + W_EIN, T, EVEN_IN, 1024, E); }
            GSYNC();
            {
                side_rstd(SD + SD_Z + 512 * 32, 512, 1.0f / 512.0f, sred);
                InSgu in{SD + SD_Z, sgu_w, sgu_b, sgu_norm, sred + SRED_RSTD};
                side_gemv_ks(even_w_out + (size_t)512 * 1024, 1024, 512, 1024, in, SD + SD_H, sred);
            }
            for (int rep_ = 0; rep_ < REP_EM; ++rep_) even_mix_units(lds, Z, SS + SS_STRIDE, (const bf16_t*)(p.ws + WS_TAB + TABB_WSB), (const bf16_t*)(p.ws + WS_TAB + TABB_PWT), sgu_norm, sgu_b, Y);
            GSYNC();
        } else {
            {
                side_rstd(SD + SD_H, 1024, 1.0f / 1024.0f, sred);
                InPlain in{SD + SD_H, ffn_norm}; EpStore ep{SD + SD_Z, sred + SRED_RSTD, 1.0f, 0};
                side_gemv(ffn_w_gate_up, GU, 1024, GU, in, ep, sred);
            }
            { Epi<EP_ODD_IN> E{Z, ODD_IN, ss_prev, ns_prev, nullptr, nullptr, nullptr};
              for (int rep_ = 0; rep_ < REP_GEMM; ++rep_) run_gemm<EP_ODD_IN>(lds, HB, WB + W_OIN, T, ODD_IN, 1024, E); }
            GSYNC();
            {
                InSwiglu in{SD + SD_Z};
                side_gemv_ks(ffn_w_down, 1024, DFF, 1024, in, SD + SD_H, sred);
            }
            for (int rep_ = 0; rep_ < REP_R1; ++rep_) ret_r1(lds, Z, TAB, RET);
            for (int rep_ = 0; rep_ < REP_DIL; ++rep_) dil_units(lds, Z, TAB, (bf16_t*)H, Y, SS + (size_t)6 * SS_STRIDE);
            GSYNC();
            {
                side_rstd(SD + SD_H, 1024, 1.0f / 1024.0f, sred);
                InPlain in{SD + SD_H, odd_mix_norm}; EpStore ep{SD + SD_Z, sred + SRED_RSTD, 1.0f, 0};
                side_gemv(odd_w_in + 1536, ODD_IN, 1024, 1024, in, ep, sred);
            }
            dil_combine((const bf16_t*)H, Y, SS + (size_t)6 * SS_STRIDE);
            ret_r2(RET);
            GSYNC();
            for (int rep_ = 0; rep_ < REP_R3; ++rep_) ret_r3(lds, Z, TAB, RET, SD + SD_Z, Y);
            GSYNC();
        }

        for (int sub = 0; sub < 3; ++sub) {
            const bf16_t* A = Y; const bf16_t* Bt = (layer == 0) ? (WB + W_EOUT) : (WB + W_OOUT); int K = 1024;
            if (sub == 1) {
                if (layer == 0) {
                PHASE_IDS();
                for (int item = gw; item < 4096; item += nw) {
                    const int i = item >> 2, h = item & 3;
                    const float4 w = *(const float4*)(xattn_wkv + (size_t)i * 2048 + h * 256 + lane * 4);
                    const float* qb = SD + SD_Q + (size_t)(h * 256 + lane * 4) * 32;
                    float mine = 0.f;
#pragma unroll
                    for (int b4 = 0; b4 < 8; ++b4) {
                        const float4 q0 = *(const float4*)(qb + b4 * 4), q1 = *(const float4*)(qb + 32 + b4 * 4), q2 = *(const float4*)(qb + 64 + b4 * 4), q3 = *(const float4*)(qb + 96 + b4 * 4);
                        const float s0 = wave_sum((w.x * q0.x + w.y * q1.x) + (w.z * q2.x + w.w * q3.x)), s1 = wave_sum((w.x * q0.y + w.y * q1.y) + (w.z * q2.y + w.w * q3.y));
                        const float s2 = wave_sum((w.x * q0.z + w.y * q1.z) + (w.z * q2.z + w.w * q3.z)), s3 = wave_sum((w.x * q0.w + w.y * q1.w) + (w.z * q2.w + w.w * q3.w));
                        if (lane == b4 * 4 + 0) mine = s0; if (lane == b4 * 4 + 1) mine = s1; if (lane == b4 * 4 + 2) mine = s2; if (lane == b4 * 4 + 3) mine = s3;
                    }
                    if (lane < 32) SD[SD_R + (size_t)(lane * 4 + h) * 1024 + i] = mine;
                }
            }
                { Epi<EP_SCALE> E{Y, 1024, ss_base, 16, nullptr, nullptr, nullptr};
                  for (int rep_ = 0; rep_ < REP_GEMM; ++rep_) run_gemm<EP_SCALE>(lds, HB, wl + WL_Q, T, 1024, 1024, E); }
                GSYNC();
                if (layer == 0) {
                    PHASE_IDS();
                    for (int item = gw; item < 8192; item += nw) {
                        const int b = item >> 8;
                        const float4* mr = (const float4*)(mem + (size_t)item * 1024);
                        float ssq = 0.f, a0 = 0.f, a1 = 0.f, a2 = 0.f, a3 = 0.f;
#pragma unroll
                        for (int q = 0; q < 4; ++q) {
                            const int idx = lane + 64 * q;
                            const float4 m = mr[idx], g = ((const float4*)mem_norm)[idx];
                            ssq += (m.x * m.x + m.y * m.y) + (m.z * m.z + m.w * m.w);
                            const float4 mg = make_float4(m.x * g.x, m.y * g.y, m.z * g.z, m.w * g.w);
                            const float4 r0 = ((const float4*)(SD + SD_R + (size_t)(b * 4 + 0) * 1024))[idx], r1 = ((const float4*)(SD + SD_R + (size_t)(b * 4 + 1) * 1024))[idx];
                            const float4 r2 = ((const float4*)(SD + SD_R + (size_t)(b * 4 + 2) * 1024))[idx], r3 = ((const float4*)(SD + SD_R + (size_t)(b * 4 + 3) * 1024))[idx];
                            a0 += (mg.x * r0.x + mg.y * r0.y) + (mg.z * r0.z + mg.w * r0.w); a1 += (mg.x * r1.x + mg.y * r1.y) + (mg.z * r1.z + mg.w * r1.w);
                            a2 += (mg.x * r2.x + mg.y * r2.y) + (mg.z * r2.z + mg.w * r2.w); a3 += (mg.x * r3.x + mg.y * r3.y) + (mg.z * r3.z + mg.w * r3.w);
                        }
                        ssq = wave_sum(ssq); a0 = wave_sum(a0); a1 = wave_sum(a1); a2 = wave_sum(a2); a3 = wave_sum(a3);
                        const float rs = rsqrtf(ssq * (1.0f / 1024.0f) + 1e-6f);
                        if (lane == 0) { const int j = item & 255; float* pp = SD + SD_P + (size_t)b * 4 * 256 + j; pp[0] = a0 * rs; pp[256] = a1 * rs; pp[512] = a2 * rs; pp[768] = a3 * rs; SD[SD_M + item] = rs; }
                    }
                }
                xattn_phase(lds, Y, KV + (size_t)layer * MROWS * 2048, KV + (size_t)layer * MROWS * 2048 + (size_t)MROWS * 1024);
                GSYNC();
                Bt = wl + WL_O;
            } else if (sub == 2) {
                if (layer == 0) {
                InHead in{SD + SD_T}; EpStore ep{SD + SD_O, nullptr, 1.0f, 0};
                side_gemv(xattn_wkv + 1024, 2048, 1024, 1024, in, ep, sred);
            }
                { Epi<EP_GU> E{Z, DFF, ss_base + SS_STRIDE, 16, nullptr, nullptr, nullptr};
                  for (int rep_ = 0; rep_ < REP_GEMM; ++rep_) run_gemm<EP_GU>(lds, HB, wl + WL_GU, T, GU, 1024, E); }
                GSYNC();
                A = Z; Bt = wl + WL_DN; K = DFF;
            }
            if (layer == 0 && sub == 0) {
                side_rstd(SD + SD_H, 1024, 1.0f / 1024.0f, sred);
                InPlain in{SD + SD_H, xattn_norm}; EpStore ep{SD + SD_Q, sred + SRED_RSTD, 0.0625f, 0};
                side_gemv(xattn_wq, 1024, 1024, 1024, in, ep, sred);
            }
            if (layer == 0 && sub == 1) {
                    PHASE_IDS();
                    LAS float* pl = sred; LAS float* prt = sred + 1024;
                    for (int item = blockIdx.x; item < 256; item += gridDim.x) {
                        const int b = item >> 3, il = tid & 127, i = (item & 7) * 128 + il, jg = tid >> 7;
                        if (wave < 4) {
                            const float* sp = SD + SD_P + (size_t)(b * 4 + wave) * 256;
                            float e0 = sp[lane], e1 = sp[lane + 64], e2 = sp[lane + 128], e3 = sp[lane + 192];
                            const float mx = wave_max(fmaxf(fmaxf(e0, e1), fmaxf(e2, e3)));
                            e0 = __expf(e0 - mx); e1 = __expf(e1 - mx); e2 = __expf(e2 - mx); e3 = __expf(e3 - mx);
                            const float inv = 1.0f / wave_sum((e0 + e1) + (e2 + e3));
                            const float* rm = SD + SD_M + b * 256;
                            pl[wave * 256 + lane] = e0 * inv * rm[lane]; pl[wave * 256 + lane + 64] = e1 * inv * rm[lane + 64];
                            pl[wave * 256 + lane + 128] = e2 * inv * rm[lane + 128]; pl[wave * 256 + lane + 192] = e3 * inv * rm[lane + 192];
                        }
                        __syncthreads();
                        float t0 = 0.f, t1 = 0.f, t2 = 0.f, t3 = 0.f;
                        const float* mc = mem + (size_t)b * 256 * 1024 + (size_t)(jg * 64) * 1024 + i;
#pragma unroll 16
                        for (int j = 0; j < 64; ++j) { const float m = mc[(size_t)j * 1024]; const int jj = jg * 64 + j; t0 += pl[jj] * m; t1 += pl[256 + jj] * m; t2 += pl[512 + jj] * m; t3 += pl[768 + jj] * m; }
                        prt[(jg * 4 + 0) * 128 + il] = t0; prt[(jg * 4 + 1) * 128 + il] = t1; prt[(jg * 4 + 2) * 128 + il] = t2; prt[(jg * 4 + 3) * 128 + il] = t3;
                        __syncthreads();
                        {
                            const int hh = tid >> 7;
                            const float tsum = (prt[(0 * 4 + hh) * 128 + il] + prt[(1 * 4 + hh) * 128 + il]) + (prt[(2 * 4 + hh) * 128 + il] + prt[(3 * 4 + hh) * 128 + il]);
                            SD[SD_T + ((size_t)hh * 1024 + i) * 32 + b] = tsum * mem_norm[i];
                        }
                        __syncthreads();
                    }
                }
            if (layer == 0 && sub == 2) {
                    InPlain in{SD + SD_O, nullptr};
                    side_gemv_ks(xattn_wo, 1024, 1024, 1024, in, SD + SD_H, sred);
                }
            { Epi<EP_RES> E{HB, 1024, nullptr, 0, HB, nullptr, ss_base + (size_t)sub * SS_STRIDE};
              run_gemm<EP_RES>(lds, A, Bt, T, 1024, K, E); }
            GSYNC();
        }
    }

    {
        const float* ssf = SS + (size_t)7 * SS_STRIDE;
        PHASE_IDS();
        for (int row = gw; row < T; row += nw) {
            const float sp = (lane < 16) ? ssf[(size_t)row * 16 + lane] : 0.f;
            const float rs = rsqrtf(wave_sum(sp) * (1.0f / 1024.0f) + 1e-6f);
            float4* hr = (float4*)(H + (size_t)row * 1024);
            const uint2* hb = (const uint2*)(HB + (size_t)row * 1024);
#pragma unroll
            for (int i = 0; i < 4; ++i) {
                const uint2 q = hb[lane + 64 * i];
                const float4 g = ((const float4*)final_norm)[lane + 64 * i];
                float4 v; v.x = bflo(q.x) * rs * g.x; v.y = bfhi(q.x) * rs * g.y; v.z = bflo(q.y) * rs * g.z; v.w = bfhi(q.y) * rs * g.w;
                hr[lane + 64 * i] = v;
            }
        }
    }
}

extern "C" void kernel_launch(void* const* d_in, const int* in_sizes, int n_in, void* d_out, int out_size, void* d_ws, size_t ws_size, hipStream_t stream) {
    static int grid_blocks = 0;
    if (grid_blocks == 0) {
        if (n_in != 22 || out_size != T * DM || ws_size < WS_END) { fprintf(stderr, "kernel_launch: unexpected shapes (n_in %d, out %d, ws %zu)\n", n_in, out_size, ws_size); grid_blocks = -1; return; }
        int dev = 0, cus = 0, per_cu = 0;
        hipGetDevice(&dev);
        hipDeviceGetAttribute(&cus, hipDeviceAttributeMultiprocessorCount, dev);
        hipOccupancyMaxActiveBlocksPerMultiprocessor(&per_cu, fwd_mega, 512, 0);
        if (per_cu < 1) per_cu = 1;
        if (per_cu > 1) per_cu = 1;
        grid_blocks = cus * per_cu;
    }
    if (grid_blocks < 0) return;
    Params p;
    memset(&p, 0, sizeof(p));
    for (int i = 0; i < 22; ++i) p.in[i] = (const float*)d_in[i];
    p.out = (float*)d_out; p.ws = (unsigned char*)d_ws;
    for (int i = 0; i < 8; ++i) p.inv_dil[i] = std::exp(-((double)i / 8.0) * std::log(500000.0));
    for (int i = 0; i < 64; ++i) p.inv_ret[i] = std::exp(-((double)i / 64.0) * std::log(10000.0));
    (void)hipMemsetAsync((char*)d_ws + WS_BAR, 0, (XCD_BAR_WORDS + 16 * 64) * 4, stream);
    void* args[] = {&p};
    hipError_t e = hipLaunchCooperativeKernel((void*)fwd_mega, dim3(grid_blocks), dim3(512), args, 0, stream);
    if (e != hipSuccess) fprintf(stderr, "cooperative launch failed: %s (grid %d)\n", hipGetErrorString(e), grid_blocks);
}
```

```cpp
#include <hip/hip_runtime.h>
#include <hip/hip_cooperative_groups.h>
#include <cstdio>
#include <cmath>
namespace cg = cooperative_groups;
#include <cstring>
namespace pg8 {
#define PG8_LAS __attribute__((address_space(3)))
typedef unsigned short bf16_t;
typedef short bf16x8 __attribute__((ext_vector_type(8)));
typedef float f32x4 __attribute__((ext_vector_type(4)));
typedef unsigned u32x4 __attribute__((ext_vector_type(4)));
constexpr int BM = 256, BK = 64, HALF = 128, HTB = HALF * BK * 2  , STAGE_BYTES = 8 * HTB, NXCD = 8, WGM = 8;

__host__ __device__ __forceinline__ int lds_byte(int r, int c) { const int st = (r >> 4) * 2 + (c >> 5), rr = r & 15, cc = c & 31, ob = rr * 64 + cc * 2; return st * 1024 + (ob ^ (((ob >> 9) & 1) << 5)); }
__host__ __device__ __forceinline__ void stage_rc(int b, int& R, int& C) { const int st = b / 1024, sb = b % 1024, swz = sb ^ (((sb >> 9) & 1) << 5); R = (st >> 1) * 16 + swz / 64; C = (st & 1) * 32 + (swz % 64) / 2; }
__host__ __device__ __forceinline__ int perm32(int rho) { const int n = rho >> 4, i = rho & 15; return 8 * (i >> 2) + 4 * n + (i & 3); }

struct Unit { int pm, pn; };
struct Gemm { const bf16_t* A; const bf16_t* Bt; int M, N, K; };

struct StaticOrder {
    int nM, nN, nwg, G, c;
    __host__ __device__ void init(int M, int N, int G_, int c_) { nM = M / BM; nN = N / BM; nwg = nM * nN; G = G_; c = c_; }
    __host__ __device__ bool next(int i, Unit& u) const {
        const long L = (long)i * G + c; if (L >= nwg) return false;
        int wgid = (int)L; { const int q = nwg / NXCD, r = nwg % NXCD, xcd = wgid % NXCD, off = wgid / NXCD; wgid = (xcd < r ? xcd * (q + 1) : r * (q + 1) + (xcd - r) * q) + off; }
        const int nig = WGM * nN, gid = wgid / nig, fm = gid * WGM, gsz = (nM - fm) < WGM ? (nM - fm) : WGM;
        u.pm = fm + ((wgid % nig) % gsz); u.pn = (wgid % nig) / gsz; return true;
    }
    __device__ __forceinline__ void a_ready(const Unit&) const {}
    __device__ __forceinline__ void done(const Unit&) const {}
};
__device__ __forceinline__ unsigned cvt_pk_bf16(float lo, float hi) { unsigned r; asm volatile("v_cvt_pk_bf16_f32 %0, %1, %2" : "=v"(r) : "v"(lo), "v"(hi)); return r; }
typedef float f32x2 __attribute__((ext_vector_type(2)));
template <class Epi, class Sched, bool ALIGN_EPI = false, bool SP2 = false>
__device__ __forceinline__ void gemm_phase(PG8_LAS unsigned char* lds, const Gemm g, const Sched& S, const Epi& E) {
    int tid_o = threadIdx.x; asm volatile("" : "+v"(tid_o));
    const int tid = tid_o, wid = __builtin_amdgcn_readfirstlane(tid >> 6), lane = tid & 63, wr = wid >> 2, wc = wid & 3, fr = lane & 15, fq = lane >> 4;
    const int K = g.K, nt = K / BK;
    unsigned voffA[2], voffB[2];
#pragma unroll
    for (int i = 0; i < 2; ++i) { int R, C; stage_rc(tid * 16 + i * 8192, R, C); const int Rb = Epi::PERM ? ((R & ~31) + perm32(R & 31)) : R;
        voffA[i] = (unsigned)(R * K + C) * 2u; voffB[i] = (unsigned)(Rb * K + C) * 2u; }
    const size_t kstep = (size_t)(BK * 2);
    const size_t hstep = (size_t)HALF * K * 2;
    const size_t tstep = 2 * hstep;
    const unsigned ldsw = (unsigned)wid * 1024u;
    const int aoff = lds_byte(wr * 64 + fr, fq * 8), boff = lds_byte(wc * 32 + fr, fq * 8);
#define PG8_SA(b, h) (((b) * 2 + (h)) * HTB)
#define PG8_SB(b, h) ((4 + (b) * 2 + (h)) * HTB)
#define PG8_STAGE(bufoff, gbase, voff) do { const char* _gb = (const char*)(gbase); asm volatile("" : "+s"(_gb)); _Pragma("unroll") for (int _i = 0; _i < 2; ++_i) \
        __builtin_amdgcn_global_load_lds((const unsigned*)(_gb + (voff)[_i]), (PG8_LAS unsigned*)(lds + (bufoff) + ldsw + _i * 8192), 16, 0, 0); } while (0)
#define PG8_LDA(dst, b, h) do { _Pragma("unroll") for (int m = 0; m < 4; ++m) _Pragma("unroll") for (int k = 0; k < 2; ++k) dst[m][k] = *(const PG8_LAS bf16x8*)(lds + PG8_SA(b, h) + aoff + m * 2048 + k * 1024); } while (0)
#define PG8_LDB(dst, b, h) do { _Pragma("unroll") for (int n = 0; n < 2; ++n) _Pragma("unroll") for (int k = 0; k < 2; ++k) dst[n][k] = *(const PG8_LAS bf16x8*)(lds + PG8_SB(b, h) + boff + n * 2048 + k * 1024); } while (0)
#define PG8_MMA(ai, bj, At, Bt) do { __builtin_amdgcn_s_setprio(1); _Pragma("unroll") for (int m = 0; m < 4; ++m) _Pragma("unroll") for (int n = 0; n < 2; ++n) _Pragma("unroll") for (int k = 0; k < 2; ++k) \
        acc[ai][bj][m][n] = __builtin_amdgcn_mfma_f32_16x16x32_bf16(Bt[n][k], At[m][k], acc[ai][bj][m][n], 0, 0, 0); __builtin_amdgcn_s_setprio(0); } while (0)
#define PG8_WAIT_V(n) asm volatile("s_waitcnt vmcnt(" #n ")" ::: "memory")
#define PG8_WAIT_L(n) asm volatile("s_waitcnt lgkmcnt(" #n ")" ::: "memory")
#define PG8_BAR __builtin_amdgcn_s_barrier()
#define PG8_SCHED __builtin_amdgcn_sched_barrier(0)
    Unit cur, nxt; int ui = 0;
    if (!S.next(0, cur)) return;
    f32x4 acc[2][2][4][2];
#pragma unroll
    for (int a = 0; a < 2; ++a)
#pragma unroll
        for (int b = 0; b < 2; ++b)
#pragma unroll
            for (int m = 0; m < 4; ++m)
#pragma unroll
                for (int n = 0; n < 2; ++n) acc[a][b][m][n] = (f32x4){0.f, 0.f, 0.f, 0.f};
    bf16x8 At[4][2], B0[2][2], B1[2][2];
    const char* cA = (const char*)g.A + (size_t)cur.pm * tstep; const char* cB = (const char*)g.Bt + (size_t)cur.pn * tstep;
    S.a_ready(cur);
    if constexpr (SP2) {
        PG8_STAGE(PG8_SB(0, 0), cB, voffB); PG8_STAGE(PG8_SB(0, 1), cB + hstep, voffB); PG8_STAGE(PG8_SA(0, 0), cA, voffA); PG8_STAGE(PG8_SA(0, 1), cA + hstep, voffA);
        if (wr == 1) PG8_BAR;
        PG8_WAIT_V(2); PG8_BAR;
        PG8_STAGE(PG8_SB(1, 0), cB + kstep, voffB); PG8_STAGE(PG8_SA(1, 0), cA + kstep, voffA); PG8_STAGE(PG8_SB(1, 1), cB + hstep + kstep, voffB);
        PG8_WAIT_V(6); PG8_BAR;
    } else {
        PG8_STAGE(PG8_SB(0, 0), cB, voffB); PG8_STAGE(PG8_SA(0, 0), cA, voffA); PG8_STAGE(PG8_SB(0, 1), cB + hstep, voffB); PG8_STAGE(PG8_SA(0, 1), cA + hstep, voffA);
        if (wr == 1) PG8_BAR;
        PG8_WAIT_V(4); PG8_BAR;
        PG8_STAGE(PG8_SB(1, 0), cB + kstep, voffB); PG8_STAGE(PG8_SA(1, 0), cA + kstep, voffA); PG8_STAGE(PG8_SB(1, 1), cB + hstep + kstep, voffB);
        PG8_WAIT_V(6); PG8_BAR;
    }
    for (;;) {
        const bool has_next = S.next(ui + 1, nxt);
        const char* nA = has_next ? (const char*)g.A + (size_t)nxt.pm * tstep : cA; const char* nB = has_next ? (const char*)g.Bt + (size_t)nxt.pn * tstep : cB;
        for (int t = 0; t < nt; t += 2) {
            const bool last = (t == nt - 2);
            const char* a1 = cA + (size_t)(t + 1) * kstep;
            const char* a2 = last ? nA : cA + (size_t)(t + 2) * kstep; const char* b2 = last ? nB : cB + (size_t)(t + 2) * kstep;
            const char* a3 = a2 + kstep; const char* b3 = b2 + kstep;
            if (last && has_next) S.a_ready(nxt);
            if constexpr (SP2) {
            PG8_LDB(B0, 0, 0); PG8_LDB(B1, 0, 1); PG8_SCHED; PG8_LDA(At, 0, 0); PG8_STAGE(PG8_SA(1, 1), a1 + hstep, voffA);
            PG8_WAIT_V(8); PG8_WAIT_L(0); PG8_BAR; PG8_MMA(0, 0, At, B0); PG8_MMA(0, 1, At, B1); PG8_BAR; PG8_SCHED;
            PG8_LDA(At, 0, 1); PG8_STAGE(PG8_SB(0, 0), b2, voffB); PG8_STAGE(PG8_SB(0, 1), b2 + hstep, voffB); PG8_STAGE(PG8_SA(0, 0), a2, voffA);
            PG8_WAIT_V(8); PG8_WAIT_L(0); PG8_BAR; PG8_MMA(1, 0, At, B0); PG8_MMA(1, 1, At, B1); PG8_BAR; PG8_SCHED;
            PG8_LDB(B0, 1, 0); PG8_LDB(B1, 1, 1); PG8_SCHED; PG8_LDA(At, 1, 0); PG8_STAGE(PG8_SA(0, 1), a2 + hstep, voffA);
            PG8_WAIT_V(8); PG8_WAIT_L(0); PG8_BAR; PG8_MMA(0, 0, At, B0); PG8_MMA(0, 1, At, B1); PG8_BAR; PG8_SCHED;
            PG8_LDA(At, 1, 1); PG8_STAGE(PG8_SB(1, 0), b3, voffB); PG8_STAGE(PG8_SB(1, 1), b3 + hstep, voffB); PG8_STAGE(PG8_SA(1, 0), a3, voffA);
            PG8_WAIT_V(8); PG8_WAIT_L(0); PG8_BAR; PG8_MMA(1, 0, At, B0); PG8_MMA(1, 1, At, B1); PG8_BAR; PG8_SCHED;
            } else {
            PG8_LDB(B0, 0, 0); PG8_SCHED; PG8_LDA(At, 0, 0); PG8_STAGE(PG8_SA(1, 1), a1 + hstep, voffA);
            PG8_WAIT_L(8); PG8_BAR; PG8_WAIT_L(0); PG8_MMA(0, 0, At, B0); PG8_BAR; PG8_SCHED;
            PG8_LDB(B1, 0, 1); PG8_STAGE(PG8_SB(0, 0), b2, voffB);
            PG8_BAR; PG8_WAIT_L(0); PG8_MMA(0, 1, At, B1); PG8_BAR;
            PG8_LDA(At, 0, 1); PG8_STAGE(PG8_SA(0, 0), a2, voffA);
            PG8_BAR; PG8_WAIT_L(0); PG8_MMA(1, 0, At, B0); PG8_BAR; PG8_SCHED;
            PG8_STAGE(PG8_SB(0, 1), b2 + hstep, voffB);
            PG8_WAIT_V(6); PG8_BAR; PG8_MMA(1, 1, At, B1); PG8_BAR;
            PG8_LDB(B0, 1, 0); PG8_SCHED; PG8_LDA(At, 1, 0); PG8_STAGE(PG8_SA(0, 1), a2 + hstep, voffA);
            PG8_WAIT_L(8); PG8_BAR; PG8_WAIT_L(0); PG8_MMA(0, 0, At, B0); PG8_BAR; PG8_SCHED;
            PG8_LDB(B1, 1, 1); PG8_STAGE(PG8_SB(1, 0), b3, voffB);
            PG8_BAR; PG8_WAIT_L(0); PG8_MMA(0, 1, At, B1); PG8_BAR;
            PG8_LDA(At, 1, 1); PG8_STAGE(PG8_SA(1, 0), a3, voffA);
            PG8_BAR; PG8_WAIT_L(0); PG8_MMA(1, 0, At, B0); PG8_BAR; PG8_SCHED;
            PG8_STAGE(PG8_SB(1, 1), b3 + hstep, voffB);
            PG8_WAIT_V(6); PG8_BAR; PG8_MMA(1, 1, At, B1); PG8_BAR;
            }
        }
        if constexpr (ALIGN_EPI) { if (wr == 0) PG8_BAR; }
        if constexpr (!Epi::AFTER_DRAIN) { E(acc, cur, wr, wc, fr, fq); S.done(cur); }
        if (!has_next) break;
#pragma unroll
        for (int a = 0; a < 2; ++a)
#pragma unroll
            for (int b = 0; b < 2; ++b)
#pragma unroll
                for (int m = 0; m < 4; ++m)
#pragma unroll
                    for (int n = 0; n < 2; ++n) acc[a][b][m][n] = (f32x4){0.f, 0.f, 0.f, 0.f};
        cur = nxt; cA = nA; cB = nB; ++ui;
        if constexpr (ALIGN_EPI) { if (wr == 1) PG8_BAR; }
    }
    PG8_WAIT_V(0);
    if constexpr (!ALIGN_EPI) { if (wr == 0) PG8_BAR; }
    PG8_BAR;
    if constexpr (Epi::AFTER_DRAIN) { E.fused(acc, cur, wr, wc, fr, fq, lds, wid, lane); S.done(cur); }
#undef PG8_SA
#undef PG8_SB
#undef PG8_STAGE
#undef PG8_LDA
#undef PG8_LDB
#undef PG8_MMA
#undef PG8_WAIT_V
#undef PG8_WAIT_L
#undef PG8_BAR
#undef PG8_SCHED
}
}

using pg8::bf16_t; using pg8::f32x4; using pg8::Unit; using pg8::cvt_pk_bf16;
#define LAS __attribute__((address_space(3)))
constexpr int T = 65536, DM = 1024, SEQ = 2048, MROWS = 8192;
constexpr int EVEN_IN = 1536, ODD_IN = 3584, DFF = 2816, GU = 5632;
constexpr size_t MiB = 1024ull * 1024ull;
constexpr size_t WS_HB = 0, WS_Z = 128 * MiB, WS_Y = 576 * MiB, WS_W = 704 * MiB, WS_MEMN = 768 * MiB, WS_KV = 800 * MiB, WS_SS = 864 * MiB, WS_TAB = 896 * MiB, WS_SIDE = 898 * MiB, WS_RET = 906 * MiB, WS_BAR = 970 * MiB, WS_END = 971 * MiB;
constexpr size_t W_EIN = 0, W_EOUT = W_EIN + 1536ull * 1024, W_OIN = W_EOUT + 1024ull * 1024, W_OOUT = W_OIN + 3584ull * 1024, W_L0 = W_OOUT + 1024ull * 1024;
constexpr size_t WL_Q = 0, WL_KV = 1024ull * 1024, WL_O = WL_KV + 2048ull * 1024, WL_GU = WL_O + 1024ull * 1024, WL_DN = WL_GU + 5632ull * 1024, WL_SIZE = WL_DN + 1024ull * 2816;
static_assert((W_L0 + 2 * WL_SIZE) * 2 <= 64 * MiB, "weights region");
constexpr size_t SS_STRIDE = (size_t)T * 16;
constexpr size_t TAB_DC = 0, TAB_DS = 2048 * 8, TAB_RC = 2 * 2048 * 8, TAB_RS = TAB_RC + 2048 * 64;
constexpr size_t SD_H = 0, SD_Z = SD_H + 1024 * 32, SD_Q = SD_Z + 5632 * 32, SD_R = SD_Q + 1024 * 32, SD_P = SD_R + 32 * 4 * 1024, SD_M = SD_P + 32 * 4 * 256, SD_T = SD_M + 32 * 256, SD_O = SD_T + 4 * 1024 * 32, SD_END = SD_O + 1024 * 32;
static_assert(SD_END * 4 <= 8 * MiB, "side region");

typedef short bf16x8_t __attribute__((ext_vector_type(8)));
typedef unsigned u32x4_t __attribute__((ext_vector_type(4)));
typedef unsigned u32x2_t __attribute__((ext_vector_type(2)));
struct Params {
    const float* in[22];
    float* out;
    unsigned char* ws;
    double inv_dil[8];
    double inv_ret[64];
};

__device__ __forceinline__ int opaque_tid() { int t = threadIdx.x; asm volatile("" : "+v"(t)); return t; }
__device__ __forceinline__ int xcd_unit(int it, int total) {
    const int G = (int)gridDim.x, bx = (int)blockIdx.x;
    if ((G & 7) || (total & 7)) { const int u = it * G + bx; return u < total ? u : -1; }
    const int per = total >> 3, ny = G >> 3, idx = it * ny + (bx >> 3);
    return idx < per ? (bx & 7) * per + idx : -1;
}
#define LDS_BARRIER() do { asm volatile("s_waitcnt lgkmcnt(0)" ::: "memory"); __builtin_amdgcn_s_barrier(); asm volatile("" ::: "memory"); } while (0)
__device__ __forceinline__ float bf2f(unsigned short v) { return __uint_as_float((unsigned)v << 16); }
__device__ __forceinline__ float bflo(unsigned v) { return __uint_as_float(v << 16); }
__device__ __forceinline__ float bfhi(unsigned v) { return __uint_as_float(v & 0xffff0000u); }
__device__ __forceinline__ unsigned short f2bf(float f) { return (unsigned short)(cvt_pk_bf16(f, 0.f) & 0xffffu); }
__device__ __forceinline__ float dot8(const uint4 a, const uint4 b) {
    float s = bflo(a.x) * bflo(b.x); s += bfhi(a.x) * bfhi(b.x);
    s += bflo(a.y) * bflo(b.y); s += bfhi(a.y) * bfhi(b.y);
    s += bflo(a.z) * bflo(b.z); s += bfhi(a.z) * bfhi(b.z);
    s += bflo(a.w) * bflo(b.w); s += bfhi(a.w) * bfhi(b.w);
    return s;
}
__device__ __forceinline__ float wave_sum(float v) {
#pragma unroll
    for (int o = 32; o >= 1; o >>= 1) v += __shfl_xor(v, o);
    return v;
}
__device__ __forceinline__ float wave_max(float v) {
#pragma unroll
    for (int o = 32; o >= 1; o >>= 1) v = fmaxf(v, __shfl_xor(v, o));
    return v;
}
__device__ __forceinline__ float silu_f(float x) { return x * __builtin_amdgcn_rcpf(1.0f + __builtin_amdgcn_exp2f(-1.4426950408889634f * x)); }
__device__ __forceinline__ float gelu_tanh_f(float x) {
    const float y = 1.5957691216057308f * (x + 0.044715f * x * x * x);
    return x * __builtin_amdgcn_rcpf(1.0f + __builtin_amdgcn_exp2f(-1.4426950408889634f * y));
}
__device__ __forceinline__ float row_rstd(const float* ss, int nslot, int row, float inv_dim) {
    float s = 0.f;
    for (int i = 0; i < nslot; i += 4) { const float4 v = *(const float4*)(ss + (size_t)row * 16 + i); s += (v.x + v.y) + (v.z + v.w); }
    return rsqrtf(s * inv_dim + 1e-6f);
}
__device__ __forceinline__ float coop_rstd(const float* ss, int nslot, int row, int fq, float inv_dim) {
    float s = 0.f;
    if (4 * fq < nslot) { const float4 v = *(const float4*)(ss + (size_t)row * 16 + 4 * fq); s = (v.x + v.y) + (v.z + v.w); }
    s += __shfl_xor(s, 16); s += __shfl_xor(s, 32);
    return rsqrtf(s * inv_dim + 1e-6f);
}

enum { EP_EVEN_IN = 0, EP_RES = 1, EP_SCALE = 2, EP_GU = 3, EP_ODD_IN = 4, EP_PLAIN = 5 };
template <int MODE> struct Epi {
    static constexpr bool PERM = true, AFTER_DRAIN = false;
    bf16_t* O; int ldo;
    const float* ss_in; int ns_in;
    const bf16_t* res; float* hout;
    float* ss_out;
    __device__ __forceinline__ void operator()(const f32x4 (&acc)[2][2][4][2], const Unit& u, int wr, int wc, int fr_in, int fq_in) const {
        int fr = fr_in, fq = fq_in;
        asm volatile("" : "+v"(fr), "+v"(fq));
        const int row00 = u.pm * 256 + wr * 64 + fr;
        float rsv[2][4];
        if (MODE == EP_EVEN_IN || MODE == EP_SCALE || MODE == EP_GU || MODE == EP_ODD_IN) {
            float part[2][4];
#pragma unroll
            for (int ai = 0; ai < 2; ++ai)
#pragma unroll
                for (int m = 0; m < 4; ++m) {
                    float sp = 0.f;
                    if (4 * fq < ns_in) { const float4 v = *(const float4*)(ss_in + (size_t)(row00 + ai * 128 + m * 16) * 16 + 4 * fq); sp = (v.x + v.y) + (v.z + v.w); }
                    part[ai][m] = sp;
                }
#pragma unroll
            for (int ai = 0; ai < 2; ++ai)
#pragma unroll
                for (int m = 0; m < 4; ++m) { float sp = part[ai][m]; sp += __shfl_xor(sp, 16); sp += __shfl_xor(sp, 32); rsv[ai][m] = rsqrtf(sp * (1.0f / 1024.0f) + 1e-6f); }
        } else {
#pragma unroll
            for (int ai = 0; ai < 2; ++ai)
#pragma unroll
                for (int m = 0; m < 4; ++m) rsv[ai][m] = 1.0f;
        }
#pragma unroll
        for (int ai = 0; ai < 2; ++ai) {
            u32x4_t rres[4][2];
            if (MODE == EP_RES) {
#pragma unroll
                for (int m = 0; m < 4; ++m)
#pragma unroll
                    for (int bj = 0; bj < 2; ++bj) rres[m][bj] = *(const u32x4_t*)(res + (size_t)(row00 + ai * 128 + m * 16) * 1024 + u.pn * 256 + bj * 128 + wc * 32 + fq * 8);
            }
#pragma unroll
            for (int m = 0; m < 4; ++m) {
                const int row = row00 + ai * 128 + m * 16;
                const float rs = rsv[ai][m];
                if (MODE == EP_GU) {
                    const f32x4 g0 = acc[ai][0][m][0] * rs, g1 = acc[ai][0][m][1] * rs, u0 = acc[ai][1][m][0] * rs, u1 = acc[ai][1][m][1] * rs;
                    uint4 w;
                    w.x = cvt_pk_bf16(silu_f(g0[0]) * u0[0], silu_f(g0[1]) * u0[1]); w.y = cvt_pk_bf16(silu_f(g0[2]) * u0[2], silu_f(g0[3]) * u0[3]);
                    w.z = cvt_pk_bf16(silu_f(g1[0]) * u1[0], silu_f(g1[1]) * u1[1]); w.w = cvt_pk_bf16(silu_f(g1[2]) * u1[2], silu_f(g1[3]) * u1[3]);
                    *(uint4*)(O + (size_t)row * ldo + u.pn * 128 + wc * 32 + fq * 8) = w;
                } else {
                    float sq = 0.f;
#pragma unroll
                    for (int bj = 0; bj < 2; ++bj) {
                        const int col0 = u.pn * 256 + bj * 128 + wc * 32 + fq * 8;
                        f32x4 v0 = acc[ai][bj][m][0] * rs, v1 = acc[ai][bj][m][1] * rs;
                        if (MODE == EP_EVEN_IN) {
                            if (u.pn >= 2) {
#pragma unroll
                                for (int j = 0; j < 4; ++j) { v0[j] = gelu_tanh_f(v0[j]); v1[j] = gelu_tanh_f(v1[j]); }
                            }
                            if (u.pn >= 4) sq += (v0[0] * v0[0] + v0[1] * v0[1]) + (v0[2] * v0[2] + v0[3] * v0[3]) + (v1[0] * v1[0] + v1[1] * v1[1]) + (v1[2] * v1[2] + v1[3] * v1[3]);
                        }
                        if (MODE == EP_ODD_IN) {
                            if (u.pn >= 12) {
#pragma unroll
                                for (int j = 0; j < 4; ++j) { v0[j] = silu_f(v0[j]); v1[j] = silu_f(v1[j]); }
                            }
                        }
                        if (MODE == EP_RES) {
                            { const u32x4_t rr = rres[m][bj];
                              v0[0] += bflo(rr[0]); v0[1] += bfhi(rr[0]); v0[2] += bflo(rr[1]); v0[3] += bfhi(rr[1]); v1[0] += bflo(rr[2]); v1[1] += bfhi(rr[2]); v1[2] += bflo(rr[3]); v1[3] += bfhi(rr[3]); }
                            sq += (v0[0] * v0[0] + v0[1] * v0[1]) + (v0[2] * v0[2] + v0[3] * v0[3]) + (v1[0] * v1[0] + v1[1] * v1[1]) + (v1[2] * v1[2] + v1[3] * v1[3]);
                        }
                        uint4 w;
                        w.x = cvt_pk_bf16(v0[0], v0[1]); w.y = cvt_pk_bf16(v0[2], v0[3]); w.z = cvt_pk_bf16(v1[0], v1[1]); w.w = cvt_pk_bf16(v1[2], v1[3]);
                        *(uint4*)(O + (size_t)row * ldo + col0) = w;
                    }
                    if (MODE == EP_RES) {
                        sq += __shfl_xor(sq, 16); sq += __shfl_xor(sq, 32);
                        if (fq == 0) ss_out[(size_t)row * 16 + u.pn * 4 + wc] = sq;
                    }
                    if (MODE == EP_EVEN_IN) {
                        if (u.pn >= 4) {
                            sq += __shfl_xor(sq, 16); sq += __shfl_xor(sq, 32);
                            if (fq == 0) ss_out[(size_t)row * 16 + (u.pn - 4) * 4 + wc] = sq;
                        }
                    }
                }
            }
            asm volatile("" ::: "memory");
        }
    }
};

#ifndef GEMM_ALIGN
#define GEMM_ALIGN true
#endif
#ifndef GEMM_SP2
#define GEMM_SP2 true
#endif
template <int MODE>
__device__ __forceinline__ void run_gemm(LAS unsigned char* lds, const bf16_t* A, const bf16_t* Bt, int M, int N, int K, const Epi<MODE>& E, int rot = 0) {
#if defined(T_ONLYMODE)
    if (MODE != T_ONLYMODE) return;
#endif
    pg8::Gemm g{A, Bt, M, N, K};
    pg8::StaticOrder S; S.init(M, N, (int)gridDim.x, (int)((blockIdx.x + rot) % gridDim.x));
    pg8::gemm_phase<Epi<MODE>, pg8::StaticOrder, GEMM_ALIGN, GEMM_SP2>(lds, g, S, E);
}

__device__ __forceinline__ void conv_weight(const float* W, const float* gain, bf16_t* Bt, int K, int Nsrc, int N, int mode, LAS float*) {
    const int tid = opaque_tid(), nkt = K / 64, nnt = N / 64;
    const int tx = tid & 63, kq = tid >> 6;
    for (int tix = blockIdx.x; tix < nkt * nnt; tix += gridDim.x) {
        const int kt = tix % nkt, ntl = tix / nkt, k0 = kt * 64 + kq * 8, np = ntl * 64 + tx;
        int src = np; float cs = 1.0f;
        if (mode == 1) { if (np < 512) cs = 0.125f; else if (np >= 2048 && np < 2560) cs = 0.08838834764831845f; }
        else if (mode == 2) cs = 0.0625f;
        else if (mode == 3) { const int pn = np >> 8, r = np & 255; src = (r < 128) ? (pn * 128 + r) : (DFF + pn * 128 + (r - 128)); }
        float v[8];
#pragma unroll
        for (int j = 0; j < 8; ++j) v[j] = W[(size_t)(k0 + j) * Nsrc + src];
        if (gain) {
            const float4 g0 = *(const float4*)(gain + k0), g1 = *(const float4*)(gain + k0 + 4);
            v[0] *= g0.x; v[1] *= g0.y; v[2] *= g0.z; v[3] *= g0.w; v[4] *= g1.x; v[5] *= g1.y; v[6] *= g1.z; v[7] *= g1.w;
        }
        uint4 w;
        w.x = cvt_pk_bf16(v[0] * cs, v[1] * cs); w.y = cvt_pk_bf16(v[2] * cs, v[3] * cs); w.z = cvt_pk_bf16(v[4] * cs, v[5] * cs); w.w = cvt_pk_bf16(v[6] * cs, v[7] * cs);
        *(uint4*)(Bt + (size_t)np * K + k0) = w;
    }
}

__device__ __forceinline__ void sincos_d(double a, float& s_out, float& c_out) {
    const double k = rint(a * 0.63661977236758134308);
    const double r = (a - k * 1.57079632679489655800) - k * 6.12323399573676603587e-17;
    const double r2 = r * r;
    double sp = -1.0 / 1307674368000.0;
    sp = sp * r2 + 1.0 / 6227020800.0; sp = sp * r2 - 1.0 / 39916800.0; sp = sp * r2 + 1.0 / 362880.0; sp = sp * r2 - 1.0 / 5040.0; sp = sp * r2 + 1.0 / 120.0; sp = sp * r2 - 1.0 / 6.0; sp = sp * r2 + 1.0;
    const double sn = sp * r;
    double cp = 1.0 / 20922789888000.0;
    cp = cp * r2 - 1.0 / 87178291200.0; cp = cp * r2 + 1.0 / 479001600.0; cp = cp * r2 - 1.0 / 3628800.0; cp = cp * r2 + 1.0 / 40320.0; cp = cp * r2 - 1.0 / 720.0; cp = cp * r2 + 1.0 / 24.0; cp = cp * r2 - 0.5; cp = cp * r2 + 1.0;
    const int q = ((int)k) & 3;
    double s, c;
    if (q == 0) { s = sn; c = cp; } else if (q == 1) { s = cp; c = -sn; } else if (q == 2) { s = -sn; c = -cp; } else { s = -cp; c = sn; }
    s_out = (float)s; c_out = (float)c;
}


constexpr int SRED_RSTD = 512;
constexpr int SRED_GEMV = 1024;
__device__ __forceinline__ void side_rstd(const float* v_t, int K, float inv_dim, LAS float* red) {
    const int tid = opaque_tid(), b = tid & 31, part = tid >> 5;
    float s = 0.f;
    float s1 = 0.f, s2 = 0.f, s3 = 0.f;
    for (int k = part; k < K; k += 64) {
        const float x0 = v_t[k * 32 + b], x1 = v_t[(k + 16) * 32 + b], x2 = v_t[(k + 32) * 32 + b], x3 = v_t[(k + 48) * 32 + b];
        s += x0 * x0; s1 += x1 * x1; s2 += x2 * x2; s3 += x3 * x3;
    }
    s = (s + s1) + (s2 + s3);
    red[tid] = s;
    __syncthreads();
    if (tid < 32) { float t = 0.f; for (int q = 0; q < 16; ++q) t += red[q * 32 + tid]; red[SRED_RSTD + tid] = rsqrtf(t * inv_dim + 1e-6f); }
    __syncthreads();
}
constexpr int SRED_IN = SRED_GEMV + 8 * 32 * 64;
template <class InF, class EpiF>
__device__ __forceinline__ void side_gemv(const float* W, int ldw, int K, int N, const InF& in, const EpiF& epi, LAS float* red) {
    const int tid = opaque_tid(), lane = tid & 63;
    const int kg = __builtin_amdgcn_readfirstlane(tid >> 6);
    const int ns = K >> 8;
    for (int c = blockIdx.x; c < (N >> 6); c += gridDim.x) {
        float acc[32];
#pragma unroll
        for (int b = 0; b < 32; ++b) acc[b] = 0.f;
        float xs[16];
        int t0 = tid; asm volatile("" : "+v"(t0));
#pragma unroll
        for (int i = 0; i < 16; ++i) { const int idx = t0 + 512 * i, k = idx >> 5; xs[i] = in.v(k, idx & 31, c) * in.ws(k); }
        __syncthreads();
#pragma unroll
        for (int i = 0; i < 16; ++i) red[SRED_IN + t0 + 512 * i] = xs[i];
        __syncthreads();
        for (int sl = 0; sl < ns; ++sl) {
            const int ks = sl << 8;
            LAS float* xin = red + SRED_IN + (sl & 1) * 8192;
            const float* wp = W + (size_t)(ks + 32 * kg) * ldw + c * 64 + lane;
            float w[32];
#pragma unroll
            for (int i = 0; i < 32; ++i) w[i] = wp[(size_t)i * ldw];
            LAS float* wl = red + SRED_GEMV + (kg * 32) * 64 + lane;
#pragma unroll
            for (int i = 0; i < 32; ++i) wl[i * 64] = w[i];
            asm volatile("" ::: "memory");
            int t1 = tid; asm volatile("" : "+v"(t1));
            if (sl + 1 < ns) {
#pragma unroll
                for (int i = 0; i < 16; ++i) { const int idx = t1 + 512 * i, k = ks + 256 + (idx >> 5); xs[i] = in.v(k, idx & 31, c) * in.ws(k); }
            }
#pragma unroll 1
            for (int k4 = 0; k4 < 8; ++k4) {
                const LAS f32x4* xv = (const LAS f32x4*)(xin + (32 * kg + k4 * 4) * 32);
                const float w0 = wl[(k4 * 4) * 64], w1 = wl[(k4 * 4 + 1) * 64], w2 = wl[(k4 * 4 + 2) * 64], w3 = wl[(k4 * 4 + 3) * 64];
#pragma unroll
                for (int q = 0; q < 8; ++q) {
                    const f32x4 x0 = xv[q], x1 = xv[8 + q], x2 = xv[16 + q], x3 = xv[24 + q];
                    acc[4 * q] += x0[0] * w0 + x1[0] * w1 + x2[0] * w2 + x3[0] * w3; acc[4 * q + 1] += x0[1] * w0 + x1[1] * w1 + x2[1] * w2 + x3[1] * w3;
                    acc[4 * q + 2] += x0[2] * w0 + x1[2] * w1 + x2[2] * w2 + x3[2] * w3; acc[4 * q + 3] += x0[3] * w0 + x1[3] * w1 + x2[3] * w2 + x3[3] * w3;
                }
            }
            if (sl + 1 < ns) {
                LAS float* xnx = red + SRED_IN + ((sl + 1) & 1) * 8192;
#pragma unroll
                for (int i = 0; i < 16; ++i) xnx[t1 + 512 * i] = xs[i];
            }
            __syncthreads();
        }
#pragma unroll
        for (int b = 0; b < 32; ++b) red[SRED_GEMV + (kg * 32 + b) * 64 + lane] = acc[b];
        __syncthreads();
#pragma unroll
        for (int i = 0; i < 4; ++i) {
            const int idx = tid + 512 * i, col = idx & 63, b = idx >> 6;
            float sum = 0.f;
#pragma unroll
            for (int g = 0; g < 8; ++g) sum += red[SRED_GEMV + (g * 32 + b) * 64 + col];
            epi(c * 64 + col, b, sum);
        }
        __syncthreads();
    }
}
template <class InF>
__device__ __forceinline__ void side_gemv_ks(const float* W, int ldw, int K, int N, const InF& in, float* h_t, LAS float* red) {
    const int tid = opaque_tid(), lane = tid & 63;
    const int kg = __builtin_amdgcn_readfirstlane(tid >> 6);
    const int ns = K >> 8, items = (N >> 6) * ns;
    for (int item = blockIdx.x; item < items; item += gridDim.x) {
        const int c = item / ns, ks = (item - c * ns) << 8;
        float xs[16];
        int t0 = tid; asm volatile("" : "+v"(t0));
#pragma unroll
        for (int i = 0; i < 16; ++i) { const int idx = t0 + 512 * i, k = ks + (idx >> 5); xs[i] = in.v(k, idx & 31, c) * in.ws(k); }
        float w[32];
        {
            const float* wp = W + (size_t)(ks + 32 * kg) * ldw + c * 64 + lane;
#pragma unroll
            for (int i = 0; i < 32; ++i) w[i] = wp[(size_t)i * ldw];
        }
        __syncthreads();
#pragma unroll
        for (int i = 0; i < 16; ++i) red[SRED_IN + t0 + 512 * i] = xs[i];
        LAS float* wl = red + SRED_GEMV + (kg * 32) * 64 + lane;
#pragma unroll
        for (int i = 0; i < 32; ++i) wl[i * 64] = w[i];
        __syncthreads();
        float acc[32];
#pragma unroll
        for (int b = 0; b < 32; ++b) acc[b] = 0.f;
        LAS float* xin = red + SRED_IN;
#pragma unroll 1
        for (int k4 = 0; k4 < 8; ++k4) {
            const LAS f32x4* xv = (const LAS f32x4*)(xin + (32 * kg + k4 * 4) * 32);
            const float w0 = wl[(k4 * 4) * 64], w1 = wl[(k4 * 4 + 1) * 64], w2 = wl[(k4 * 4 + 2) * 64], w3 = wl[(k4 * 4 + 3) * 64];
#pragma unroll
            for (int q = 0; q < 8; ++q) {
                const f32x4 x0 = xv[q], x1 = xv[8 + q], x2 = xv[16 + q], x3 = xv[24 + q];
                acc[4 * q] += x0[0] * w0 + x1[0] * w1 + x2[0] * w2 + x3[0] * w3; acc[4 * q + 1] += x0[1] * w0 + x1[1] * w1 + x2[1] * w2 + x3[1] * w3;
                acc[4 * q + 2] += x0[2] * w0 + x1[2] * w1 + x2[2] * w2 + x3[2] * w3; acc[4 * q + 3] += x0[3] * w0 + x1[3] * w1 + x2[3] * w2 + x3[3] * w3;
            }
        }
        __syncthreads();
#pragma unroll
        for (int b = 0; b < 32; ++b) red[SRED_GEMV + (kg * 32 + b) * 64 + lane] = acc[b];
        __syncthreads();
#pragma unroll
        for (int i = 0; i < 4; ++i) {
            const int idx = tid + 512 * i, col = idx & 63, b = idx >> 6;
            float sum = 0.f;
#pragma unroll
            for (int g = 0; g < 8; ++g) sum += red[SRED_GEMV + (g * 32 + b) * 64 + col];
            atomicAdd(h_t + (c * 64 + col) * 32 + b, sum);
        }
        __syncthreads();
    }
}
struct InPlain { const float* v_t; const float* gain; __device__ __forceinline__ float ws(int k) const { return gain ? gain[k] : 1.0f; } __device__ __forceinline__ float v(int k, int b, int) const { return v_t[k * 32 + b]; } };
struct InSgu { const float* z_t; const float* sgu_w; const float* sgu_b; const float* sgu_norm; const LAS float* rstdv;
    __device__ __forceinline__ float ws(int) const { return 1.0f; }
    __device__ __forceinline__ float v(int k, int b, int) const { const int g = k >> 7; return z_t[k * 32 + b] * (sgu_w[(size_t)g * 16384] * z_t[(512 + k) * 32 + b] * rstdv[b] * sgu_norm[k] + sgu_b[g * 128]); } };
struct InHead { const float* t_t; __device__ __forceinline__ float ws(int) const { return 1.0f; } __device__ __forceinline__ float v(int k, int b, int c) const { return t_t[((size_t)(c >> 2) * 1024 + k) * 32 + b]; } };
struct InSwiglu { const float* z_t; __device__ __forceinline__ float ws(int) const { return 1.0f; } __device__ __forceinline__ float v(int k, int b, int) const { return silu_f(z_t[k * 32 + b]) * z_t[(DFF + k) * 32 + b]; } };
struct EpStore { float* o_t; const LAS float* rstd; float scale; int act;
    __device__ __forceinline__ void operator()(int n, int b, float s) const { float v = s * scale * (rstd ? rstd[b] : 1.0f); if (act == 1) v = gelu_tanh_f(v); o_t[n * 32 + b] = v; } };
struct EpAdd { float* h_t; __device__ __forceinline__ void operator()(int n, int b, float s) const { h_t[n * 32 + b] += s; } };


__device__ __forceinline__ void xattn_phase(LAS unsigned char* lds, bf16_t* Yq, const bf16_t* Kmat, const bf16_t* VT) {
    const int tid = opaque_tid(), lane = tid & 63, r = lane & 15, qp = lane >> 4;
    const int wave = __builtin_amdgcn_readfirstlane(tid >> 6);
    constexpr int KS = 528;
    for (int trip = 0;; ++trip) {
        const int unit = xcd_unit(trip, 1024);
        if (unit < 0) break;
        const int b = unit >> 5, h = (unit >> 3) & 3, qb = unit & 7;
        __syncthreads();
        int tk = tid; asm volatile("" : "+v"(tk));
#pragma unroll
        for (int half = 0; half < 2; ++half) {
            u32x4_t tv[8];
#pragma unroll
            for (int i = 0; i < 8; ++i) { const int c = tk + 512 * (half * 8 + i), row = c >> 5, ch = c & 31; tv[i] = *(const u32x4_t*)(Kmat + (size_t)(b * 256 + row) * 1024 + h * 256 + ch * 8); }
#pragma unroll
            for (int i = 0; i < 8; ++i) { const int c = tk + 512 * (half * 8 + i), row = c >> 5, ch = c & 31; *(LAS u32x4_t*)(lds + row * KS + ch * 16) = tv[i]; }
        }
        __syncthreads();
        const int q0 = b * 2048 + qb * 256 + wave * 32;
        bf16x8_t pf[2][8];
        float inv[2];
        {
            f32x4 sacc[2][16];
#pragma unroll
            for (int kt = 0; kt < 16; ++kt) { sacc[0][kt] = (f32x4){0.f, 0.f, 0.f, 0.f}; sacc[1][kt] = (f32x4){0.f, 0.f, 0.f, 0.f}; }
            const bf16_t* qrow = Yq + (size_t)(q0 + r) * 1024 + h * 256 + qp * 8;
            const LAS unsigned char* kb = lds + r * KS + qp * 16; const LAS unsigned char* kb2 = kb + 8 * 16 * KS; asm volatile("" : "+v"(kb2));
            bf16x8_t qa = *(const bf16x8_t*)qrow, qb = *(const bf16x8_t*)(qrow + 16 * 1024);
#pragma unroll
            for (int ks = 0; ks < 8; ++ks) {
                const bf16x8_t qf0 = qa, qf1 = qb;
                if (ks < 7) { qa = *(const bf16x8_t*)(qrow + (ks + 1) * 32); qb = *(const bf16x8_t*)(qrow + 16 * 1024 + (ks + 1) * 32); }
#pragma unroll
                for (int kt = 0; kt < 16; ++kt) {
                    const bf16x8_t a = *(const LAS bf16x8_t*)((kt < 8 ? kb : kb2) + (kt & 7) * 16 * KS + ks * 64);
                    sacc[0][kt] = __builtin_amdgcn_mfma_f32_16x16x32_bf16(a, qf0, sacc[0][kt], 0, 0, 0);
                    sacc[1][kt] = __builtin_amdgcn_mfma_f32_16x16x32_bf16(a, qf1, sacc[1][kt], 0, 0, 0);
                }
            }
#pragma unroll
            for (int qt = 0; qt < 2; ++qt) {
                float mx = -INFINITY;
#pragma unroll
                for (int kt = 0; kt < 16; ++kt) mx = fmaxf(mx, fmaxf(fmaxf(sacc[qt][kt][0], sacc[qt][kt][1]), fmaxf(sacc[qt][kt][2], sacc[qt][kt][3])));
                mx = fmaxf(mx, __shfl_xor(mx, 16)); mx = fmaxf(mx, __shfl_xor(mx, 32));
                float sum = 0.f;
#pragma unroll
                for (int kt = 0; kt < 16; ++kt) {
#pragma unroll
                    for (int j = 0; j < 4; ++j) { const float e = __builtin_amdgcn_exp2f((sacc[qt][kt][j] - mx) * 1.4426950408889634f); sacc[qt][kt][j] = e; sum += e; }
                }
                sum += __shfl_xor(sum, 16); sum += __shfl_xor(sum, 32);
                inv[qt] = 1.0f / sum;
#pragma unroll
                for (int u = 0; u < 8; ++u) {
                    u32x4_t w;
                    w[0] = cvt_pk_bf16(sacc[qt][2 * u][0], sacc[qt][2 * u][1]); w[1] = cvt_pk_bf16(sacc[qt][2 * u][2], sacc[qt][2 * u][3]);
                    w[2] = cvt_pk_bf16(sacc[qt][2 * u + 1][0], sacc[qt][2 * u + 1][1]); w[3] = cvt_pk_bf16(sacc[qt][2 * u + 1][2], sacc[qt][2 * u + 1][3]);
                    pf[qt][u] = __builtin_bit_cast(bf16x8_t, w);
                }
            }
        }
        __syncthreads();
        int tv2 = tid; asm volatile("" : "+v"(tv2));
#pragma unroll 1
        for (int qd = 0; qd < 4; ++qd) {
            u32x4_t tv[4];
#pragma unroll
            for (int i = 0; i < 4; ++i) { const int c = tv2 + 512 * (qd * 4 + i), row = c >> 5, ch = c & 31; tv[i] = *(const u32x4_t*)(VT + (size_t)(h * 256 + row) * MROWS + b * 256 + ch * 8); }
#pragma unroll
            for (int i = 0; i < 4; ++i) { const int c = tv2 + 512 * (qd * 4 + i), row = c >> 5, ch = c & 31; *(LAS u32x4_t*)(lds + (((row & 15) << 4) | (row >> 4)) * KS + ch * 16) = tv[i]; }
        }
        __syncthreads();
        {
            f32x4 oacc[2][16];
#pragma unroll
            for (int nt = 0; nt < 16; ++nt) { oacc[0][nt] = (f32x4){0.f, 0.f, 0.f, 0.f}; oacc[1][nt] = (f32x4){0.f, 0.f, 0.f, 0.f}; }
            const LAS unsigned char* vb = lds + r * KS + qp * 8; const LAS unsigned char* vb2 = vb + 8 * 16 * KS; asm volatile("" : "+v"(vb2));
#pragma unroll
            for (int u = 0; u < 8; ++u)
#pragma unroll
                for (int nt = 0; nt < 16; ++nt) {
                    const LAS unsigned char* bp = (nt < 8 ? vb : vb2) + (nt & 7) * 16 * KS + u * 64;
                    const u32x2_t lo = *(const LAS u32x2_t*)bp, hi = *(const LAS u32x2_t*)(bp + 32);
                    u32x4_t w; w[0] = lo[0]; w[1] = lo[1]; w[2] = hi[0]; w[3] = hi[1];
                    const bf16x8_t bv = __builtin_bit_cast(bf16x8_t, w);
                    oacc[0][nt] = __builtin_amdgcn_mfma_f32_16x16x32_bf16(pf[0][u], bv, oacc[0][nt], 0, 0, 0);
                    oacc[1][nt] = __builtin_amdgcn_mfma_f32_16x16x32_bf16(pf[1][u], bv, oacc[1][nt], 0, 0, 0);
                }
            int r2 = r, qp2 = qp; asm volatile("" : "+v"(r2), "+v"(qp2));
#pragma unroll
            for (int qt = 0; qt < 2; ++qt)
#pragma unroll
                for (int j = 0; j < 4; ++j) {
                    const float is = __shfl(inv[qt], qp2 * 4 + j);
                    bf16_t* op = Yq + (size_t)(q0 + qt * 16 + qp2 * 4 + j) * 1024 + h * 256 + r2 * 16;
                    u32x4_t w0, w1;
#pragma unroll
                    for (int e = 0; e < 4; ++e) { w0[e] = cvt_pk_bf16(oacc[qt][2 * e][j] * is, oacc[qt][2 * e + 1][j] * is); w1[e] = cvt_pk_bf16(oacc[qt][8 + 2 * e][j] * is, oacc[qt][9 + 2 * e][j] * is); }
                    *(u32x4_t*)op = w0; *(u32x4_t*)(op + 8) = w1;
                }
        }
    }
    __syncthreads();
}

constexpr int RP = 272;
constexpr int RTILE = 128 * RP;
__device__ __forceinline__ float ret_lg2(int h) { return log2f(1.0f - exp2f(-5.0f - (float)h)); }
template <int TR>
__device__ __forceinline__ void ret_stage_rot(LAS unsigned char* dst, const bf16_t* Z1, int tok0, int col0, const float* TAB, float lg2, float sgn, int tid) {
    for (int it = tid; it < 1024; it += 512) {
        const int row = TR ? (it & 127) : (it >> 3), c8 = TR ? ((it >> 7) * 8) : ((it & 7) * 8);
        const bf16_t* zp = Z1 + (size_t)(tok0 + row) * ODD_IN + col0 + c8;
        const u32x4_t a = *(const u32x4_t*)zp, bq = *(const u32x4_t*)(zp + 64);
        const int pos = (tok0 + row) & 2047;
        const float4 c0 = *(const float4*)(TAB + TAB_RC + pos * 64 + c8), c1 = *(const float4*)(TAB + TAB_RC + pos * 64 + c8 + 4);
        const float4 s0 = *(const float4*)(TAB + TAB_RS + pos * 64 + c8), s1 = *(const float4*)(TAB + TAB_RS + pos * 64 + c8 + 4);
        const float sc = exp2f(sgn * (float)(row + 1) * lg2);
        const float x1[8] = {bflo(a[0]), bfhi(a[0]), bflo(a[1]), bfhi(a[1]), bflo(a[2]), bfhi(a[2]), bflo(a[3]), bfhi(a[3])};
        const float x2[8] = {bflo(bq[0]), bfhi(bq[0]), bflo(bq[1]), bfhi(bq[1]), bflo(bq[2]), bfhi(bq[2]), bflo(bq[3]), bfhi(bq[3])};
        const float cs[8] = {c0.x, c0.y, c0.z, c0.w, c1.x, c1.y, c1.z, c1.w};
        const float sn[8] = {s0.x, s0.y, s0.z, s0.w, s1.x, s1.y, s1.z, s1.w};
        float o1[8], o2[8];
#pragma unroll
        for (int e = 0; e < 8; ++e) { o1[e] = (x1[e] * cs[e] - x2[e] * sn[e]) * sc; o2[e] = (x1[e] * sn[e] + x2[e] * cs[e]) * sc; }
        if (TR == 0) {
            u32x4_t w1, w2;
#pragma unroll
            for (int e = 0; e < 4; ++e) { w1[e] = cvt_pk_bf16(o1[2 * e], o1[2 * e + 1]); w2[e] = cvt_pk_bf16(o2[2 * e], o2[2 * e + 1]); }
            *(LAS u32x4_t*)(dst + row * RP + c8 * 2) = w1; *(LAS u32x4_t*)(dst + row * RP + (64 + c8) * 2) = w2;
        } else {
#pragma unroll
            for (int e = 0; e < 8; ++e) {
                const int d1 = c8 + e, d2 = 64 + c8 + e;
                *(LAS unsigned short*)(dst + ((d1 & 7) * 16 + (d1 >> 3)) * RP + row * 2) = f2bf(o1[e]); *(LAS unsigned short*)(dst + ((d2 & 7) * 16 + (d2 >> 3)) * RP + row * 2) = f2bf(o2[e]);
            }
        }
    }
}
template <int PERM8>
__device__ __forceinline__ void stage_tr128(LAS unsigned char* dst, const bf16_t* src, int ld, int tok0, int col0, int tid) {
    for (int it = tid; it < 2048; it += 512) {
        const int row = it & 127, c8 = (it >> 7) * 8;
        const u32x4_t a = *(const u32x4_t*)(src + (size_t)(tok0 + row) * ld + col0 + c8);
#pragma unroll
        for (int e = 0; e < 4; ++e) {
            const int e0 = c8 + 2 * e, e1 = e0 + 1;
            *(LAS unsigned short*)(dst + (PERM8 ? ((e0 & 7) * 16 + (e0 >> 3)) : e0) * RP + row * 2) = (unsigned short)(a[e] & 0xffffu);
            *(LAS unsigned short*)(dst + (PERM8 ? ((e1 & 7) * 16 + (e1 >> 3)) : e1) * RP + row * 2) = (unsigned short)(a[e] >> 16);
        }
    }
}
__device__ __forceinline__ void ret_r1(LAS unsigned char* lds, const bf16_t* Z1, const float* TAB, bf16_t* RET) {
    const int tid = opaque_tid(), lane = tid & 63, r = lane & 15, qp = lane >> 4;
    const int wave = __builtin_amdgcn_readfirstlane(tid >> 6);
    LAS unsigned char* KT = lds; LAS unsigned char* VTL = lds + RTILE;
    for (int unit = blockIdx.x; unit < 2048; unit += gridDim.x) {
        const int b = unit >> 6, h = (unit >> 4) & 3, n = unit & 15, tok0 = b * 2048 + n * 128;
        const float lg2 = ret_lg2(h);
        __syncthreads();
        ret_stage_rot<1>(KT, Z1, tok0, 2048 + h * 128, TAB, lg2, -1.0f, tid);
        stage_tr128<0>(VTL, Z1, ODD_IN, tok0, 2560 + h * 128, tid);
        __syncthreads();
        f32x4 acc[8];
#pragma unroll
        for (int nt = 0; nt < 8; ++nt) acc[nt] = (f32x4){0.f, 0.f, 0.f, 0.f};
#pragma unroll
        for (int ks = 0; ks < 4; ++ks) {
            const bf16x8_t a = *(const LAS bf16x8_t*)(VTL + (16 * wave + r) * RP + (32 * ks + 8 * qp) * 2);
#pragma unroll
            for (int nt = 0; nt < 8; ++nt) {
                const bf16x8_t bv = *(const LAS bf16x8_t*)(KT + (16 * nt + r) * RP + (32 * ks + 8 * qp) * 2);
                acc[nt] = __builtin_amdgcn_mfma_f32_16x16x32_bf16(a, bv, acc[nt], 0, 0, 0);
            }
        }
        const float g128 = exp2f(128.0f * lg2);
        bf16_t* op = RET + (size_t)unit * 16384;
#pragma unroll
        for (int j = 0; j < 4; ++j) {
            u32x4_t w;
#pragma unroll
            for (int e = 0; e < 4; ++e) w[e] = cvt_pk_bf16(acc[2 * e][j] * g128, acc[2 * e + 1][j] * g128);
            *(u32x4_t*)(op + (16 * wave + 4 * qp + j) * 128 + 8 * r) = w;
        }
    }
    __syncthreads();
}
__device__ __forceinline__ void ret_r2(bf16_t* RET) {
    const int tid = opaque_tid();
    for (int idx = blockIdx.x * 512 + tid; idx < 128 * 8192; idx += gridDim.x * 512) {
        const int bh = idx >> 13, pr = idx & 8191;
        const float g128 = exp2f(128.0f * ret_lg2(bh & 3));
        unsigned* p = (unsigned*)(RET + (size_t)bh * 16 * 16384) + pr;
        float s0 = 0.f, s1 = 0.f;
        for (int n = 0; n < 16; ++n) {
            const unsigned v = p[(size_t)n * 8192];
            p[(size_t)n * 8192] = cvt_pk_bf16(s0, s1);
            s0 = s0 * g128 + bflo(v); s1 = s1 * g128 + bfhi(v);
        }
    }
}
__device__ __forceinline__ void ret_r3(LAS unsigned char* lds, const bf16_t* Z1, const float* TAB, const bf16_t* RET, const float* SDZ, bf16_t* Yo) {
    const int tid = opaque_tid(), lane = tid & 63, r = lane & 15, qp = lane >> 4;
    const int wave = __builtin_amdgcn_readfirstlane(tid >> 6);
    LAS unsigned char* QL = lds; LAS unsigned char* KL = lds + RTILE; LAS unsigned char* VTL = lds + 2 * RTILE; LAS unsigned char* PL = lds + 3 * RTILE;
    for (int unit = blockIdx.x; unit < 2048; unit += gridDim.x) {
        const int b = unit >> 6, h = (unit >> 4) & 3, n = unit & 15, tok0 = b * 2048 + n * 128;
        const float lg2 = ret_lg2(h);
        __syncthreads();
        ret_stage_rot<0>(QL, Z1, tok0, 1536 + h * 128, TAB, lg2, 1.0f, tid);
        ret_stage_rot<0>(KL, Z1, tok0, 2048 + h * 128, TAB, lg2, -1.0f, tid);
        stage_tr128<1>(VTL, Z1, ODD_IN, tok0, 2560 + h * 128, tid);
        for (int it = tid; it < 2048; it += 512) { const int row = it >> 4, c8 = (it & 15) * 8; *(LAS u32x4_t*)(PL + ((row & 7) * 16 + (row >> 3)) * RP + c8 * 2) = *(const u32x4_t*)(RET + (size_t)unit * 16384 + row * 128 + c8); }
        __syncthreads();
        bf16x8_t qf[4];
#pragma unroll
        for (int ks = 0; ks < 4; ++ks) qf[ks] = *(const LAS bf16x8_t*)(QL + (16 * wave + r) * RP + (32 * ks + 8 * qp) * 2);
        f32x4 sacc[8];
#pragma unroll
        for (int jt = 0; jt < 8; ++jt) {
            sacc[jt] = (f32x4){0.f, 0.f, 0.f, 0.f};
            if (jt <= wave) {
#pragma unroll
                for (int ks = 0; ks < 4; ++ks) {
                    const bf16x8_t a = *(const LAS bf16x8_t*)(KL + (16 * jt + r) * RP + (32 * ks + 8 * qp) * 2);
                    sacc[jt] = __builtin_amdgcn_mfma_f32_16x16x32_bf16(a, qf[ks], sacc[jt], 0, 0, 0);
                }
#pragma unroll
                for (int j = 0; j < 4; ++j) if (16 * jt + 4 * qp + j > 16 * wave + r) sacc[jt][j] = 0.f;
            }
        }
        if (n == 0 && wave == 0) {
            const float* zq = SDZ + (size_t)(h * 128) * 32 + b;
            const float c = wave_sum(zq[lane * 32] * zq[(512 + lane) * 32] + zq[(lane + 64) * 32] * zq[(512 + lane + 64) * 32]) * 0.08838834764831845f;
            if (lane == 0) sacc[0][0] = c;
        }
        bf16x8_t pf[4];
#pragma unroll
        for (int u = 0; u < 4; ++u) {
            u32x4_t w;
            w[0] = cvt_pk_bf16(sacc[2 * u][0], sacc[2 * u][1]); w[1] = cvt_pk_bf16(sacc[2 * u][2], sacc[2 * u][3]);
            w[2] = cvt_pk_bf16(sacc[2 * u + 1][0], sacc[2 * u + 1][1]); w[3] = cvt_pk_bf16(sacc[2 * u + 1][2], sacc[2 * u + 1][3]);
            pf[u] = __builtin_bit_cast(bf16x8_t, w);
        }
        f32x4 oacc[8];
#pragma unroll
        for (int nt = 0; nt < 8; ++nt) oacc[nt] = (f32x4){0.f, 0.f, 0.f, 0.f};
#pragma unroll
        for (int u = 0; u < 4; ++u) {
            if (2 * u <= wave) {
#pragma unroll
                for (int nt = 0; nt < 8; ++nt) {
                    const LAS unsigned char* bp = VTL + (16 * nt + r) * RP + (32 * u + 4 * qp) * 2;
                    const u32x2_t lo = *(const LAS u32x2_t*)bp, hi = *(const LAS u32x2_t*)(bp + 32);
                    u32x4_t w; w[0] = lo[0]; w[1] = lo[1]; w[2] = hi[0]; w[3] = hi[1];
                    oacc[nt] = __builtin_amdgcn_mfma_f32_16x16x32_bf16(pf[u], __builtin_bit_cast(bf16x8_t, w), oacc[nt], 0, 0, 0);
                }
            }
        }
#pragma unroll
        for (int ks = 0; ks < 4; ++ks)
#pragma unroll
            for (int nt = 0; nt < 8; ++nt) {
                const bf16x8_t bv = *(const LAS bf16x8_t*)(PL + (16 * nt + r) * RP + (32 * ks + 8 * qp) * 2);
                oacc[nt] = __builtin_amdgcn_mfma_f32_16x16x32_bf16(qf[ks], bv, oacc[nt], 0, 0, 0);
            }
#pragma unroll
        for (int j = 0; j < 4; ++j) {
            float sm = 0.f;
#pragma unroll
            for (int nt = 0; nt < 8; ++nt) sm += oacc[nt][j];
            sm += __shfl_xor(sm, 1); sm += __shfl_xor(sm, 2); sm += __shfl_xor(sm, 4); sm += __shfl_xor(sm, 8);
            const float mu = sm * (1.0f / 128.0f);
            float vr = 0.f;
#pragma unroll
            for (int nt = 0; nt < 8; ++nt) { const float d = oacc[nt][j] - mu; vr += d * d; }
            vr += __shfl_xor(vr, 1); vr += __shfl_xor(vr, 2); vr += __shfl_xor(vr, 4); vr += __shfl_xor(vr, 8);
            const float rs = rsqrtf(vr * (1.0f / 128.0f) + 1e-6f);
            const size_t tok = (size_t)(tok0 + 16 * wave + 4 * qp + j);
            const u32x4_t gg = *(const u32x4_t*)(Z1 + tok * ODD_IN + 3072 + h * 128 + 8 * r);
            u32x4_t w;
#pragma unroll
            for (int e = 0; e < 4; ++e) w[e] = cvt_pk_bf16(bflo(gg[e]) * (oacc[2 * e][j] - mu) * rs, bfhi(gg[e]) * (oacc[2 * e + 1][j] - mu) * rs);
            *(u32x4_t*)(Yo + tok * 1024 + 512 + h * 128 + 8 * r) = w;
        }
    }
    __syncthreads();
}

constexpr int DKP = 144;
constexpr int DVP = 592;
constexpr int DK_BYTES = 256 * DKP;
#define DIL_DECODE(u) const int b = (u) / 384, v = (u) - b * 384, h = v / 48, v2 = v - h * 48, g = v2 >> 4, rb = v2 & 15; \
    const int lognb = 4 - 2 * g, dil = 1 << (2 * g), nbi = rb & ((1 << lognb) - 1), res = rb >> lognb; const int tokb = b * 2048
#define DIL_ISSUE(u) do { DIL_DECODE(u); const int row_ = (wave & 3) * 64 + lane, hh_ = wave >> 2; const int j_ = 128 * nbi - 128 + row_; validr = j_ >= 0; const int pos_ = validr ? j_ * dil + res : 0; \
    const bf16_t* zr_ = Z1 + (size_t)(tokb + pos_) * ODD_IN + h * 64 + hh_ * 32; \
    _Pragma("unroll") for (int i_ = 0; i_ < 4; ++i_) { kvr[i_] = *(const u32x4_t*)(zr_ + 512 + i_ * 8); vvr[i_] = *(const u32x4_t*)(zr_ + 1024 + i_ * 8); } \
    if (hh_ == 0) { const float* tc_ = TAB + TAB_DC + pos_ * 8; const float* ts_ = TAB + TAB_DS + pos_ * 8; kc0 = *(const float4*)tc_; kc1 = *(const float4*)(tc_ + 4); ks0 = *(const float4*)ts_; ks1 = *(const float4*)(ts_ + 4); } \
    const int qpos_ = (128 * nbi + 16 * wave + r) * dil + res; const bf16_t* qrow_ = Z1 + (size_t)(tokb + qpos_) * ODD_IN + h * 64 + qp * 8; \
    qr0 = *(const u32x4_t*)qrow_; qr1 = *(const u32x4_t*)(qrow_ + 32); \
    { const float* tc_ = TAB + TAB_DC + qpos_ * 8; const float* ts_ = TAB + TAB_DS + qpos_ * 8; qc0 = *(const float4*)tc_; qc1 = *(const float4*)(tc_ + 4); qs0 = *(const float4*)ts_; qs1 = *(const float4*)(ts_ + 4); } } while (0)
__device__ __forceinline__ void dil_units(LAS unsigned char* lds, const bf16_t* Z1, const float* TAB, bf16_t* OB01, bf16_t* Yo, float* LSE) {
    const int tid = opaque_tid(), lane = tid & 63, r = lane & 15, qp = lane >> 4;
    const int wave = __builtin_amdgcn_readfirstlane(tid >> 6);
    LAS unsigned char* KL = lds; LAS unsigned char* VTL = lds + DK_BYTES;
    __syncthreads();
    for (int i = tid; i < 64 * 16; i += 512) { const int d = i >> 4, c = i & 15; *(LAS unsigned*)(VTL + d * DVP + 512 + c * 4) = 0u; }
    u32x4_t kvr[4], vvr[4], qr0, qr1; float4 kc0, kc1, ks0, ks1, qc0, qc1, qs0, qs1; bool validr;
    kc0 = kc1 = ks0 = ks1 = make_float4(0.f, 0.f, 0.f, 0.f);
    int trip = 0, unit = xcd_unit(0, 12288);
    if (unit >= 0) DIL_ISSUE(unit);
    while (unit >= 0) {
        DIL_DECODE(unit);
        __syncthreads();
        {
            const int row = (wave & 3) * 64 + lane, hh = wave >> 2;
            u32x4_t kv[4], vv[4];
#pragma unroll
            for (int i = 0; i < 4; ++i) { kv[i] = validr ? kvr[i] : (u32x4_t){0u, 0u, 0u, 0u}; vv[i] = validr ? vvr[i] : (u32x4_t){0u, 0u, 0u, 0u}; }
#pragma unroll
            for (int i = 0; i < 4; ++i)
#pragma unroll
                for (int e = 0; e < 4; ++e) {
                    *(LAS unsigned short*)(VTL + ((hh * 4 + i) * 8 + 2 * e) * DVP + row * 2) = (unsigned short)(vv[i][e] & 0xffffu);
                    *(LAS unsigned short*)(VTL + ((hh * 4 + i) * 8 + 2 * e + 1) * DVP + row * 2) = (unsigned short)(vv[i][e] >> 16);
                }
            if (hh == 0) {
                const float cs[8] = {kc0.x, kc0.y, kc0.z, kc0.w, kc1.x, kc1.y, kc1.z, kc1.w}, sn[8] = {ks0.x, ks0.y, ks0.z, ks0.w, ks1.x, ks1.y, ks1.z, ks1.w};
                const u32x4_t k1 = kv[0], k2 = kv[1];
                const float x1[8] = {bflo(k1[0]), bfhi(k1[0]), bflo(k1[1]), bfhi(k1[1]), bflo(k1[2]), bfhi(k1[2]), bflo(k1[3]), bfhi(k1[3])};
                const float x2[8] = {bflo(k2[0]), bfhi(k2[0]), bflo(k2[1]), bfhi(k2[1]), bflo(k2[2]), bfhi(k2[2]), bflo(k2[3]), bfhi(k2[3])};
#pragma unroll
                for (int e = 0; e < 4; ++e) {
                    kv[0][e] = cvt_pk_bf16(x1[2 * e] * cs[2 * e] - x2[2 * e] * sn[2 * e], x1[2 * e + 1] * cs[2 * e + 1] - x2[2 * e + 1] * sn[2 * e + 1]);
                    kv[1][e] = cvt_pk_bf16(x1[2 * e] * sn[2 * e] + x2[2 * e] * cs[2 * e], x1[2 * e + 1] * sn[2 * e + 1] + x2[2 * e + 1] * cs[2 * e + 1]);
                }
            }
#pragma unroll
            for (int i = 0; i < 4; ++i) *(LAS u32x4_t*)(KL + row * DKP + (hh * 4 + i) * 16) = kv[i];
        }
        const int qi = 128 * nbi + 16 * wave + r, qpos = qi * dil + res;
        u32x4_t q0 = qr0; const u32x4_t q1 = qr1;
        {
            u32x4_t pr;
#pragma unroll
            for (int e = 0; e < 4; ++e) pr[e] = (unsigned)__shfl_xor((int)q0[e], 16);
            const float cs[8] = {qc0.x, qc0.y, qc0.z, qc0.w, qc1.x, qc1.y, qc1.z, qc1.w}, sn[8] = {qs0.x, qs0.y, qs0.z, qs0.w, qs1.x, qs1.y, qs1.z, qs1.w};
            const float own[8] = {bflo(q0[0]), bfhi(q0[0]), bflo(q0[1]), bfhi(q0[1]), bflo(q0[2]), bfhi(q0[2]), bflo(q0[3]), bfhi(q0[3])};
            const float oth[8] = {bflo(pr[0]), bfhi(pr[0]), bflo(pr[1]), bfhi(pr[1]), bflo(pr[2]), bfhi(pr[2]), bflo(pr[3]), bfhi(pr[3])};
            float o[8];
#pragma unroll
            for (int e = 0; e < 8; ++e) o[e] = (qp == 0) ? (own[e] * cs[e] - oth[e] * sn[e]) : (oth[e] * sn[e] + own[e] * cs[e]);
            if (qp < 2) {
#pragma unroll
                for (int e = 0; e < 4; ++e) q0[e] = cvt_pk_bf16(o[2 * e], o[2 * e + 1]);
            }
        }
        const bf16x8_t qf0 = __builtin_bit_cast(bf16x8_t, q0), qf1 = __builtin_bit_cast(bf16x8_t, q1);
        const int nxt = xcd_unit(++trip, 12288);
        if (nxt >= 0) DIL_ISSUE(nxt);
        __syncthreads();
        f32x4 sacc[9];
        const LAS unsigned char* kb = KL + (16 * wave + r) * DKP + qp * 16;
#pragma unroll
        for (int st = 0; st < 9; ++st) {
            const bf16x8_t a0 = *(const LAS bf16x8_t*)(kb + st * 16 * DKP), a1 = *(const LAS bf16x8_t*)(kb + st * 16 * DKP + 64);
            f32x4 acc = (f32x4){0.f, 0.f, 0.f, 0.f};
            acc = __builtin_amdgcn_mfma_f32_16x16x32_bf16(a0, qf0, acc, 0, 0, 0);
            acc = __builtin_amdgcn_mfma_f32_16x16x32_bf16(a1, qf1, acc, 0, 0, 0);
#pragma unroll
            for (int j = 0; j < 4; ++j) {
                const int dk = 16 * st + 4 * qp + j;
                const bool ok = (dk >= r) && (dk <= r + 128) && (nbi > 0 || 16 * wave + dk >= 128);
                acc[j] = ok ? acc[j] : -INFINITY;
            }
            sacc[st] = acc;
        }
        float mx = -INFINITY;
#pragma unroll
        for (int st = 0; st < 9; ++st) mx = fmaxf(mx, fmaxf(fmaxf(sacc[st][0], sacc[st][1]), fmaxf(sacc[st][2], sacc[st][3])));
        mx = fmaxf(mx, __shfl_xor(mx, 16)); mx = fmaxf(mx, __shfl_xor(mx, 32));
        float sum = 0.f;
#pragma unroll
        for (int st = 0; st < 9; ++st) {
#pragma unroll
            for (int j = 0; j < 4; ++j) { const float e = (sacc[st][j] == -INFINITY) ? 0.f : __expf(sacc[st][j] - mx); sacc[st][j] = e; sum += e; }
        }
        sum += __shfl_xor(sum, 16); sum += __shfl_xor(sum, 32);
        const float inv = 1.0f / sum;
        if (qp == 0) LSE[((size_t)g * T + tokb + qpos) * 8 + h] = mx + __logf(sum);
        f32x4 oacc[4];
#pragma unroll
        for (int nt = 0; nt < 4; ++nt) oacc[nt] = (f32x4){0.f, 0.f, 0.f, 0.f};
        const LAS unsigned char* vb = VTL + r * DVP + (16 * wave + 4 * qp) * 2;
#pragma unroll
        for (int u = 0; u < 5; ++u) {
            u32x4_t w;
            w[0] = cvt_pk_bf16(sacc[2 * u][0], sacc[2 * u][1]); w[1] = cvt_pk_bf16(sacc[2 * u][2], sacc[2 * u][3]);
            if (u < 4) { w[2] = cvt_pk_bf16(sacc[2 * u + 1][0], sacc[2 * u + 1][1]); w[3] = cvt_pk_bf16(sacc[2 * u + 1][2], sacc[2 * u + 1][3]); } else { w[2] = 0u; w[3] = 0u; }
            const bf16x8_t pfr = __builtin_bit_cast(bf16x8_t, w);
#pragma unroll
            for (int nt = 0; nt < 4; ++nt) {
                const LAS unsigned char* bp = vb + nt * 16 * DVP + u * 64;
                const u32x2_t lo = *(const LAS u32x2_t*)bp, hi = *(const LAS u32x2_t*)(bp + 32);
                u32x4_t bw; bw[0] = lo[0]; bw[1] = lo[1]; bw[2] = hi[0]; bw[3] = hi[1];
                oacc[nt] = __builtin_amdgcn_mfma_f32_16x16x32_bf16(pfr, __builtin_bit_cast(bf16x8_t, bw), oacc[nt], 0, 0, 0);
            }
        }
        bf16_t* ob = (g == 2) ? Yo : (OB01 + (size_t)g * T * 512);
        const int opitch = (g == 2) ? 1024 : 512;
#pragma unroll
        for (int j = 0; j < 4; ++j) {
            const float is = __shfl(inv, qp * 4 + j);
            const int tq = tokb + (128 * nbi + 16 * wave + 4 * qp + j) * dil + res;
            bf16_t* op = ob + (size_t)tq * opitch + h * 64 + r;
#pragma unroll
            for (int nt = 0; nt < 4; ++nt) op[16 * nt] = f2bf(oacc[nt][j] * is);
        }
        unit = nxt;
    }
    __syncthreads();
}
#undef DIL_ISSUE
#undef DIL_DECODE
__device__ __forceinline__ void dil_combine(const bf16_t* OB01, bf16_t* Yo, const float* LSE) {
    const int tid = opaque_tid();
    for (int idx = blockIdx.x * 512 + tid; idx < T * 64; idx += gridDim.x * 512) {
        const int t = idx >> 6, c8 = (idx & 63) * 8, h = c8 >> 6;
        const float l0 = LSE[((size_t)0 * T + t) * 8 + h], l1 = LSE[((size_t)1 * T + t) * 8 + h], l2 = LSE[((size_t)2 * T + t) * 8 + h];
        const float m = fmaxf(l0, fmaxf(l1, l2));
        float w0 = __expf(l0 - m), w1 = __expf(l1 - m), w2 = __expf(l2 - m);
        const float is = 1.0f / (w0 + w1 + w2); w0 *= is; w1 *= is; w2 *= is;
        const u32x4_t a = *(const u32x4_t*)(OB01 + (size_t)t * 512 + c8), bq = *(const u32x4_t*)(OB01 + (size_t)T * 512 + (size_t)t * 512 + c8), c = *(const u32x4_t*)(Yo + (size_t)t * 1024 + c8);
        u32x4_t o;
#pragma unroll
        for (int e = 0; e < 4; ++e) o[e] = cvt_pk_bf16(w0 * bflo(a[e]) + w1 * bflo(bq[e]) + w2 * bflo(c[e]), w0 * bfhi(a[e]) + w1 * bfhi(bq[e]) + w2 * bfhi(c[e]));
        *(u32x4_t*)(Yo + (size_t)t * 1024 + c8) = o;
    }
}

constexpr size_t TABB_WSB = 1280 * 1024, TABB_PWT = TABB_WSB + 4 * 128 * 128 * 2;
constexpr int EM_AL = RTILE, EM_DL = RTILE + 144 * RP;
__device__ __forceinline__ void even_mix_units(LAS unsigned char* lds, const bf16_t* Z0, const float* ssv, const bf16_t* WSB, const bf16_t* PWT, const float* sgu_norm, const float* sgu_b, bf16_t* Yo) {
    const int tid = opaque_tid(), lane = tid & 63, r = lane & 15, qp = lane >> 4;
    const int wave = __builtin_amdgcn_readfirstlane(tid >> 6);
    LAS unsigned char* VT = lds; LAS unsigned char* AL = lds + EM_AL; LAS unsigned char* DL = lds + EM_DL;
    for (int unit = blockIdx.x; unit < 2048; unit += gridDim.x) {
        const int chunk = unit >> 2, g = unit & 3, tok0 = chunk * 128, pos0 = tok0 & 2047, win = 2 << g;
        __syncthreads();
        for (int it = tid; it < 2048; it += 512) {
            const int row = it & 127, c8 = (it >> 7) * 8;
            const float rs = row_rstd(ssv, 8, tok0 + row, 1.0f / 512.0f);
            const u32x4_t a = *(const u32x4_t*)(Z0 + (size_t)(tok0 + row) * EVEN_IN + 1024 + g * 128 + c8);
#pragma unroll
            for (int e = 0; e < 4; ++e) {
                *(LAS unsigned short*)(VT + (c8 + 2 * e) * RP + row * 2) = f2bf(bflo(a[e]) * rs);
                *(LAS unsigned short*)(VT + (c8 + 2 * e + 1) * RP + row * 2) = f2bf(bfhi(a[e]) * rs);
            }
        }
        for (int it = tid; it < 143 * 16; it += 512) {
            const int rr = it >> 4, c8 = (it & 15) * 8;
            const bool valid = pos0 - 15 + rr >= 0;
            u32x4_t a = *(const u32x4_t*)(Z0 + (size_t)(valid ? tok0 - 15 + rr : tok0) * EVEN_IN + g * 128 + c8);
            if (!valid) a = (u32x4_t){0u, 0u, 0u, 0u};
            *(LAS u32x4_t*)(AL + rr * RP + c8 * 2) = a;
        }
        __syncthreads();
        for (int it = tid; it < 2048; it += 512) {
            const int t = it >> 4, c8 = (it & 15) * 8;
            float sum[8];
#pragma unroll
            for (int e = 0; e < 8; ++e) sum[e] = 0.f;
            for (int jj = 0; jj < win; ++jj) {
                const u32x4_t a = *(const LAS u32x4_t*)(AL + (t + 15 - jj) * RP + c8 * 2);
#pragma unroll
                for (int e = 0; e < 4; ++e) { sum[2 * e] += bflo(a[e]); sum[2 * e + 1] += bfhi(a[e]); }
            }
            const u32x4_t cur = *(const LAS u32x4_t*)(AL + (t + 15) * RP + c8 * 2);
            const float ic = 1.0f / (float)min(pos0 + t + 1, win);
            u32x4_t w;
#pragma unroll
            for (int e = 0; e < 4; ++e) w[e] = cvt_pk_bf16(sum[2 * e] * ic - bflo(cur[e]), sum[2 * e + 1] * ic - bfhi(cur[e]));
            *(LAS u32x4_t*)(DL + t * RP + c8 * 2) = w;
        }
        __syncthreads();
        {
            f32x4 acc[8];
#pragma unroll
            for (int nt = 0; nt < 8; ++nt) acc[nt] = (f32x4){0.f, 0.f, 0.f, 0.f};
#pragma unroll
            for (int ks = 0; ks < 4; ++ks) {
                if (32 * ks <= 16 * wave + 15) {
                    const bf16x8_t a = *(const bf16x8_t*)(WSB + (size_t)g * 16384 + (16 * wave + r) * 128 + 32 * ks + 8 * qp);
#pragma unroll
                    for (int nt = 0; nt < 8; ++nt) {
                        const bf16x8_t bv = *(const LAS bf16x8_t*)(VT + (16 * nt + r) * RP + (32 * ks + 8 * qp) * 2);
                        acc[nt] = __builtin_amdgcn_mfma_f32_16x16x32_bf16(a, bv, acc[nt], 0, 0, 0);
                    }
                }
            }
#pragma unroll
            for (int j = 0; j < 4; ++j) {
                const int t = 16 * wave + 4 * qp + j;
                const float bb = sgu_b[g * 128 + t];
                const bf16_t* up = Z0 + (size_t)(tok0 + t) * EVEN_IN + 512 + g * 128 + r;
                bf16_t* yp = Yo + (size_t)(tok0 + t) * 1024 + 512 + g * 128 + r;
#pragma unroll
                for (int nt = 0; nt < 8; ++nt) yp[16 * nt] = f2bf(bf2f(up[16 * nt]) * (acc[nt][j] * sgu_norm[g * 128 + 16 * nt + r] + bb));
            }
        }
        {
            f32x4 acc[8];
#pragma unroll
            for (int nt = 0; nt < 8; ++nt) acc[nt] = (f32x4){0.f, 0.f, 0.f, 0.f};
#pragma unroll
            for (int ks = 0; ks < 4; ++ks) {
                const bf16x8_t a = *(const LAS bf16x8_t*)(DL + (16 * wave + r) * RP + (32 * ks + 8 * qp) * 2);
#pragma unroll
                for (int nt = 0; nt < 8; ++nt) {
                    const bf16x8_t bv = *(const bf16x8_t*)(PWT + (size_t)g * 16384 + (16 * nt + r) * 128 + 32 * ks + 8 * qp);
                    acc[nt] = __builtin_amdgcn_mfma_f32_16x16x32_bf16(a, bv, acc[nt], 0, 0, 0);
                }
            }
#pragma unroll
            for (int j = 0; j < 4; ++j) {
                bf16_t* yp = Yo + (size_t)(tok0 + 16 * wave + 4 * qp + j) * 1024 + g * 128 + r;
#pragma unroll
                for (int nt = 0; nt < 8; ++nt) yp[16 * nt] = f2bf(acc[nt][j]);
            }
        }
    }
    __syncthreads();
}
#define PHASE_IDS() const int tid = opaque_tid(), lane = tid & 63, wave = tid >> 6; const int gw = blockIdx.x * 8 + wave, nw = gridDim.x * 8; const int gt = blockIdx.x * 512 + tid, nt = gridDim.x * 512; (void)lane; (void)gw; (void)nw; (void)gt; (void)nt;
#include <vector>

#define XB_TMO      128
#define XB_XCNT(j)  (256  + 64 * (j))
#define XB_XSUB(j)  (1280 + 64 * (j))
#define XB_XGEN(j)  (2304 + 64 * (j))
#define XB_TOP      3328
#define XB_TOPGEN   3392
#define XCD_BAR_WORDS 3456
#define XB_SPIN_CAP (1u << 18)

__device__ __forceinline__ unsigned xb_ld(unsigned* p)              { return __hip_atomic_load(p, __ATOMIC_RELAXED, __HIP_MEMORY_SCOPE_AGENT); }
__device__ __forceinline__ unsigned xb_add(unsigned* p, unsigned v) { return __hip_atomic_fetch_add(p, v, __ATOMIC_RELAXED, __HIP_MEMORY_SCOPE_AGENT); }
__device__ __forceinline__ unsigned xb_xcc_id() { return (unsigned)__builtin_amdgcn_s_getreg((3 << 11) | 20) & 0xFu; }
#define XB_SPIN(cond, bar) do { unsigned _sp = 0; while (cond) { __builtin_amdgcn_s_sleep(1); \
    if ((++_sp & 255u) == 0u) { if (xb_ld(&(bar)[XB_TMO])) break; if (_sp > XB_SPIN_CAP) { atomicAdd(&(bar)[XB_TMO], 1u); break; } } } } while (0)

struct XcdBarrier {
    unsigned* bar; unsigned x;
    volatile LAS unsigned* st;
};

__device__ __forceinline__ XcdBarrier xcd_barrier_post(unsigned* bar, volatile LAS unsigned* st) {
    XcdBarrier b; b.bar = bar; b.x = xb_xcc_id(); b.st = st;
    if (threadIdx.x == 0) (void)xb_add(&bar[XB_XCNT(b.x)], 1u);
    return b;
}
__device__ __forceinline__ void xcd_barrier_complete(unsigned* bar, unsigned x, unsigned& nloc, unsigned& nx) {
    const unsigned G = gridDim.x * gridDim.y * gridDim.z;
    unsigned sum, cnt, mine, sp = 0u;
    for (;;) {
        sum = 0u; cnt = 0u; mine = 0u;
#pragma unroll
        for (unsigned j = 0; j < 16; ++j) { const unsigned c = xb_ld(&bar[XB_XCNT(j)]); sum += c; cnt += (c > 0u) ? 1u : 0u; mine = (j == x) ? c : mine; }
        if (sum == G) break;
        __builtin_amdgcn_s_sleep(1);
        if ((++sp & 255u) == 0u) { if (xb_ld(&bar[XB_TMO])) break; if (sp > XB_SPIN_CAP) { atomicAdd(&bar[XB_TMO], 1u); break; } }
    }
    nloc = mine > 0u ? mine : 1u; nx = cnt > 0u ? cnt : 1u;
}

__device__ __forceinline__ void xcd_barrier(const XcdBarrier& b) {
    asm volatile("s_waitcnt vmcnt(0)" ::: "memory");
    __syncthreads();
    if (threadIdx.x == 0) {
        unsigned* bar = b.bar;
        __builtin_amdgcn_s_waitcnt(0);
        unsigned nloc = b.st[0], nx = b.st[1];
        if (nloc == 0u) { xcd_barrier_complete(bar, b.x, nloc, nx); b.st[0] = nloc; b.st[1] = nx; }
        const unsigned old = xb_add(&bar[XB_XSUB(b.x)], 1u);
        const unsigned gen = old / nloc;
        if (old + 1u == (gen + 1u) * nloc) {
            __builtin_amdgcn_fence(__ATOMIC_RELEASE, "agent");
            asm volatile("s_waitcnt vmcnt(0)" ::: "memory");
            const unsigned og = xb_add(&bar[XB_TOP], 1u);
            const unsigned tg = og / nx;
            if (og + 1u == (tg + 1u) * nx) xb_add(&bar[XB_TOPGEN], 1u);
            else XB_SPIN(xb_ld(&bar[XB_TOPGEN]) == tg, bar);
            __builtin_amdgcn_fence(__ATOMIC_ACQUIRE, "agent");
            xb_add(&bar[XB_XGEN(b.x)], 1u);
            asm volatile("s_waitcnt vmcnt(0)" ::: "memory");
        } else {
            XB_SPIN(xb_ld(&bar[XB_XGEN(b.x)]) == gen, bar);
            __builtin_amdgcn_fence(__ATOMIC_ACQUIRE, "agent");
            asm volatile("s_waitcnt vmcnt(0)" ::: "memory");
        }
    }
    __syncthreads();
}


#ifndef REP_GEMM
#define REP_GEMM 1
#endif
#ifndef REP_EM
#define REP_EM 1
#endif
#ifndef REP_DIL
#define REP_DIL 1
#endif
#ifndef REP_R1
#define REP_R1 1
#endif
#ifndef REP_R3
#define REP_R3 1
#endif
#ifndef REP_PRO
#define REP_PRO 1
#endif
#ifndef REP_SYNC
#define REP_SYNC 1
#endif
#define GSYNC() do { for (int rep_ = 0; rep_ < REP_SYNC; ++rep_) xcd_barrier(xb); } while (0)
constexpr int LDS_BYTES = 144 * 1024;

__global__ void __launch_bounds__(512) fwd_mega(Params p) {
    __shared__ __attribute__((aligned(16))) unsigned char lds_raw[LDS_BYTES];
    LAS unsigned char* lds = (LAS unsigned char*)lds_raw;
    cg::grid_group grid = cg::this_grid();
    __shared__ uint4 xb_words;
    if (threadIdx.x == 0) xb_words = make_uint4(0u, 0u, 0u, 0u);
    __syncthreads();
    const XcdBarrier xb = xcd_barrier_post((unsigned*)(p.ws + WS_BAR), (volatile LAS unsigned*)&xb_words);
    const float* x = p.in[0]; const float* mem = p.in[1];
    const float* even_mix_norm = p.in[2]; const float* even_w_in = p.in[3]; const float* pool_w = p.in[4]; const float* pool_scale = p.in[5];
    const float* sgu_norm = p.in[6]; const float* sgu_w = p.in[7]; const float* sgu_b = p.in[8]; const float* even_w_out = p.in[9];
    const float* odd_mix_norm = p.in[10]; const float* odd_w_in = p.in[11]; const float* odd_w_out = p.in[12];
    const float* xattn_norm = p.in[13]; const float* mem_norm = p.in[14]; const float* xattn_wq = p.in[15]; const float* xattn_wkv = p.in[16]; const float* xattn_wo = p.in[17];
    const float* ffn_norm = p.in[18]; const float* ffn_w_gate_up = p.in[19]; const float* ffn_w_down = p.in[20]; const float* final_norm = p.in[21];
    float* H = p.out;
    bf16_t* HB = (bf16_t*)(p.ws + WS_HB); bf16_t* Z = (bf16_t*)(p.ws + WS_Z); bf16_t* Y = (bf16_t*)(p.ws + WS_Y); bf16_t* WB = (bf16_t*)(p.ws + WS_W);
    bf16_t* MEMN = (bf16_t*)(p.ws + WS_MEMN); bf16_t* KV = (bf16_t*)(p.ws + WS_KV); float* SS = (float*)(p.ws + WS_SS); float* TAB = (float*)(p.ws + WS_TAB); float* SD = (float*)(p.ws + WS_SIDE); bf16_t* RET = (bf16_t*)(p.ws + WS_RET); LAS float* sred = (LAS float*)lds;

    for (int rep_ = 0; rep_ < REP_PRO; ++rep_) {
        LAS float* tile = (LAS float*)lds;
        conv_weight(even_w_in, even_mix_norm, WB + W_EIN, 1024, EVEN_IN, EVEN_IN, 0, tile);
        conv_weight(even_w_out, nullptr, WB + W_EOUT, 1024, 1024, 1024, 0, tile);
        conv_weight(odd_w_in, odd_mix_norm, WB + W_OIN, 1024, ODD_IN, ODD_IN, 1, tile);
        conv_weight(odd_w_out, nullptr, WB + W_OOUT, 1024, 1024, 1024, 0, tile);
        for (int l = 0; l < 2; ++l) {
            bf16_t* wl = WB + W_L0 + (size_t)l * WL_SIZE;
            conv_weight(xattn_wq + (size_t)l * 1024 * 1024, xattn_norm + l * 1024, wl + WL_Q, 1024, 1024, 1024, 2, tile);
            conv_weight(xattn_wkv + (size_t)l * 1024 * 2048, nullptr, wl + WL_KV, 1024, 2048, 2048, 0, tile);
            conv_weight(xattn_wo + (size_t)l * 1024 * 1024, nullptr, wl + WL_O, 1024, 1024, 1024, 0, tile);
            conv_weight(ffn_w_gate_up + (size_t)l * 1024 * GU, ffn_norm + l * 1024, wl + WL_GU, 1024, GU, GU, 3, tile);
            conv_weight(ffn_w_down + (size_t)l * DFF * 1024, nullptr, wl + WL_DN, DFF, 1024, 1024, 0, tile);
        }
        PHASE_IDS();
        for (int row0 = gw * 4; row0 < T; row0 += nw * 4) {
            float4 v[4][4];
#pragma unroll
            for (int rr = 0; rr < 4; ++rr)
#pragma unroll
                for (int i = 0; i < 4; ++i) v[rr][i] = ((const float4*)(x + (size_t)(row0 + rr) * 1024))[lane + 64 * i];
#pragma unroll
            for (int rr = 0; rr < 4; ++rr) {
                float s = 0.f;
#pragma unroll
                for (int i = 0; i < 4; ++i) {
                    const float4 q = v[rr][i];
                    s += (q.x * q.x + q.y * q.y) + (q.z * q.z + q.w * q.w);
                    uint2 w; w.x = cvt_pk_bf16(q.x, q.y); w.y = cvt_pk_bf16(q.z, q.w);
                    *(uint2*)(HB + (size_t)(row0 + rr) * 1024 + 4 * (lane + 64 * i)) = w;
                }
                s = wave_sum(s);
                if (lane < 4) SS[(size_t)(row0 + rr) * 16 + lane] = (lane == 0) ? s : 0.f;
            }
        }
        for (int row = gw; row < MROWS; row += nw) {
            const float4* xr = (const float4*)(mem + (size_t)row * 1024);
            float4 v[4]; float s = 0.f;
#pragma unroll
            for (int i = 0; i < 4; ++i) { v[i] = xr[lane + 64 * i]; s += (v[i].x * v[i].x + v[i].y * v[i].y) + (v[i].z * v[i].z + v[i].w * v[i].w); }
            s = wave_sum(s);
            const float rs = rsqrtf(s * (1.0f / 1024.0f) + 1e-6f);
#pragma unroll
            for (int l = 0; l < 2; ++l)
#pragma unroll
                for (int i = 0; i < 4; ++i) {
                    const float4 g = *(const float4*)(mem_norm + l * 1024 + 4 * (lane + 64 * i));
                    uint2 w; w.x = cvt_pk_bf16(v[i].x * rs * g.x, v[i].y * rs * g.y); w.y = cvt_pk_bf16(v[i].z * rs * g.z, v[i].w * rs * g.w);
                    *(uint2*)(MEMN + (size_t)l * MROWS * 1024 + (size_t)row * 1024 + 4 * (lane + 64 * i)) = w;
                }
        }
        for (int i = gt; i < 32 * 1024; i += nt) { const int b = i >> 10, k = i & 1023; SD[SD_H + k * 32 + b] = x[(size_t)b * 2048 * 1024 + k]; }
        {
            bf16_t* WSBw = (bf16_t*)(p.ws + WS_TAB + TABB_WSB); bf16_t* PWTw = (bf16_t*)(p.ws + WS_TAB + TABB_PWT);
            for (int i = gt; i < 4 * 128 * 128; i += nt) {
                const int g = i >> 14, a = (i >> 7) & 127, c = i & 127;
                WSBw[i] = f2bf(c <= a ? sgu_w[i] : 0.f);
                PWTw[i] = f2bf(pool_w[(size_t)g * 16384 + c * 128 + a] * pool_scale[g * 128 + a]);
            }
        }
        for (int i = gt; i < 2048 * 8; i += nt) { float s, c; sincos_d((double)(i >> 3) * p.inv_dil[i & 7], s, c); TAB[TAB_DC + i] = c; TAB[TAB_DS + i] = s; }
        for (int i = gt; i < 2048 * 64; i += nt) { float s, c; sincos_d((double)(i >> 6) * p.inv_ret[i & 63], s, c); TAB[TAB_RC + i] = c; TAB[TAB_RS + i] = s; }
    }
    grid.sync();

    {
        side_rstd(SD + SD_H, 1024, 1.0f / 1024.0f, sred);
        InPlain in{SD + SD_H, even_mix_norm}; EpStore ep{SD + SD_Z, sred + SRED_RSTD, 1.0f, 1};
        side_gemv(even_w_in + 512, EVEN_IN, 1024, 1024, in, ep, sred);
    }
    for (int g4 = 0; g4 < 4; ++g4) {
        const int l = g4 >> 1, isv = g4 & 1;
        const bf16_t* mn = MEMN + (size_t)l * MROWS * 1024; const bf16_t* wk = WB + W_L0 + (size_t)l * WL_SIZE + WL_KV;
        Epi<EP_PLAIN> E{KV + (size_t)l * MROWS * 2048 + (size_t)isv * MROWS * 1024, isv ? MROWS : 1024, nullptr, 0, nullptr, nullptr, nullptr};
        for (int rep_ = 0; rep_ < REP_GEMM; ++rep_) run_gemm<EP_PLAIN>(lds, isv ? wk + (size_t)1024 * 1024 : mn, isv ? mn : wk, isv ? 1024 : MROWS, isv ? MROWS : 1024, 1024, E, isv ? (int)(gridDim.x >> 1) : 0);
    }

    for (int layer = 0; layer < 2; ++layer) {
        const bf16_t* wl = WB + W_L0 + (size_t)layer * WL_SIZE;
        float* ss_base = SS + (size_t)(layer * 3 + 2) * SS_STRIDE;
        const float* ss_prev = (layer == 0) ? SS : SS + (size_t)4 * SS_STRIDE;
        const int ns_prev = (layer == 0) ? 4 : 16;
        if (layer == 0) {
            { Epi<EP_EVEN_IN> E{Z, EVEN_IN, ss_prev, ns_prev, nullptr, nullptr, SS + SS_STRIDE};
              for (int rep_ = 0; rep_ < REP_GEMM; ++rep_) run_gemm<EP_EVEN_IN>(lds, HB, WB + W_EIN, T, EVEN_IN, 1024, E); }
            GSYNC();
            {
                side_rstd(SD + SD_Z + 512 * 32, 512, 1.0f / 512.0f, sred);
                InSgu in{SD + SD_Z, sgu_w, sgu_b, sgu_norm, sred + SRED_RSTD};
                side_gemv_ks(even_w_out + (size_t)512 * 1024, 1024, 512, 1024, in, SD + SD_H, sred);
            }
            for (int rep_ = 0; rep_ < REP_EM; ++rep_) even_mix_units(lds, Z, SS + SS_STRIDE, (const bf16_t*)(p.ws + WS_TAB + TABB_WSB), (const bf16_t*)(p.ws + WS_TAB + TABB_PWT), sgu_norm, sgu_b, Y);
            GSYNC();
        } else {
            {
                side_rstd(SD + SD_H, 1024, 1.0f / 1024.0f, sred);
                InPlain in{SD + SD_H, ffn_norm}; EpStore ep{SD + SD_Z, sred + SRED_RSTD, 1.0f, 0};
                side_gemv(ffn_w_gate_up, GU, 1024, GU, in, ep, sred);
            }
            { Epi<EP_ODD_IN> E{Z, ODD_IN, ss_prev, ns_prev, nullptr, nullptr, nullptr};
              for (int rep_ = 0; rep_ < REP_GEMM; ++rep_) run_gemm<EP_ODD_IN>(lds, HB, WB + W_OIN, T, ODD_IN, 1024, E); }
            GSYNC();
            {
                InSwiglu in{SD + SD_Z};
                side_gemv_ks(ffn_w_down, 1024, DFF, 1024, in, SD + SD_H, sred);
            }
            for (int rep_ = 0; rep_ < REP_R1; ++rep_) ret_r1(lds, Z, TAB, RET);
            for (int rep_ = 0; rep_ < REP_DIL; ++rep_) dil_units(lds, Z, TAB, (bf16_t*)H, Y, SS + (size_t)6 * SS_STRIDE);
            GSYNC();
            {
                side_rstd(SD + SD_H, 1024, 1.0f / 1024.0f, sred);
                InPlain in{SD + SD_H, odd_mix_norm}; EpStore ep{SD + SD_Z, sred + SRED_RSTD, 1.0f, 0};
                side_gemv(odd_w_in + 1536, ODD_IN, 1024, 1024, in, ep, sred);
            }
            dil_combine((const bf16_t*)H, Y, SS + (size_t)6 * SS_STRIDE);
            ret_r2(RET);
            GSYNC();
            for (int rep_ = 0; rep_ < REP_R3; ++rep_) ret_r3(lds, Z, TAB, RET, SD + SD_Z, Y);
            GSYNC();
        }

        for (int sub = 0; sub < 3; ++sub) {
            const bf16_t* A = Y; const bf16_t* Bt = (layer == 0) ? (WB + W_EOUT) : (WB + W_OOUT); int K = 1024;
            if (sub == 1) {
                if (layer == 0) {
                PHASE_IDS();
                for (int item = gw; item < 4096; item += nw) {
                    const int i = item >> 2, h = item & 3;
                    const float4 w = *(const float4*)(xattn_wkv + (size_t)i * 2048 + h * 256 + lane * 4);
                    const float* qb = SD + SD_Q + (size_t)(h * 256 + lane * 4) * 32;
                    float mine = 0.f;
#pragma unroll
                    for (int b4 = 0; b4 < 8; ++b4) {
                        const float4 q0 = *(const float4*)(qb + b4 * 4), q1 = *(const float4*)(qb + 32 + b4 * 4), q2 = *(const float4*)(qb + 64 + b4 * 4), q3 = *(const float4*)(qb + 96 + b4 * 4);
                        const float s0 = wave_sum((w.x * q0.x + w.y * q1.x) + (w.z * q2.x + w.w * q3.x)), s1 = wave_sum((w.x * q0.y + w.y * q1.y) + (w.z * q2.y + w.w * q3.y));
                        const float s2 = wave_sum((w.x * q0.z + w.y * q1.z) + (w.z * q2.z + w.w * q3.z)), s3 = wave_sum((w.x * q0.w + w.y * q1.w) + (w.z * q2.w + w.w * q3.w));
                        if (lane == b4 * 4 + 0) mine = s0; if (lane == b4 * 4 + 1) mine = s1; if (lane == b4 * 4 + 2) mine = s2; if (lane == b4 * 4 + 3) mine = s3;
                    }
                    if (lane < 32) SD[SD_R + (size_t)(lane * 4 + h) * 1024 + i] = mine;
                }
            }
                { Epi<EP_SCALE> E{Y, 1024, ss_base, 16, nullptr, nullptr, nullptr};
                  for (int rep_ = 0; rep_ < REP_GEMM; ++rep_) run_gemm<EP_SCALE>(lds, HB, wl + WL_Q, T, 1024, 1024, E); }
                GSYNC();
                if (layer == 0) {
                    PHASE_IDS();
                    for (int item = gw; item < 8192; item += nw) {
                        const int b = item >> 8;
                        const float4* mr = (const float4*)(mem + (size_t)item * 1024);
                        float ssq = 0.f, a0 = 0.f, a1 = 0.f, a2 = 0.f, a3 = 0.f;
#pragma unroll
                        for (int q = 0; q < 4; ++q) {
                            const int idx = lane + 64 * q;
                            const float4 m = mr[idx], g = ((const float4*)mem_norm)[idx];
                            ssq += (m.x * m.x + m.y * m.y) + (m.z * m.z + m.w * m.w);
                            const float4 mg = make_float4(m.x * g.x, m.y * g.y, m.z * g.z, m.w * g.w);
                            const float4 r0 = ((const float4*)(SD + SD_R + (size_t)(b * 4 + 0) * 1024))[idx], r1 = ((const float4*)(SD + SD_R + (size_t)(b * 4 + 1) * 1024))[idx];
                            const float4 r2 = ((const float4*)(SD + SD_R + (size_t)(b * 4 + 2) * 1024))[idx], r3 = ((const float4*)(SD + SD_R + (size_t)(b * 4 + 3) * 1024))[idx];
                            a0 += (mg.x * r0.x + mg.y * r0.y) + (mg.z * r0.z + mg.w * r0.w); a1 += (mg.x * r1.x + mg.y * r1.y) + (mg.z * r1.z + mg.w * r1.w);
                            a2 += (mg.x * r2.x + mg.y * r2.y) + (mg.z * r2.z + mg.w * r2.w); a3 += (mg.x * r3.x + mg.y * r3.y) + (mg.z * r3.z + mg.w * r3.w);
                        }
                        ssq = wave_sum(ssq); a0 = wave_sum(a0); a1 = wave_sum(a1); a2 = wave_sum(a2); a3 = wave_sum(a3);
                        const float rs = rsqrtf(ssq * (1.0f / 1024.0f) + 1e-6f);
                        if (lane == 0) { const int j = item & 255; float* pp = SD + SD_P + (size_t)b * 4 * 256 + j; pp[0] = a0 * rs; pp[256] = a1 * rs; pp[512] = a2 * rs; pp[768] = a3 * rs; SD[SD_M + item] = rs; }
                    }
                }
                xattn_phase(lds, Y, KV + (size_t)layer * MROWS * 2048, KV + (size_t)layer * MROWS * 2048 + (size_t)MROWS * 1024);
                GSYNC();
                Bt = wl + WL_O;
            } else if (sub == 2) {
                if (layer == 0) {
                InHead in{SD + SD_T}; EpStore ep{SD + SD_O, nullptr, 1.0f, 0};
                side_gemv(xattn_wkv + 1024, 2048, 1024, 1024, in, ep, sred);
            }
                { Epi<EP_GU> E{Z, DFF, ss_base + SS_STRIDE, 16, nullptr, nullptr, nullptr};
                  for (int rep_ = 0; rep_ < REP_GEMM; ++rep_) run_gemm<EP_GU>(lds, HB, wl + WL_GU, T, GU, 1024, E); }
                GSYNC();
                A = Z; Bt = wl + WL_DN; K = DFF;
            }
            if (layer == 0 && sub == 0) {
                side_rstd(SD + SD_H, 1024, 1.0f / 1024.0f, sred);
                InPlain in{SD + SD_H, xattn_norm}; EpStore ep{SD + SD_Q, sred + SRED_RSTD, 0.0625f, 0};
                side_gemv(xattn_wq, 1024, 1024, 1024, in, ep, sred);
            }
            if (layer == 0 && sub == 1) {
                    PHASE_IDS();
                    LAS float* pl = sred; LAS float* prt = sred + 1024;
                    for (int item = blockIdx.x; item < 256; item += gridDim.x) {
                        const int b = item >> 3, il = tid & 127, i = (item & 7) * 128 + il, jg = tid >> 7;
                        if (wave < 4) {
                            const float* sp = SD + SD_P + (size_t)(b * 4 + wave) * 256;
                            float e0 = sp[lane], e1 = sp[lane + 64], e2 = sp[lane + 128], e3 = sp[lane + 192];
                            const float mx = wave_max(fmaxf(fmaxf(e0, e1), fmaxf(e2, e3)));
                            e0 = __expf(e0 - mx); e1 = __expf(e1 - mx); e2 = __expf(e2 - mx); e3 = __expf(e3 - mx);
                            const float inv = 1.0f / wave_sum((e0 + e1) + (e2 + e3));
                            const float* rm = SD + SD_M + b * 256;
                            pl[wave * 256 + lane] = e0 * inv * rm[lane]; pl[wave * 256 + lane + 64] = e1 * inv * rm[lane + 64];
                            pl[wave * 256 + lane + 128] = e2 * inv * rm[lane + 128]; pl[wave * 256 + lane + 192] = e3 * inv * rm[lane + 192];
                        }
                        __syncthreads();
                        float t0 = 0.f, t1 = 0.f, t2 = 0.f, t3 = 0.f;
                        const float* mc = mem + (size_t)b * 256 * 1024 + (size_t)(jg * 64) * 1024 + i;
#pragma unroll 16
                        for (int j = 0; j < 64; ++j) { const float m = mc[(size_t)j * 1024]; const int jj = jg * 64 + j; t0 += pl[jj] * m; t1 += pl[256 + jj] * m; t2 += pl[512 + jj] * m; t3 += pl[768 + jj] * m; }
                        prt[(jg * 4 + 0) * 128 + il] = t0; prt[(jg * 4 + 1) * 128 + il] = t1; prt[(jg * 4 + 2) * 128 + il] = t2; prt[(jg * 4 + 3) * 128 + il] = t3;
                        __syncthreads();
                        {
                            const int hh = tid >> 7;
                            const float tsum = (prt[(0 * 4 + hh) * 128 + il] + prt[(1 * 4 + hh) * 128 + il]) + (prt[(2 * 4 + hh) * 128 + il] + prt[(3 * 4 + hh) * 128 + il]);
                            SD[SD_T + ((size_t)hh * 1024 + i) * 32 + b] = tsum * mem_norm[i];
                        }
                        __syncthreads();
                    }
                }
            if (layer == 0 && sub == 2) {
                    InPlain in{SD + SD_O, nullptr};
                    side_gemv_ks(xattn_wo, 1024, 1024, 1024, in, SD + SD_H, sred);
                }
            { Epi<EP_RES> E{HB, 1024, nullptr, 0, HB, nullptr, ss_base + (size_t)sub * SS_STRIDE};
              run_gemm<EP_RES>(lds, A, Bt, T, 1024, K, E); }
            GSYNC();
        }
    }

    {
        const float* ssf = SS + (size_t)7 * SS_STRIDE;
        PHASE_IDS();
        for (int row = gw; row < T; row += nw) {
            const float sp = (lane < 16) ? ssf[(size_t)row * 16 + lane] : 0.f;
            const float rs = rsqrtf(wave_sum(sp) * (1.0f / 1024.0f) + 1e-6f);
            float4* hr = (float4*)(H + (size_t)row * 1024);
            const uint2* hb = (const uint2*)(HB + (size_t)row * 1024);
#pragma unroll
            for (int i = 0; i < 4; ++i) {
                const uint2 q = hb[lane + 64 * i];
                const float4 g = ((const float4*)final_norm)[lane + 64 * i];
                float4 v; v.x = bflo(q.x) * rs * g.x; v.y = bfhi(q.x) * rs * g.y; v.z = bflo(q.y) * rs * g.z; v.w = bfhi(q.y) * rs * g.w;
                hr[lane + 64 * i] = v;
            }
        }
    }
}

extern "C" void kernel_launch(void* const* d_in, const int* in_sizes, int n_in, void* d_out, int out_size, void* d_ws, size_t ws_size, hipStream_t stream) {
    static int grid_blocks = 0;
    if (grid_blocks == 0) {
        if (n_in != 22 || out_size != T * DM || ws_size < WS_END) { fprintf(stderr, "kernel_launch: unexpected shapes (n_in %d, out %d, ws %zu)\n", n_in, out_size, ws_size); grid_blocks = -1; return; }
        int dev = 0, cus = 0, per_cu = 0;
        hipGetDevice(&dev);
        hipDeviceGetAttribute(&cus, hipDeviceAttributeMultiprocessorCount, dev);
        hipOccupancyMaxActiveBlocksPerMultiprocessor(&per_cu, fwd_mega, 512, 0);
        if (per_cu < 1) per_cu = 1;
        if (per_cu > 1) per_cu = 1;
        grid_blocks = cus * per_cu;
    }
    if (grid_blocks < 0) return;
    Params p;
    memset(&p, 0, sizeof(p));
    for (int i = 0; i < 22; ++i) p.in[i] = (const float*)d_in[i];
    p.out = (float*)d_out; p.ws = (unsigned char*)d_ws;
    for (int i = 0; i < 8; ++i) p.inv_dil[i] = std::exp(-((double)i / 8.0) * std::log(500000.0));
    for (int i = 0; i < 64; ++i) p.inv_ret[i] = std::exp(-((double)i / 64.0) * std::log(10000.0));
    (void)hipMemsetAsync((char*)d_ws + WS_BAR, 0, XCD_BAR_WORDS * 4, stream);
    void* args[] = {&p};
    hipError_t e = hipLaunchCooperativeKernel((void*)fwd_mega, dim3(grid_blocks), dim3(512), args, 0, stream);
    if (e != hipSuccess) fprintf(stderr, "cooperative launch failed: %s (grid %d)\n", hipGetErrorString(e), grid_blocks);
}
```

```cpp
#include <hip/hip_runtime.h>
#include <hip/hip_cooperative_groups.h>
#include <cstdio>
#include <cmath>
namespace cg = cooperative_groups;
#include <cstring>
namespace pg8 {
#define PG8_LAS __attribute__((address_space(3)))
typedef unsigned short bf16_t;
typedef short bf16x8 __attribute__((ext_vector_type(8)));
typedef float f32x4 __attribute__((ext_vector_type(4)));
typedef unsigned u32x4 __attribute__((ext_vector_type(4)));
constexpr int BM = 256, BK = 64, HALF = 128, HTB = HALF * BK * 2  , STAGE_BYTES = 8 * HTB, NXCD = 8, WGM = 8;

__host__ __device__ __forceinline__ int lds_byte(int r, int c) { const int st = (r >> 4) * 2 + (c >> 5), rr = r & 15, cc = c & 31, ob = rr * 64 + cc * 2; return st * 1024 + (ob ^ (((ob >> 9) & 1) << 5)); }
__host__ __device__ __forceinline__ void stage_rc(int b, int& R, int& C) { const int st = b / 1024, sb = b % 1024, swz = sb ^ (((sb >> 9) & 1) << 5); R = (st >> 1) * 16 + swz / 64; C = (st & 1) * 32 + (swz % 64) / 2; }
__host__ __device__ __forceinline__ int perm32(int rho) { const int n = rho >> 4, i = rho & 15; return 8 * (i >> 2) + 4 * n + (i & 3); }

struct Unit { int pm, pn; };
struct Gemm { const bf16_t* A; const bf16_t* Bt; int M, N, K; };

struct StaticOrder {
    int nM, nN, nwg, G, c;
    __host__ __device__ void init(int M, int N, int G_, int c_) { nM = M / BM; nN = N / BM; nwg = nM * nN; G = G_; c = c_; }
    __host__ __device__ bool next(int i, Unit& u) const {
        const long L = (long)i * G + c; if (L >= nwg) return false;
        int wgid = (int)L; { const int q = nwg / NXCD, r = nwg % NXCD, xcd = wgid % NXCD, off = wgid / NXCD; wgid = (xcd < r ? xcd * (q + 1) : r * (q + 1) + (xcd - r) * q) + off; }
        const int nig = WGM * nN, gid = wgid / nig, fm = gid * WGM, gsz = (nM - fm) < WGM ? (nM - fm) : WGM;
        u.pm = fm + ((wgid % nig) % gsz); u.pn = (wgid % nig) / gsz; return true;
    }
    __device__ __forceinline__ void a_ready(const Unit&) const {}
    __device__ __forceinline__ void done(const Unit&) const {}
};
__device__ __forceinline__ unsigned cvt_pk_bf16(float lo, float hi) { unsigned r; asm volatile("v_cvt_pk_bf16_f32 %0, %1, %2" : "=v"(r) : "v"(lo), "v"(hi)); return r; }
typedef float f32x2 __attribute__((ext_vector_type(2)));
template <class Epi, class Sched, bool ALIGN_EPI = false, bool SP2 = false>
__device__ __forceinline__ void gemm_phase(PG8_LAS unsigned char* lds, const Gemm g, const Sched& S, const Epi& E) {
    int tid_o = threadIdx.x; asm volatile("" : "+v"(tid_o));
    const int tid = tid_o, wid = __builtin_amdgcn_readfirstlane(tid >> 6), lane = tid & 63, wr = wid >> 2, wc = wid & 3, fr = lane & 15, fq = lane >> 4;
    const int K = g.K, nt = K / BK;
    unsigned voffA[2], voffB[2];
#pragma unroll
    for (int i = 0; i < 2; ++i) { int R, C; stage_rc(tid * 16 + i * 8192, R, C); const int Rb = Epi::PERM ? ((R & ~31) + perm32(R & 31)) : R;
        voffA[i] = (unsigned)(R * K + C) * 2u; voffB[i] = (unsigned)(Rb * K + C) * 2u; }
    const size_t kstep = (size_t)(BK * 2);
    const size_t hstep = (size_t)HALF * K * 2;
    const size_t tstep = 2 * hstep;
    const unsigned ldsw = (unsigned)wid * 1024u;
    const int aoff = lds_byte(wr * 64 + fr, fq * 8), boff = lds_byte(wc * 32 + fr, fq * 8);
#define PG8_SA(b, h) (((b) * 2 + (h)) * HTB)
#define PG8_SB(b, h) ((4 + (b) * 2 + (h)) * HTB)
#define PG8_STAGE(bufoff, gbase, voff) do { const char* _gb = (const char*)(gbase); asm volatile("" : "+s"(_gb)); _Pragma("unroll") for (int _i = 0; _i < 2; ++_i) \
        __builtin_amdgcn_global_load_lds((const unsigned*)(_gb + (voff)[_i]), (PG8_LAS unsigned*)(lds + (bufoff) + ldsw + _i * 8192), 16, 0, 0); } while (0)
#define PG8_LDA(dst, b, h) do { _Pragma("unroll") for (int m = 0; m < 4; ++m) _Pragma("unroll") for (int k = 0; k < 2; ++k) dst[m][k] = *(const PG8_LAS bf16x8*)(lds + PG8_SA(b, h) + aoff + m * 2048 + k * 1024); } while (0)
#define PG8_LDB(dst, b, h) do { _Pragma("unroll") for (int n = 0; n < 2; ++n) _Pragma("unroll") for (int k = 0; k < 2; ++k) dst[n][k] = *(const PG8_LAS bf16x8*)(lds + PG8_SB(b, h) + boff + n * 2048 + k * 1024); } while (0)
#define PG8_MMA(ai, bj, At, Bt) do { __builtin_amdgcn_s_setprio(1); _Pragma("unroll") for (int m = 0; m < 4; ++m) _Pragma("unroll") for (int n = 0; n < 2; ++n) _Pragma("unroll") for (int k = 0; k < 2; ++k) \
        acc[ai][bj][m][n] = __builtin_amdgcn_mfma_f32_16x16x32_bf16(Bt[n][k], At[m][k], acc[ai][bj][m][n], 0, 0, 0); __builtin_amdgcn_s_setprio(0); } while (0)
#define PG8_WAIT_V(n) asm volatile("s_waitcnt vmcnt(" #n ")" ::: "memory")
#define PG8_WAIT_L(n) asm volatile("s_waitcnt lgkmcnt(" #n ")" ::: "memory")
#define PG8_BAR __builtin_amdgcn_s_barrier()
#define PG8_SCHED __builtin_amdgcn_sched_barrier(0)
    Unit cur, nxt; int ui = 0;
    if (!S.next(0, cur)) return;
    f32x4 acc[2][2][4][2];
#pragma unroll
    for (int a = 0; a < 2; ++a)
#pragma unroll
        for (int b = 0; b < 2; ++b)
#pragma unroll
            for (int m = 0; m < 4; ++m)
#pragma unroll
                for (int n = 0; n < 2; ++n) acc[a][b][m][n] = (f32x4){0.f, 0.f, 0.f, 0.f};
    bf16x8 At[4][2], B0[2][2], B1[2][2];
    const char* cA = (const char*)g.A + (size_t)cur.pm * tstep; const char* cB = (const char*)g.Bt + (size_t)cur.pn * tstep;
    S.a_ready(cur);
    if constexpr (SP2) {
        PG8_STAGE(PG8_SB(0, 0), cB, voffB); PG8_STAGE(PG8_SB(0, 1), cB + hstep, voffB); PG8_STAGE(PG8_SA(0, 0), cA, voffA); PG8_STAGE(PG8_SA(0, 1), cA + hstep, voffA);
        if (wr == 1) PG8_BAR;
        PG8_WAIT_V(2); PG8_BAR;
        PG8_STAGE(PG8_SB(1, 0), cB + kstep, voffB); PG8_STAGE(PG8_SA(1, 0), cA + kstep, voffA); PG8_STAGE(PG8_SB(1, 1), cB + hstep + kstep, voffB);
        PG8_WAIT_V(6); PG8_BAR;
    } else {
        PG8_STAGE(PG8_SB(0, 0), cB, voffB); PG8_STAGE(PG8_SA(0, 0), cA, voffA); PG8_STAGE(PG8_SB(0, 1), cB + hstep, voffB); PG8_STAGE(PG8_SA(0, 1), cA + hstep, voffA);
        if (wr == 1) PG8_BAR;
        PG8_WAIT_V(4); PG8_BAR;
        PG8_STAGE(PG8_SB(1, 0), cB + kstep, voffB); PG8_STAGE(PG8_SA(1, 0), cA + kstep, voffA); PG8_STAGE(PG8_SB(1, 1), cB + hstep + kstep, voffB);
        PG8_WAIT_V(6); PG8_BAR;
    }
    for (;;) {
        const bool has_next = S.next(ui + 1, nxt);
        const char* nA = has_next ? (const char*)g.A + (size_t)nxt.pm * tstep : cA; const char* nB = has_next ? (const char*)g.Bt + (size_t)nxt.pn * tstep : cB;
        for (int t = 0; t < nt; t += 2) {
            const bool last = (t == nt - 2);
            const char* a1 = cA + (size_t)(t + 1) * kstep;
            const char* a2 = last ? nA : cA + (size_t)(t + 2) * kstep; const char* b2 = last ? nB : cB + (size_t)(t + 2) * kstep;
            const char* a3 = a2 + kstep; const char* b3 = b2 + kstep;
            if (last && has_next) S.a_ready(nxt);
            if constexpr (SP2) {
            PG8_LDB(B0, 0, 0); PG8_LDB(B1, 0, 1); PG8_SCHED; PG8_LDA(At, 0, 0); PG8_STAGE(PG8_SA(1, 1), a1 + hstep, voffA);
            PG8_WAIT_V(8); PG8_WAIT_L(0); PG8_BAR; PG8_MMA(0, 0, At, B0); PG8_MMA(0, 1, At, B1); PG8_BAR; PG8_SCHED;
            PG8_LDA(At, 0, 1); PG8_STAGE(PG8_SB(0, 0), b2, voffB); PG8_STAGE(PG8_SB(0, 1), b2 + hstep, voffB); PG8_STAGE(PG8_SA(0, 0), a2, voffA);
            PG8_WAIT_V(8); PG8_WAIT_L(0); PG8_BAR; PG8_MMA(1, 0, At, B0); PG8_MMA(1, 1, At, B1); PG8_BAR; PG8_SCHED;
            PG8_LDB(B0, 1, 0); PG8_LDB(B1, 1, 1); PG8_SCHED; PG8_LDA(At, 1, 0); PG8_STAGE(PG8_SA(0, 1), a2 + hstep, voffA);
            PG8_WAIT_V(8); PG8_WAIT_L(0); PG8_BAR; PG8_MMA(0, 0, At, B0); PG8_MMA(0, 1, At, B1); PG8_BAR; PG8_SCHED;
            PG8_LDA(At, 1, 1); PG8_STAGE(PG8_SB(1, 0), b3, voffB); PG8_STAGE(PG8_SB(1, 1), b3 + hstep, voffB); PG8_STAGE(PG8_SA(1, 0), a3, voffA);
            PG8_WAIT_V(8); PG8_WAIT_L(0); PG8_BAR; PG8_MMA(1, 0, At, B0); PG8_MMA(1, 1, At, B1); PG8_BAR; PG8_SCHED;
            } else {
            PG8_LDB(B0, 0, 0); PG8_SCHED; PG8_LDA(At, 0, 0); PG8_STAGE(PG8_SA(1, 1), a1 + hstep, voffA);
            PG8_WAIT_L(8); PG8_BAR; PG8_WAIT_L(0); PG8_MMA(0, 0, At, B0); PG8_BAR; PG8_SCHED;
            PG8_LDB(B1, 0, 1); PG8_STAGE(PG8_SB(0, 0), b2, voffB);
            PG8_BAR; PG8_WAIT_L(0); PG8_MMA(0, 1, At, B1); PG8_BAR;
            PG8_LDA(At, 0, 1); PG8_STAGE(PG8_SA(0, 0), a2, voffA);
            PG8_BAR; PG8_WAIT_L(0); PG8_MMA(1, 0, At, B0); PG8_BAR; PG8_SCHED;
            PG8_STAGE(PG8_SB(0, 1), b2 + hstep, voffB);
            PG8_WAIT_V(6); PG8_BAR; PG8_MMA(1, 1, At, B1); PG8_BAR;
            PG8_LDB(B0, 1, 0); PG8_SCHED; PG8_LDA(At, 1, 0); PG8_STAGE(PG8_SA(0, 1), a2 + hstep, voffA);
            PG8_WAIT_L(8); PG8_BAR; PG8_WAIT_L(0); PG8_MMA(0, 0, At, B0); PG8_BAR; PG8_SCHED;
            PG8_LDB(B1, 1, 1); PG8_STAGE(PG8_SB(1, 0), b3, voffB);
            PG8_BAR; PG8_WAIT_L(0); PG8_MMA(0, 1, At, B1); PG8_BAR;
            PG8_LDA(At, 1, 1); PG8_STAGE(PG8_SA(1, 0), a3, voffA);
            PG8_BAR; PG8_WAIT_L(0); PG8_MMA(1, 0, At, B0); PG8_BAR; PG8_SCHED;
            PG8_STAGE(PG8_SB(1, 1), b3 + hstep, voffB);
            PG8_WAIT_V(6); PG8_BAR; PG8_MMA(1, 1, At, B1); PG8_BAR;
            }
        }
        if constexpr (ALIGN_EPI) { if (wr == 0) PG8_BAR; }
        if constexpr (!Epi::AFTER_DRAIN) { E(acc, cur, wr, wc, fr, fq); S.done(cur); }
        if (!has_next) break;
#pragma unroll
        for (int a = 0; a < 2; ++a)
#pragma unroll
            for (int b = 0; b < 2; ++b)
#pragma unroll
                for (int m = 0; m < 4; ++m)
#pragma unroll
                    for (int n = 0; n < 2; ++n) acc[a][b][m][n] = (f32x4){0.f, 0.f, 0.f, 0.f};
        cur = nxt; cA = nA; cB = nB; ++ui;
        if constexpr (ALIGN_EPI) { if (wr == 1) PG8_BAR; }
    }
    PG8_WAIT_V(0);
    if constexpr (!ALIGN_EPI) { if (wr == 0) PG8_BAR; }
    PG8_BAR;
    if constexpr (Epi::AFTER_DRAIN) { E.fused(acc, cur, wr, wc, fr, fq, lds, wid, lane); S.done(cur); }
#undef PG8_SA
#undef PG8_SB
#undef PG8_STAGE
#undef PG8_LDA
#undef PG8_LDB
#undef PG8_MMA
#undef PG8_WAIT_V
#undef PG8_WAIT_L
#undef PG8_BAR
#undef PG8_SCHED
}
}

using pg8::bf16_t; using pg8::f32x4; using pg8::Unit; using pg8::cvt_pk_bf16;
#define LAS __attribute__((address_space(3)))
constexpr int T = 65536, DM = 1024, SEQ = 2048, MROWS = 8192;
constexpr int EVEN_IN = 1536, ODD_IN = 3584, DFF = 2816, GU = 5632;
constexpr size_t MiB = 1024ull * 1024ull;
constexpr size_t WS_HB = 0, WS_Z = 128 * MiB, WS_Y = 576 * MiB, WS_W = 704 * MiB, WS_MEMN = 768 * MiB, WS_KV = 800 * MiB, WS_SS = 864 * MiB, WS_TAB = 896 * MiB, WS_SIDE = 898 * MiB, WS_RET = 906 * MiB, WS_BAR = 970 * MiB, WS_END = 971 * MiB;
constexpr size_t W_EIN = 0, W_EOUT = W_EIN + 1536ull * 1024, W_OIN = W_EOUT + 1024ull * 1024, W_OOUT = W_OIN + 3584ull * 1024, W_L0 = W_OOUT + 1024ull * 1024;
constexpr size_t WL_Q = 0, WL_KV = 1024ull * 1024, WL_O = WL_KV + 2048ull * 1024, WL_GU = WL_O + 1024ull * 1024, WL_DN = WL_GU + 5632ull * 1024, WL_SIZE = WL_DN + 1024ull * 2816;
static_assert((W_L0 + 2 * WL_SIZE) * 2 <= 64 * MiB, "weights region");
constexpr size_t SS_STRIDE = (size_t)T * 16;
constexpr size_t TAB_DC = 0, TAB_DS = 2048 * 8, TAB_RC = 2 * 2048 * 8, TAB_RS = TAB_RC + 2048 * 64;
constexpr size_t SD_H = 0, SD_Z = SD_H + 1024 * 32, SD_Q = SD_Z + 5632 * 32, SD_R = SD_Q + 1024 * 32, SD_P = SD_R + 32 * 4 * 1024, SD_M = SD_P + 32 * 4 * 256, SD_T = SD_M + 32 * 256, SD_O = SD_T + 4 * 1024 * 32, SD_END = SD_O + 1024 * 32;
static_assert(SD_END * 4 <= 8 * MiB, "side region");

typedef short bf16x8_t __attribute__((ext_vector_type(8)));
typedef unsigned u32x4_t __attribute__((ext_vector_type(4)));
typedef unsigned u32x2_t __attribute__((ext_vector_type(2)));
struct Params {
    const float* in[22];
    float* out;
    unsigned char* ws;
    double inv_dil[8];
    double inv_ret[64];
};

__device__ __forceinline__ int opaque_tid() { int t = threadIdx.x; asm volatile("" : "+v"(t)); return t; }
__device__ __forceinline__ int xcd_unit(int it, int total) {
    const int G = (int)gridDim.x, bx = (int)blockIdx.x;
    if ((G & 7) || (total & 7)) { const int u = it * G + bx; return u < total ? u : -1; }
    const int per = total >> 3, ny = G >> 3, idx = it * ny + (bx >> 3);
    return idx < per ? (bx & 7) * per + idx : -1;
}
#define LDS_BARRIER() do { asm volatile("s_waitcnt lgkmcnt(0)" ::: "memory"); __builtin_amdgcn_s_barrier(); asm volatile("" ::: "memory"); } while (0)
__device__ __forceinline__ float bf2f(unsigned short v) { return __uint_as_float((unsigned)v << 16); }
__device__ __forceinline__ float bflo(unsigned v) { return __uint_as_float(v << 16); }
__device__ __forceinline__ float bfhi(unsigned v) { return __uint_as_float(v & 0xffff0000u); }
__device__ __forceinline__ unsigned short f2bf(float f) { return (unsigned short)(cvt_pk_bf16(f, 0.f) & 0xffffu); }
__device__ __forceinline__ float dot8(const uint4 a, const uint4 b) {
    float s = bflo(a.x) * bflo(b.x); s += bfhi(a.x) * bfhi(b.x);
    s += bflo(a.y) * bflo(b.y); s += bfhi(a.y) * bfhi(b.y);
    s += bflo(a.z) * bflo(b.z); s += bfhi(a.z) * bfhi(b.z);
    s += bflo(a.w) * bflo(b.w); s += bfhi(a.w) * bfhi(b.w);
    return s;
}
__device__ __forceinline__ float wave_sum(float v) {
#pragma unroll
    for (int o = 32; o >= 1; o >>= 1) v += __shfl_xor(v, o);
    return v;
}
__device__ __forceinline__ float wave_max(float v) {
#pragma unroll
    for (int o = 32; o >= 1; o >>= 1) v = fmaxf(v, __shfl_xor(v, o));
    return v;
}
__device__ __forceinline__ float silu_f(float x) { return x * __builtin_amdgcn_rcpf(1.0f + __builtin_amdgcn_exp2f(-1.4426950408889634f * x)); }
__device__ __forceinline__ float gelu_tanh_f(float x) {
    const float y = 1.5957691216057308f * (x + 0.044715f * x * x * x);
    return x * __builtin_amdgcn_rcpf(1.0f + __builtin_amdgcn_exp2f(-1.4426950408889634f * y));
}
__device__ __forceinline__ float row_rstd(const float* ss, int nslot, int row, float inv_dim) {
    float s = 0.f;
    for (int i = 0; i < nslot; i += 4) { const float4 v = *(const float4*)(ss + (size_t)row * 16 + i); s += (v.x + v.y) + (v.z + v.w); }
    return rsqrtf(s * inv_dim + 1e-6f);
}
__device__ __forceinline__ float coop_rstd(const float* ss, int nslot, int row, int fq, float inv_dim) {
    float s = 0.f;
    if (4 * fq < nslot) { const float4 v = *(const float4*)(ss + (size_t)row * 16 + 4 * fq); s = (v.x + v.y) + (v.z + v.w); }
    s += __shfl_xor(s, 16); s += __shfl_xor(s, 32);
    return rsqrtf(s * inv_dim + 1e-6f);
}

enum { EP_EVEN_IN = 0, EP_RES = 1, EP_SCALE = 2, EP_GU = 3, EP_ODD_IN = 4, EP_PLAIN = 5 };
template <int MODE> struct Epi {
    static constexpr bool PERM = true, AFTER_DRAIN = false;
    bf16_t* O; int ldo;
    const float* ss_in; int ns_in;
    const bf16_t* res; float* hout;
    float* ss_out;
    __device__ __forceinline__ void operator()(const f32x4 (&acc)[2][2][4][2], const Unit& u, int wr, int wc, int fr_in, int fq_in) const {
        int fr = fr_in, fq = fq_in;
        asm volatile("" : "+v"(fr), "+v"(fq));
        const int row00 = u.pm * 256 + wr * 64 + fr;
        float rsv[2][4];
        if (MODE == EP_EVEN_IN || MODE == EP_SCALE || MODE == EP_GU || MODE == EP_ODD_IN) {
            float part[2][4];
#pragma unroll
            for (int ai = 0; ai < 2; ++ai)
#pragma unroll
                for (int m = 0; m < 4; ++m) {
                    float sp = 0.f;
                    if (4 * fq < ns_in) { const float4 v = *(const float4*)(ss_in + (size_t)(row00 + ai * 128 + m * 16) * 16 + 4 * fq); sp = (v.x + v.y) + (v.z + v.w); }
                    part[ai][m] = sp;
                }
#pragma unroll
            for (int ai = 0; ai < 2; ++ai)
#pragma unroll
                for (int m = 0; m < 4; ++m) { float sp = part[ai][m]; sp += __shfl_xor(sp, 16); sp += __shfl_xor(sp, 32); rsv[ai][m] = rsqrtf(sp * (1.0f / 1024.0f) + 1e-6f); }
        } else {
#pragma unroll
            for (int ai = 0; ai < 2; ++ai)
#pragma unroll
                for (int m = 0; m < 4; ++m) rsv[ai][m] = 1.0f;
        }
#pragma unroll
        for (int ai = 0; ai < 2; ++ai) {
            u32x4_t rres[4][2];
            if (MODE == EP_RES) {
#pragma unroll
                for (int m = 0; m < 4; ++m)
#pragma unroll
                    for (int bj = 0; bj < 2; ++bj) rres[m][bj] = *(const u32x4_t*)(res + (size_t)(row00 + ai * 128 + m * 16) * 1024 + u.pn * 256 + bj * 128 + wc * 32 + fq * 8);
            }
#pragma unroll
            for (int m = 0; m < 4; ++m) {
                const int row = row00 + ai * 128 + m * 16;
                const float rs = rsv[ai][m];
                if (MODE == EP_GU) {
                    const f32x4 g0 = acc[ai][0][m][0] * rs, g1 = acc[ai][0][m][1] * rs, u0 = acc[ai][1][m][0] * rs, u1 = acc[ai][1][m][1] * rs;
                    uint4 w;
                    w.x = cvt_pk_bf16(silu_f(g0[0]) * u0[0], silu_f(g0[1]) * u0[1]); w.y = cvt_pk_bf16(silu_f(g0[2]) * u0[2], silu_f(g0[3]) * u0[3]);
                    w.z = cvt_pk_bf16(silu_f(g1[0]) * u1[0], silu_f(g1[1]) * u1[1]); w.w = cvt_pk_bf16(silu_f(g1[2]) * u1[2], silu_f(g1[3]) * u1[3]);
                    *(uint4*)(O + (size_t)row * ldo + u.pn * 128 + wc * 32 + fq * 8) = w;
                } else {
                    float sq = 0.f;
#pragma unroll
                    for (int bj = 0; bj < 2; ++bj) {
                        const int col0 = u.pn * 256 + bj * 128 + wc * 32 + fq * 8;
                        f32x4 v0 = acc[ai][bj][m][0] * rs, v1 = acc[ai][bj][m][1] * rs;
                        if (MODE == EP_EVEN_IN) {
                            if (u.pn >= 2) {
#pragma unroll
                                for (int j = 0; j < 4; ++j) { v0[j] = gelu_tanh_f(v0[j]); v1[j] = gelu_tanh_f(v1[j]); }
                            }
                            if (u.pn >= 4) sq += (v0[0] * v0[0] + v0[1] * v0[1]) + (v0[2] * v0[2] + v0[3] * v0[3]) + (v1[0] * v1[0] + v1[1] * v1[1]) + (v1[2] * v1[2] + v1[3] * v1[3]);
                        }
                        if (MODE == EP_ODD_IN) {
                            if (u.pn >= 12) {
#pragma unroll
                                for (int j = 0; j < 4; ++j) { v0[j] = silu_f(v0[j]); v1[j] = silu_f(v1[j]); }
                            }
                        }
                        if (MODE == EP_RES) {
                            { const u32x4_t rr = rres[m][bj];
                              v0[0] += bflo(rr[0]); v0[1] += bfhi(rr[0]); v0[2] += bflo(rr[1]); v0[3] += bfhi(rr[1]); v1[0] += bflo(rr[2]); v1[1] += bfhi(rr[2]); v1[2] += bflo(rr[3]); v1[3] += bfhi(rr[3]); }
                            sq += (v0[0] * v0[0] + v0[1] * v0[1]) + (v0[2] * v0[2] + v0[3] * v0[3]) + (v1[0] * v1[0] + v1[1] * v1[1]) + (v1[2] * v1[2] + v1[3] * v1[3]);
                        }
                        uint4 w;
                        w.x = cvt_pk_bf16(v0[0], v0[1]); w.y = cvt_pk_bf16(v0[2], v0[3]); w.z = cvt_pk_bf16(v1[0], v1[1]); w.w = cvt_pk_bf16(v1[2], v1[3]);
                        *(uint4*)(O + (size_t)row * ldo + col0) = w;
                    }
                    if (MODE == EP_RES) {
                        sq += __shfl_xor(sq, 16); sq += __shfl_xor(sq, 32);
                        if (fq == 0) ss_out[(size_t)row * 16 + u.pn * 4 + wc] = sq;
                    }
                    if (MODE == EP_EVEN_IN) {
                        if (u.pn >= 4) {
                            sq += __shfl_xor(sq, 16); sq += __shfl_xor(sq, 32);
                            if (fq == 0) ss_out[(size_t)row * 16 + (u.pn - 4) * 4 + wc] = sq;
                        }
                    }
                }
            }
            asm volatile("" ::: "memory");
        }
    }
};

#ifndef GEMM_ALIGN
#define GEMM_ALIGN true
#endif
#ifndef GEMM_SP2
#define GEMM_SP2 true
#endif
template <int MODE>
__device__ __forceinline__ void run_gemm(LAS unsigned char* lds, const bf16_t* A, const bf16_t* Bt, int M, int N, int K, const Epi<MODE>& E, int rot = 0) {
#if defined(T_ONLYMODE)
    if (MODE != T_ONLYMODE) return;
#endif
    pg8::Gemm g{A, Bt, M, N, K};
    pg8::StaticOrder S; S.init(M, N, (int)gridDim.x, (int)((blockIdx.x + rot) % gridDim.x));
    pg8::gemm_phase<Epi<MODE>, pg8::StaticOrder, GEMM_ALIGN, GEMM_SP2>(lds, g, S, E);
}

__device__ __forceinline__ void conv_weight(const float* W, const float* gain, bf16_t* Bt, int K, int Nsrc, int N, int mode, LAS float*) {
    const int tid = opaque_tid(), nkt = K / 64, nnt = N / 64;
    const int tx = tid & 63, kq = tid >> 6;
    for (int tix = blockIdx.x; tix < nkt * nnt; tix += gridDim.x) {
        const int kt = tix % nkt, ntl = tix / nkt, k0 = kt * 64 + kq * 8, np = ntl * 64 + tx;
        int src = np; float cs = 1.0f;
        if (mode == 1) { if (np < 512) cs = 0.125f; else if (np >= 2048 && np < 2560) cs = 0.08838834764831845f; }
        else if (mode == 2) cs = 0.0625f;
        else if (mode == 3) { const int pn = np >> 8, r = np & 255; src = (r < 128) ? (pn * 128 + r) : (DFF + pn * 128 + (r - 128)); }
        float v[8];
#pragma unroll
        for (int j = 0; j < 8; ++j) v[j] = W[(size_t)(k0 + j) * Nsrc + src];
        if (gain) {
            const float4 g0 = *(const float4*)(gain + k0), g1 = *(const float4*)(gain + k0 + 4);
            v[0] *= g0.x; v[1] *= g0.y; v[2] *= g0.z; v[3] *= g0.w; v[4] *= g1.x; v[5] *= g1.y; v[6] *= g1.z; v[7] *= g1.w;
        }
        uint4 w;
        w.x = cvt_pk_bf16(v[0] * cs, v[1] * cs); w.y = cvt_pk_bf16(v[2] * cs, v[3] * cs); w.z = cvt_pk_bf16(v[4] * cs, v[5] * cs); w.w = cvt_pk_bf16(v[6] * cs, v[7] * cs);
        *(uint4*)(Bt + (size_t)np * K + k0) = w;
    }
}

__device__ __forceinline__ void sincos_d(double a, float& s_out, float& c_out) {
    const double k = rint(a * 0.63661977236758134308);
    const double r = (a - k * 1.57079632679489655800) - k * 6.12323399573676603587e-17;
    const double r2 = r * r;
    double sp = -1.0 / 1307674368000.0;
    sp = sp * r2 + 1.0 / 6227020800.0; sp = sp * r2 - 1.0 / 39916800.0; sp = sp * r2 + 1.0 / 362880.0; sp = sp * r2 - 1.0 / 5040.0; sp = sp * r2 + 1.0 / 120.0; sp = sp * r2 - 1.0 / 6.0; sp = sp * r2 + 1.0;
    const double sn = sp * r;
    double cp = 1.0 / 20922789888000.0;
    cp = cp * r2 - 1.0 / 87178291200.0; cp = cp * r2 + 1.0 / 479001600.0; cp = cp * r2 - 1.0 / 3628800.0; cp = cp * r2 + 1.0 / 40320.0; cp = cp * r2 - 1.0 / 720.0; cp = cp * r2 + 1.0 / 24.0; cp = cp * r2 - 0.5; cp = cp * r2 + 1.0;
    const int q = ((int)k) & 3;
    double s, c;
    if (q == 0) { s = sn; c = cp; } else if (q == 1) { s = cp; c = -sn; } else if (q == 2) { s = -sn; c = -cp; } else { s = -cp; c = sn; }
    s_out = (float)s; c_out = (float)c;
}


constexpr int SRED_RSTD = 512;
constexpr int SRED_GEMV = 1024;
__device__ __forceinline__ void side_rstd(const float* v_t, int K, float inv_dim, LAS float* red) {
    const int tid = opaque_tid(), b = tid & 31, part = tid >> 5;
    float s = 0.f;
    float s1 = 0.f, s2 = 0.f, s3 = 0.f;
    for (int k = part; k < K; k += 128) {
        const float x0 = v_t[k * 32 + b], x1 = v_t[(k + 16) * 32 + b], x2 = v_t[(k + 32) * 32 + b], x3 = v_t[(k + 48) * 32 + b];
        const float x4 = v_t[(k + 64) * 32 + b], x5 = v_t[(k + 80) * 32 + b], x6 = v_t[(k + 96) * 32 + b], x7 = v_t[(k + 112) * 32 + b];
        s += x0 * x0 + x4 * x4; s1 += x1 * x1 + x5 * x5; s2 += x2 * x2 + x6 * x6; s3 += x3 * x3 + x7 * x7;
    }
    s = (s + s1) + (s2 + s3);
    red[tid] = s;
    __syncthreads();
    if (tid < 32) { float t = 0.f; for (int q = 0; q < 16; ++q) t += red[q * 32 + tid]; red[SRED_RSTD + tid] = rsqrtf(t * inv_dim + 1e-6f); }
    __syncthreads();
}
constexpr int SRED_IN = SRED_GEMV + 8 * 32 * 64;
template <class InF, class EpiF>
__device__ __forceinline__ void side_gemv(const float* W, int ldw, int K, int N, const InF& in, const EpiF& epi, LAS float* red) {
    const int tid = opaque_tid(), lane = tid & 63;
    const int kg = __builtin_amdgcn_readfirstlane(tid >> 6);
    const int ns = K >> 8;
    for (int c = blockIdx.x; c < (N >> 6); c += gridDim.x) {
        float acc[32];
#pragma unroll
        for (int b = 0; b < 32; ++b) acc[b] = 0.f;
        float xs[16];
        int t0 = tid; asm volatile("" : "+v"(t0));
#pragma unroll
        for (int i = 0; i < 16; ++i) { const int idx = t0 + 512 * i, k = idx >> 5; xs[i] = in.v(k, idx & 31, c) * in.ws(k); }
        __syncthreads();
#pragma unroll
        for (int i = 0; i < 16; ++i) red[SRED_IN + t0 + 512 * i] = xs[i];
        __syncthreads();
        for (int sl = 0; sl < ns; ++sl) {
            const int ks = sl << 8;
            LAS float* xin = red + SRED_IN + (sl & 1) * 8192;
            const float* wp = W + (size_t)(ks + 32 * kg) * ldw + c * 64 + lane;
            float w[32];
#pragma unroll
            for (int i = 0; i < 32; ++i) w[i] = wp[(size_t)i * ldw];
            LAS float* wl = red + SRED_GEMV + (kg * 32) * 64 + lane;
#pragma unroll
            for (int i = 0; i < 32; ++i) wl[i * 64] = w[i];
            asm volatile("" ::: "memory");
            int t1 = tid; asm volatile("" : "+v"(t1));
            if (sl + 1 < ns) {
#pragma unroll
                for (int i = 0; i < 16; ++i) { const int idx = t1 + 512 * i, k = ks + 256 + (idx >> 5); xs[i] = in.v(k, idx & 31, c) * in.ws(k); }
            }
#pragma unroll 1
            for (int k4 = 0; k4 < 8; ++k4) {
                const LAS f32x4* xv = (const LAS f32x4*)(xin + (32 * kg + k4 * 4) * 32);
                const float w0 = wl[(k4 * 4) * 64], w1 = wl[(k4 * 4 + 1) * 64], w2 = wl[(k4 * 4 + 2) * 64], w3 = wl[(k4 * 4 + 3) * 64];
#pragma unroll
                for (int q = 0; q < 8; ++q) {
                    const f32x4 x0 = xv[q], x1 = xv[8 + q], x2 = xv[16 + q], x3 = xv[24 + q];
                    acc[4 * q] += x0[0] * w0 + x1[0] * w1 + x2[0] * w2 + x3[0] * w3; acc[4 * q + 1] += x0[1] * w0 + x1[1] * w1 + x2[1] * w2 + x3[1] * w3;
                    acc[4 * q + 2] += x0[2] * w0 + x1[2] * w1 + x2[2] * w2 + x3[2] * w3; acc[4 * q + 3] += x0[3] * w0 + x1[3] * w1 + x2[3] * w2 + x3[3] * w3;
                }
            }
            if (sl + 1 < ns) {
                LAS float* xnx = red + SRED_IN + ((sl + 1) & 1) * 8192;
#pragma unroll
                for (int i = 0; i < 16; ++i) xnx[t1 + 512 * i] = xs[i];
            }
            __syncthreads();
        }
#pragma unroll
        for (int b = 0; b < 32; ++b) red[SRED_GEMV + (kg * 32 + b) * 64 + lane] = acc[b];
        __syncthreads();
#pragma unroll
        for (int i = 0; i < 4; ++i) {
            const int idx = tid + 512 * i, col = idx & 63, b = idx >> 6;
            float sum = 0.f;
#pragma unroll
            for (int g = 0; g < 8; ++g) sum += red[SRED_GEMV + (g * 32 + b) * 64 + col];
            epi(c * 64 + col, b, sum);
        }
        __syncthreads();
    }
}
template <class InF>
__device__ __forceinline__ void side_gemv_ks(const float* W, int ldw, int K, int N, const InF& in, float* h_t, LAS float* red) {
    const int tid = opaque_tid(), lane = tid & 63;
    const int kg = __builtin_amdgcn_readfirstlane(tid >> 6);
    const int ns = K >> 8, items = (N >> 6) * ns;
    for (int item = blockIdx.x; item < items; item += gridDim.x) {
        const int c = item / ns, ks = (item - c * ns) << 8;
        float xs[16];
        int t0 = tid; asm volatile("" : "+v"(t0));
#pragma unroll
        for (int i = 0; i < 16; ++i) { const int idx = t0 + 512 * i, k = ks + (idx >> 5); xs[i] = in.v(k, idx & 31, c) * in.ws(k); }
        float w[32];
        {
            const float* wp = W + (size_t)(ks + 32 * kg) * ldw + c * 64 + lane;
#pragma unroll
            for (int i = 0; i < 32; ++i) w[i] = wp[(size_t)i * ldw];
        }
        __syncthreads();
#pragma unroll
        for (int i = 0; i < 16; ++i) red[SRED_IN + t0 + 512 * i] = xs[i];
        LAS float* wl = red + SRED_GEMV + (kg * 32) * 64 + lane;
#pragma unroll
        for (int i = 0; i < 32; ++i) wl[i * 64] = w[i];
        __syncthreads();
        float acc[32];
#pragma unroll
        for (int b = 0; b < 32; ++b) acc[b] = 0.f;
        LAS float* xin = red + SRED_IN;
#pragma unroll 1
        for (int k4 = 0; k4 < 8; ++k4) {
            const LAS f32x4* xv = (const LAS f32x4*)(xin + (32 * kg + k4 * 4) * 32);
            const float w0 = wl[(k4 * 4) * 64], w1 = wl[(k4 * 4 + 1) * 64], w2 = wl[(k4 * 4 + 2) * 64], w3 = wl[(k4 * 4 + 3) * 64];
#pragma unroll
            for (int q = 0; q < 8; ++q) {
                const f32x4 x0 = xv[q], x1 = xv[8 + q], x2 = xv[16 + q], x3 = xv[24 + q];
                acc[4 * q] += x0[0] * w0 + x1[0] * w1 + x2[0] * w2 + x3[0] * w3; acc[4 * q + 1] += x0[1] * w0 + x1[1] * w1 + x2[1] * w2 + x3[1] * w3;
                acc[4 * q + 2] += x0[2] * w0 + x1[2] * w1 + x2[2] * w2 + x3[2] * w3; acc[4 * q + 3] += x0[3] * w0 + x1[3] * w1 + x2[3] * w2 + x3[3] * w3;
            }
        }
        __syncthreads();
#pragma unroll
        for (int b = 0; b < 32; ++b) red[SRED_GEMV + (kg * 32 + b) * 64 + lane] = acc[b];
        __syncthreads();
#pragma unroll
        for (int i = 0; i < 4; ++i) {
            const int idx = tid + 512 * i, col = idx & 63, b = idx >> 6;
            float sum = 0.f;
#pragma unroll
            for (int g = 0; g < 8; ++g) sum += red[SRED_GEMV + (g * 32 + b) * 64 + col];
            atomicAdd(h_t + (c * 64 + col) * 32 + b, sum);
        }
        __syncthreads();
    }
}
struct InPlain { const float* v_t; const float* gain; __device__ __forceinline__ float ws(int k) const { return gain ? gain[k] : 1.0f; } __device__ __forceinline__ float v(int k, int b, int) const { return v_t[k * 32 + b]; } };
struct InSgu { const float* z_t; const float* sgu_w; const float* sgu_b; const float* sgu_norm; const LAS float* rstdv;
    __device__ __forceinline__ float ws(int) const { return 1.0f; }
    __device__ __forceinline__ float v(int k, int b, int) const { const int g = k >> 7; return z_t[k * 32 + b] * (sgu_w[(size_t)g * 16384] * z_t[(512 + k) * 32 + b] * rstdv[b] * sgu_norm[k] + sgu_b[g * 128]); } };
struct InHead { const float* t_t; __device__ __forceinline__ float ws(int) const { return 1.0f; } __device__ __forceinline__ float v(int k, int b, int c) const { return t_t[((size_t)(c >> 2) * 1024 + k) * 32 + b]; } };
struct InSwiglu { const float* z_t; __device__ __forceinline__ float ws(int) const { return 1.0f; } __device__ __forceinline__ float v(int k, int b, int) const { return silu_f(z_t[k * 32 + b]) * z_t[(DFF + k) * 32 + b]; } };
struct EpStore { float* o_t; const LAS float* rstd; float scale; int act;
    __device__ __forceinline__ void operator()(int n, int b, float s) const { float v = s * scale * (rstd ? rstd[b] : 1.0f); if (act == 1) v = gelu_tanh_f(v); o_t[n * 32 + b] = v; } };
struct EpAdd { float* h_t; __device__ __forceinline__ void operator()(int n, int b, float s) const { h_t[n * 32 + b] += s; } };


__device__ __forceinline__ void xattn_phase(LAS unsigned char* lds, bf16_t* Yq, const bf16_t* Kmat, const bf16_t* VT) {
    const int tid = opaque_tid(), lane = tid & 63, r = lane & 15, qp = lane >> 4;
    const int wave = __builtin_amdgcn_readfirstlane(tid >> 6);
    constexpr int KS = 528;
    for (int trip = 0;; ++trip) {
        const int unit = xcd_unit(trip, 1024);
        if (unit < 0) break;
        const int b = unit >> 5, h = (unit >> 3) & 3, qb = unit & 7;
        __syncthreads();
        int tk = tid; asm volatile("" : "+v"(tk));
#pragma unroll
        for (int half = 0; half < 2; ++half) {
            u32x4_t tv[8];
#pragma unroll
            for (int i = 0; i < 8; ++i) { const int c = tk + 512 * (half * 8 + i), row = c >> 5, ch = c & 31; tv[i] = *(const u32x4_t*)(Kmat + (size_t)(b * 256 + row) * 1024 + h * 256 + ch * 8); }
#pragma unroll
            for (int i = 0; i < 8; ++i) { const int c = tk + 512 * (half * 8 + i), row = c >> 5, ch = c & 31; *(LAS u32x4_t*)(lds + row * KS + ch * 16) = tv[i]; }
        }
        __syncthreads();
        const int q0 = b * 2048 + qb * 256 + wave * 32;
        bf16x8_t pf[2][8];
        float inv[2];
        {
            f32x4 sacc[2][16];
#pragma unroll
            for (int kt = 0; kt < 16; ++kt) { sacc[0][kt] = (f32x4){0.f, 0.f, 0.f, 0.f}; sacc[1][kt] = (f32x4){0.f, 0.f, 0.f, 0.f}; }
            const bf16_t* qrow = Yq + (size_t)(q0 + r) * 1024 + h * 256 + qp * 8;
            const LAS unsigned char* kb = lds + r * KS + qp * 16; const LAS unsigned char* kb2 = kb + 8 * 16 * KS; asm volatile("" : "+v"(kb2));
            bf16x8_t qa = *(const bf16x8_t*)qrow, qb = *(const bf16x8_t*)(qrow + 16 * 1024);
#pragma unroll
            for (int ks = 0; ks < 8; ++ks) {
                const bf16x8_t qf0 = qa, qf1 = qb;
                if (ks < 7) { qa = *(const bf16x8_t*)(qrow + (ks + 1) * 32); qb = *(const bf16x8_t*)(qrow + 16 * 1024 + (ks + 1) * 32); }
#pragma unroll
                for (int kt = 0; kt < 16; ++kt) {
                    const bf16x8_t a = *(const LAS bf16x8_t*)((kt < 8 ? kb : kb2) + (kt & 7) * 16 * KS + ks * 64);
                    sacc[0][kt] = __builtin_amdgcn_mfma_f32_16x16x32_bf16(a, qf0, sacc[0][kt], 0, 0, 0);
                    sacc[1][kt] = __builtin_amdgcn_mfma_f32_16x16x32_bf16(a, qf1, sacc[1][kt], 0, 0, 0);
                }
            }
#pragma unroll
            for (int qt = 0; qt < 2; ++qt) {
                float mx = -INFINITY;
#pragma unroll
                for (int kt = 0; kt < 16; ++kt) mx = fmaxf(mx, fmaxf(fmaxf(sacc[qt][kt][0], sacc[qt][kt][1]), fmaxf(sacc[qt][kt][2], sacc[qt][kt][3])));
                mx = fmaxf(mx, __shfl_xor(mx, 16)); mx = fmaxf(mx, __shfl_xor(mx, 32));
                float sum = 0.f;
#pragma unroll
                for (int kt = 0; kt < 16; ++kt) {
#pragma unroll
                    for (int j = 0; j < 4; ++j) { const float e = __builtin_amdgcn_exp2f((sacc[qt][kt][j] - mx) * 1.4426950408889634f); sacc[qt][kt][j] = e; sum += e; }
                }
                sum += __shfl_xor(sum, 16); sum += __shfl_xor(sum, 32);
                inv[qt] = 1.0f / sum;
#pragma unroll
                for (int u = 0; u < 8; ++u) {
                    u32x4_t w;
                    w[0] = cvt_pk_bf16(sacc[qt][2 * u][0], sacc[qt][2 * u][1]); w[1] = cvt_pk_bf16(sacc[qt][2 * u][2], sacc[qt][2 * u][3]);
                    w[2] = cvt_pk_bf16(sacc[qt][2 * u + 1][0], sacc[qt][2 * u + 1][1]); w[3] = cvt_pk_bf16(sacc[qt][2 * u + 1][2], sacc[qt][2 * u + 1][3]);
                    pf[qt][u] = __builtin_bit_cast(bf16x8_t, w);
                }
            }
        }
        __syncthreads();
        int tv2 = tid; asm volatile("" : "+v"(tv2));
#pragma unroll 1
        for (int qd = 0; qd < 4; ++qd) {
            u32x4_t tv[4];
#pragma unroll
            for (int i = 0; i < 4; ++i) { const int c = tv2 + 512 * (qd * 4 + i), row = c >> 5, ch = c & 31; tv[i] = *(const u32x4_t*)(VT + (size_t)(h * 256 + row) * MROWS + b * 256 + ch * 8); }
#pragma unroll
            for (int i = 0; i < 4; ++i) { const int c = tv2 + 512 * (qd * 4 + i), row = c >> 5, ch = c & 31; *(LAS u32x4_t*)(lds + (((row & 15) << 4) | (row >> 4)) * KS + ch * 16) = tv[i]; }
        }
        __syncthreads();
        {
            f32x4 oacc[2][16];
#pragma unroll
            for (int nt = 0; nt < 16; ++nt) { oacc[0][nt] = (f32x4){0.f, 0.f, 0.f, 0.f}; oacc[1][nt] = (f32x4){0.f, 0.f, 0.f, 0.f}; }
            const LAS unsigned char* vb = lds + r * KS + qp * 8; const LAS unsigned char* vb2 = vb + 8 * 16 * KS; asm volatile("" : "+v"(vb2));
#pragma unroll
            for (int u = 0; u < 8; ++u)
#pragma unroll
                for (int nt = 0; nt < 16; ++nt) {
                    const LAS unsigned char* bp = (nt < 8 ? vb : vb2) + (nt & 7) * 16 * KS + u * 64;
                    const u32x2_t lo = *(const LAS u32x2_t*)bp, hi = *(const LAS u32x2_t*)(bp + 32);
                    u32x4_t w; w[0] = lo[0]; w[1] = lo[1]; w[2] = hi[0]; w[3] = hi[1];
                    const bf16x8_t bv = __builtin_bit_cast(bf16x8_t, w);
                    oacc[0][nt] = __builtin_amdgcn_mfma_f32_16x16x32_bf16(pf[0][u], bv, oacc[0][nt], 0, 0, 0);
                    oacc[1][nt] = __builtin_amdgcn_mfma_f32_16x16x32_bf16(pf[1][u], bv, oacc[1][nt], 0, 0, 0);
                }
            int r2 = r, qp2 = qp; asm volatile("" : "+v"(r2), "+v"(qp2));
#pragma unroll
            for (int qt = 0; qt < 2; ++qt)
#pragma unroll
                for (int j = 0; j < 4; ++j) {
                    const float is = __shfl(inv[qt], qp2 * 4 + j);
                    bf16_t* op = Yq + (size_t)(q0 + qt * 16 + qp2 * 4 + j) * 1024 + h * 256 + r2 * 16;
                    u32x4_t w0, w1;
#pragma unroll
                    for (int e = 0; e < 4; ++e) { w0[e] = cvt_pk_bf16(oacc[qt][2 * e][j] * is, oacc[qt][2 * e + 1][j] * is); w1[e] = cvt_pk_bf16(oacc[qt][8 + 2 * e][j] * is, oacc[qt][9 + 2 * e][j] * is); }
                    *(u32x4_t*)op = w0; *(u32x4_t*)(op + 8) = w1;
                }
        }
    }
    __syncthreads();
}

constexpr int RP = 272;
constexpr int RTILE = 128 * RP;
__device__ __forceinline__ float ret_lg2(int h) { return log2f(1.0f - exp2f(-5.0f - (float)h)); }
template <int TR>
__device__ __forceinline__ void ret_stage_rot(LAS unsigned char* dst, const bf16_t* Z1, int tok0, int col0, const float* TAB, float lg2, float sgn, int tid) {
    for (int it = tid; it < 1024; it += 512) {
        const int row = TR ? (it & 127) : (it >> 3), c8 = TR ? ((it >> 7) * 8) : ((it & 7) * 8);
        const bf16_t* zp = Z1 + (size_t)(tok0 + row) * ODD_IN + col0 + c8;
        const u32x4_t a = *(const u32x4_t*)zp, bq = *(const u32x4_t*)(zp + 64);
        const int pos = (tok0 + row) & 2047;
        const float4 c0 = *(const float4*)(TAB + TAB_RC + pos * 64 + c8), c1 = *(const float4*)(TAB + TAB_RC + pos * 64 + c8 + 4);
        const float4 s0 = *(const float4*)(TAB + TAB_RS + pos * 64 + c8), s1 = *(const float4*)(TAB + TAB_RS + pos * 64 + c8 + 4);
        const float sc = exp2f(sgn * (float)(row + 1) * lg2);
        const float x1[8] = {bflo(a[0]), bfhi(a[0]), bflo(a[1]), bfhi(a[1]), bflo(a[2]), bfhi(a[2]), bflo(a[3]), bfhi(a[3])};
        const float x2[8] = {bflo(bq[0]), bfhi(bq[0]), bflo(bq[1]), bfhi(bq[1]), bflo(bq[2]), bfhi(bq[2]), bflo(bq[3]), bfhi(bq[3])};
        const float cs[8] = {c0.x, c0.y, c0.z, c0.w, c1.x, c1.y, c1.z, c1.w};
        const float sn[8] = {s0.x, s0.y, s0.z, s0.w, s1.x, s1.y, s1.z, s1.w};
        float o1[8], o2[8];
#pragma unroll
        for (int e = 0; e < 8; ++e) { o1[e] = (x1[e] * cs[e] - x2[e] * sn[e]) * sc; o2[e] = (x1[e] * sn[e] + x2[e] * cs[e]) * sc; }
        if (TR == 0) {
            u32x4_t w1, w2;
#pragma unroll
            for (int e = 0; e < 4; ++e) { w1[e] = cvt_pk_bf16(o1[2 * e], o1[2 * e + 1]); w2[e] = cvt_pk_bf16(o2[2 * e], o2[2 * e + 1]); }
            *(LAS u32x4_t*)(dst + row * RP + c8 * 2) = w1; *(LAS u32x4_t*)(dst + row * RP + (64 + c8) * 2) = w2;
        } else {
#pragma unroll
            for (int e = 0; e < 8; ++e) {
                const int d1 = c8 + e, d2 = 64 + c8 + e;
                *(LAS unsigned short*)(dst + ((d1 & 7) * 16 + (d1 >> 3)) * RP + row * 2) = f2bf(o1[e]); *(LAS unsigned short*)(dst + ((d2 & 7) * 16 + (d2 >> 3)) * RP + row * 2) = f2bf(o2[e]);
            }
        }
    }
}
template <int PERM8>
__device__ __forceinline__ void stage_tr128(LAS unsigned char* dst, const bf16_t* src, int ld, int tok0, int col0, int tid) {
    for (int it = tid; it < 2048; it += 512) {
        const int row = it & 127, c8 = (it >> 7) * 8;
        const u32x4_t a = *(const u32x4_t*)(src + (size_t)(tok0 + row) * ld + col0 + c8);
#pragma unroll
        for (int e = 0; e < 4; ++e) {
            const int e0 = c8 + 2 * e, e1 = e0 + 1;
            *(LAS unsigned short*)(dst + (PERM8 ? ((e0 & 7) * 16 + (e0 >> 3)) : e0) * RP + row * 2) = (unsigned short)(a[e] & 0xffffu);
            *(LAS unsigned short*)(dst + (PERM8 ? ((e1 & 7) * 16 + (e1 >> 3)) : e1) * RP + row * 2) = (unsigned short)(a[e] >> 16);
        }
    }
}
__device__ __forceinline__ void ret_r1(LAS unsigned char* lds, const bf16_t* Z1, const float* TAB, bf16_t* RET) {
    const int tid = opaque_tid(), lane = tid & 63, r = lane & 15, qp = lane >> 4;
    const int wave = __builtin_amdgcn_readfirstlane(tid >> 6);
    LAS unsigned char* KT = lds; LAS unsigned char* VTL = lds + RTILE;
    for (int unit = blockIdx.x; unit < 2048; unit += gridDim.x) {
        const int b = unit >> 6, h = (unit >> 4) & 3, n = unit & 15, tok0 = b * 2048 + n * 128;
        const float lg2 = ret_lg2(h);
        __syncthreads();
        ret_stage_rot<1>(KT, Z1, tok0, 2048 + h * 128, TAB, lg2, -1.0f, tid);
        stage_tr128<0>(VTL, Z1, ODD_IN, tok0, 2560 + h * 128, tid);
        __syncthreads();
        f32x4 acc[8];
#pragma unroll
        for (int nt = 0; nt < 8; ++nt) acc[nt] = (f32x4){0.f, 0.f, 0.f, 0.f};
#pragma unroll
        for (int ks = 0; ks < 4; ++ks) {
            const bf16x8_t a = *(const LAS bf16x8_t*)(VTL + (16 * wave + r) * RP + (32 * ks + 8 * qp) * 2);
#pragma unroll
            for (int nt = 0; nt < 8; ++nt) {
                const bf16x8_t bv = *(const LAS bf16x8_t*)(KT + (16 * nt + r) * RP + (32 * ks + 8 * qp) * 2);
                acc[nt] = __builtin_amdgcn_mfma_f32_16x16x32_bf16(a, bv, acc[nt], 0, 0, 0);
            }
        }
        const float g128 = exp2f(128.0f * lg2);
        bf16_t* op = RET + (size_t)unit * 16384;
#pragma unroll
        for (int j = 0; j < 4; ++j) {
            u32x4_t w;
#pragma unroll
            for (int e = 0; e < 4; ++e) w[e] = cvt_pk_bf16(acc[2 * e][j] * g128, acc[2 * e + 1][j] * g128);
            *(u32x4_t*)(op + (16 * wave + 4 * qp + j) * 128 + 8 * r) = w;
        }
    }
    __syncthreads();
}
__device__ __forceinline__ void ret_r2(bf16_t* RET) {
    const int tid = opaque_tid();
    for (int idx = blockIdx.x * 512 + tid; idx < 128 * 8192; idx += gridDim.x * 512) {
        const int bh = idx >> 13, pr = idx & 8191;
        const float g128 = exp2f(128.0f * ret_lg2(bh & 3));
        unsigned* p = (unsigned*)(RET + (size_t)bh * 16 * 16384) + pr;
        float s0 = 0.f, s1 = 0.f;
        for (int n = 0; n < 16; ++n) {
            const unsigned v = p[(size_t)n * 8192];
            p[(size_t)n * 8192] = cvt_pk_bf16(s0, s1);
            s0 = s0 * g128 + bflo(v); s1 = s1 * g128 + bfhi(v);
        }
    }
}
__device__ __forceinline__ void ret_r3(LAS unsigned char* lds, const bf16_t* Z1, const float* TAB, const bf16_t* RET, const float* SDZ, bf16_t* Yo) {
    const int tid = opaque_tid(), lane = tid & 63, r = lane & 15, qp = lane >> 4;
    const int wave = __builtin_amdgcn_readfirstlane(tid >> 6);
    LAS unsigned char* QL = lds; LAS unsigned char* KL = lds + RTILE; LAS unsigned char* VTL = lds + 2 * RTILE; LAS unsigned char* PL = lds + 3 * RTILE;
    for (int unit = blockIdx.x; unit < 2048; unit += gridDim.x) {
        const int b = unit >> 6, h = (unit >> 4) & 3, n = unit & 15, tok0 = b * 2048 + n * 128;
        const float lg2 = ret_lg2(h);
        __syncthreads();
        ret_stage_rot<0>(QL, Z1, tok0, 1536 + h * 128, TAB, lg2, 1.0f, tid);
        ret_stage_rot<0>(KL, Z1, tok0, 2048 + h * 128, TAB, lg2, -1.0f, tid);
        stage_tr128<1>(VTL, Z1, ODD_IN, tok0, 2560 + h * 128, tid);
        for (int it = tid; it < 2048; it += 512) { const int row = it >> 4, c8 = (it & 15) * 8; *(LAS u32x4_t*)(PL + ((row & 7) * 16 + (row >> 3)) * RP + c8 * 2) = *(const u32x4_t*)(RET + (size_t)unit * 16384 + row * 128 + c8); }
        __syncthreads();
        bf16x8_t qf[4];
#pragma unroll
        for (int ks = 0; ks < 4; ++ks) qf[ks] = *(const LAS bf16x8_t*)(QL + (16 * wave + r) * RP + (32 * ks + 8 * qp) * 2);
        f32x4 sacc[8];
#pragma unroll
        for (int jt = 0; jt < 8; ++jt) {
            sacc[jt] = (f32x4){0.f, 0.f, 0.f, 0.f};
            if (jt <= wave) {
#pragma unroll
                for (int ks = 0; ks < 4; ++ks) {
                    const bf16x8_t a = *(const LAS bf16x8_t*)(KL + (16 * jt + r) * RP + (32 * ks + 8 * qp) * 2);
                    sacc[jt] = __builtin_amdgcn_mfma_f32_16x16x32_bf16(a, qf[ks], sacc[jt], 0, 0, 0);
                }
#pragma unroll
                for (int j = 0; j < 4; ++j) if (16 * jt + 4 * qp + j > 16 * wave + r) sacc[jt][j] = 0.f;
            }
        }
        if (n == 0 && wave == 0) {
            const float* zq = SDZ + (size_t)(h * 128) * 32 + b;
            const float c = wave_sum(zq[lane * 32] * zq[(512 + lane) * 32] + zq[(lane + 64) * 32] * zq[(512 + lane + 64) * 32]) * 0.08838834764831845f;
            if (lane == 0) sacc[0][0] = c;
        }
        bf16x8_t pf[4];
#pragma unroll
        for (int u = 0; u < 4; ++u) {
            u32x4_t w;
            w[0] = cvt_pk_bf16(sacc[2 * u][0], sacc[2 * u][1]); w[1] = cvt_pk_bf16(sacc[2 * u][2], sacc[2 * u][3]);
            w[2] = cvt_pk_bf16(sacc[2 * u + 1][0], sacc[2 * u + 1][1]); w[3] = cvt_pk_bf16(sacc[2 * u + 1][2], sacc[2 * u + 1][3]);
            pf[u] = __builtin_bit_cast(bf16x8_t, w);
        }
        f32x4 oacc[8];
#pragma unroll
        for (int nt = 0; nt < 8; ++nt) oacc[nt] = (f32x4){0.f, 0.f, 0.f, 0.f};
#pragma unroll
        for (int u = 0; u < 4; ++u) {
            if (2 * u <= wave) {
#pragma unroll
                for (int nt = 0; nt < 8; ++nt) {
                    const LAS unsigned char* bp = VTL + (16 * nt + r) * RP + (32 * u + 4 * qp) * 2;
                    const u32x2_t lo = *(const LAS u32x2_t*)bp, hi = *(const LAS u32x2_t*)(bp + 32);
                    u32x4_t w; w[0] = lo[0]; w[1] = lo[1]; w[2] = hi[0]; w[3] = hi[1];
                    oacc[nt] = __builtin_amdgcn_mfma_f32_16x16x32_bf16(pf[u], __builtin_bit_cast(bf16x8_t, w), oacc[nt], 0, 0, 0);
                }
            }
        }
#pragma unroll
        for (int ks = 0; ks < 4; ++ks)
#pragma unroll
            for (int nt = 0; nt < 8; ++nt) {
                const bf16x8_t bv = *(const LAS bf16x8_t*)(PL + (16 * nt + r) * RP + (32 * ks + 8 * qp) * 2);
                oacc[nt] = __builtin_amdgcn_mfma_f32_16x16x32_bf16(qf[ks], bv, oacc[nt], 0, 0, 0);
            }
#pragma unroll
        for (int j = 0; j < 4; ++j) {
            float sm = 0.f;
#pragma unroll
            for (int nt = 0; nt < 8; ++nt) sm += oacc[nt][j];
            sm += __shfl_xor(sm, 1); sm += __shfl_xor(sm, 2); sm += __shfl_xor(sm, 4); sm += __shfl_xor(sm, 8);
            const float mu = sm * (1.0f / 128.0f);
            float vr = 0.f;
#pragma unroll
            for (int nt = 0; nt < 8; ++nt) { const float d = oacc[nt][j] - mu; vr += d * d; }
            vr += __shfl_xor(vr, 1); vr += __shfl_xor(vr, 2); vr += __shfl_xor(vr, 4); vr += __shfl_xor(vr, 8);
            const float rs = rsqrtf(vr * (1.0f / 128.0f) + 1e-6f);
            const size_t tok = (size_t)(tok0 + 16 * wave + 4 * qp + j);
            const u32x4_t gg = *(const u32x4_t*)(Z1 + tok * ODD_IN + 3072 + h * 128 + 8 * r);
            u32x4_t w;
#pragma unroll
            for (int e = 0; e < 4; ++e) w[e] = cvt_pk_bf16(bflo(gg[e]) * (oacc[2 * e][j] - mu) * rs, bfhi(gg[e]) * (oacc[2 * e + 1][j] - mu) * rs);
            *(u32x4_t*)(Yo + tok * 1024 + 512 + h * 128 + 8 * r) = w;
        }
    }
    __syncthreads();
}

constexpr int DKP = 144;
constexpr int DVP = 592;
constexpr int DK_BYTES = 256 * DKP;
#define DIL_DECODE(u) const int b = (u) / 384, v = (u) - b * 384, h = v / 48, v2 = v - h * 48, g = v2 >> 4, rb = v2 & 15; \
    const int lognb = 4 - 2 * g, dil = 1 << (2 * g), nbi = rb & ((1 << lognb) - 1), res = rb >> lognb; const int tokb = b * 2048
#define DIL_ISSUE(u) do { DIL_DECODE(u); const int row_ = (wave & 3) * 64 + lane, hh_ = wave >> 2; const int j_ = 128 * nbi - 128 + row_; validr = j_ >= 0; const int pos_ = validr ? j_ * dil + res : 0; \
    const bf16_t* zr_ = Z1 + (size_t)(tokb + pos_) * ODD_IN + h * 64 + hh_ * 32; \
    _Pragma("unroll") for (int i_ = 0; i_ < 4; ++i_) { kvr[i_] = *(const u32x4_t*)(zr_ + 512 + i_ * 8); vvr[i_] = *(const u32x4_t*)(zr_ + 1024 + i_ * 8); } \
    if (hh_ == 0) { const float* tc_ = TAB + TAB_DC + pos_ * 8; const float* ts_ = TAB + TAB_DS + pos_ * 8; kc0 = *(const float4*)tc_; kc1 = *(const float4*)(tc_ + 4); ks0 = *(const float4*)ts_; ks1 = *(const float4*)(ts_ + 4); } \
    const int qpos_ = (128 * nbi + 16 * wave + r) * dil + res; const bf16_t* qrow_ = Z1 + (size_t)(tokb + qpos_) * ODD_IN + h * 64 + qp * 8; \
    qr0 = *(const u32x4_t*)qrow_; qr1 = *(const u32x4_t*)(qrow_ + 32); \
    { const float* tc_ = TAB + TAB_DC + qpos_ * 8; const float* ts_ = TAB + TAB_DS + qpos_ * 8; qc0 = *(const float4*)tc_; qc1 = *(const float4*)(tc_ + 4); qs0 = *(const float4*)ts_; qs1 = *(const float4*)(ts_ + 4); } } while (0)
__device__ __forceinline__ void dil_units(LAS unsigned char* lds, const bf16_t* Z1, const float* TAB, bf16_t* OB01, bf16_t* Yo, float* LSE) {
    const int tid = opaque_tid(), lane = tid & 63, r = lane & 15, qp = lane >> 4;
    const int wave = __builtin_amdgcn_readfirstlane(tid >> 6);
    LAS unsigned char* KL = lds; LAS unsigned char* VTL = lds + DK_BYTES;
    __syncthreads();
    for (int i = tid; i < 64 * 16; i += 512) { const int d = i >> 4, c = i & 15; *(LAS unsigned*)(VTL + d * DVP + 512 + c * 4) = 0u; }
    u32x4_t kvr[4], vvr[4], qr0, qr1; float4 kc0, kc1, ks0, ks1, qc0, qc1, qs0, qs1; bool validr;
    kc0 = kc1 = ks0 = ks1 = make_float4(0.f, 0.f, 0.f, 0.f);
    int trip = 0, unit = xcd_unit(0, 12288);
    if (unit >= 0) DIL_ISSUE(unit);
    while (unit >= 0) {
        DIL_DECODE(unit);
        __syncthreads();
        {
            const int row = (wave & 3) * 64 + lane, hh = wave >> 2;
            u32x4_t kv[4], vv[4];
#pragma unroll
            for (int i = 0; i < 4; ++i) { kv[i] = validr ? kvr[i] : (u32x4_t){0u, 0u, 0u, 0u}; vv[i] = validr ? vvr[i] : (u32x4_t){0u, 0u, 0u, 0u}; }
#pragma unroll
            for (int i = 0; i < 4; ++i)
#pragma unroll
                for (int e = 0; e < 4; ++e) {
                    *(LAS unsigned short*)(VTL + ((hh * 4 + i) * 8 + 2 * e) * DVP + row * 2) = (unsigned short)(vv[i][e] & 0xffffu);
                    *(LAS unsigned short*)(VTL + ((hh * 4 + i) * 8 + 2 * e + 1) * DVP + row * 2) = (unsigned short)(vv[i][e] >> 16);
                }
            if (hh == 0) {
                const float cs[8] = {kc0.x, kc0.y, kc0.z, kc0.w, kc1.x, kc1.y, kc1.z, kc1.w}, sn[8] = {ks0.x, ks0.y, ks0.z, ks0.w, ks1.x, ks1.y, ks1.z, ks1.w};
                const u32x4_t k1 = kv[0], k2 = kv[1];
                const float x1[8] = {bflo(k1[0]), bfhi(k1[0]), bflo(k1[1]), bfhi(k1[1]), bflo(k1[2]), bfhi(k1[2]), bflo(k1[3]), bfhi(k1[3])};
                const float x2[8] = {bflo(k2[0]), bfhi(k2[0]), bflo(k2[1]), bfhi(k2[1]), bflo(k2[2]), bfhi(k2[2]), bflo(k2[3]), bfhi(k2[3])};
#pragma unroll
                for (int e = 0; e < 4; ++e) {
                    kv[0][e] = cvt_pk_bf16(x1[2 * e] * cs[2 * e] - x2[2 * e] * sn[2 * e], x1[2 * e + 1] * cs[2 * e + 1] - x2[2 * e + 1] * sn[2 * e + 1]);
                    kv[1][e] = cvt_pk_bf16(x1[2 * e] * sn[2 * e] + x2[2 * e] * cs[2 * e], x1[2 * e + 1] * sn[2 * e + 1] + x2[2 * e + 1] * cs[2 * e + 1]);
                }
            }
#pragma unroll
            for (int i = 0; i < 4; ++i) *(LAS u32x4_t*)(KL + row * DKP + (hh * 4 + i) * 16) = kv[i];
        }
        const int qi = 128 * nbi + 16 * wave + r, qpos = qi * dil + res;
        u32x4_t q0 = qr0; const u32x4_t q1 = qr1;
        {
            u32x4_t pr;
#pragma unroll
            for (int e = 0; e < 4; ++e) pr[e] = (unsigned)__shfl_xor((int)q0[e], 16);
            const float cs[8] = {qc0.x, qc0.y, qc0.z, qc0.w, qc1.x, qc1.y, qc1.z, qc1.w}, sn[8] = {qs0.x, qs0.y, qs0.z, qs0.w, qs1.x, qs1.y, qs1.z, qs1.w};
            const float own[8] = {bflo(q0[0]), bfhi(q0[0]), bflo(q0[1]), bfhi(q0[1]), bflo(q0[2]), bfhi(q0[2]), bflo(q0[3]), bfhi(q0[3])};
            const float oth[8] = {bflo(pr[0]), bfhi(pr[0]), bflo(pr[1]), bfhi(pr[1]), bflo(pr[2]), bfhi(pr[2]), bflo(pr[3]), bfhi(pr[3])};
            float o[8];
#pragma unroll
            for (int e = 0; e < 8; ++e) o[e] = (qp == 0) ? (own[e] * cs[e] - oth[e] * sn[e]) : (oth[e] * sn[e] + own[e] * cs[e]);
            if (qp < 2) {
#pragma unroll
                for (int e = 0; e < 4; ++e) q0[e] = cvt_pk_bf16(o[2 * e], o[2 * e + 1]);
            }
        }
        const bf16x8_t qf0 = __builtin_bit_cast(bf16x8_t, q0), qf1 = __builtin_bit_cast(bf16x8_t, q1);
        const int nxt = xcd_unit(++trip, 12288);
        if (nxt >= 0) DIL_ISSUE(nxt);
        __syncthreads();
        f32x4 sacc[9];
        const LAS unsigned char* kb = KL + (16 * wave + r) * DKP + qp * 16;
#pragma unroll
        for (int st = 0; st < 9; ++st) {
            const bf16x8_t a0 = *(const LAS bf16x8_t*)(kb + st * 16 * DKP), a1 = *(const LAS bf16x8_t*)(kb + st * 16 * DKP + 64);
            f32x4 acc = (f32x4){0.f, 0.f, 0.f, 0.f};
            acc = __builtin_amdgcn_mfma_f32_16x16x32_bf16(a0, qf0, acc, 0, 0, 0);
            acc = __builtin_amdgcn_mfma_f32_16x16x32_bf16(a1, qf1, acc, 0, 0, 0);
#pragma unroll
            for (int j = 0; j < 4; ++j) {
                const int dk = 16 * st + 4 * qp + j;
                const bool ok = (dk >= r) && (dk <= r + 128) && (nbi > 0 || 16 * wave + dk >= 128);
                acc[j] = ok ? acc[j] : -INFINITY;
            }
            sacc[st] = acc;
        }
        float mx = -INFINITY;
#pragma unroll
        for (int st = 0; st < 9; ++st) mx = fmaxf(mx, fmaxf(fmaxf(sacc[st][0], sacc[st][1]), fmaxf(sacc[st][2], sacc[st][3])));
        mx = fmaxf(mx, __shfl_xor(mx, 16)); mx = fmaxf(mx, __shfl_xor(mx, 32));
        float sum = 0.f;
#pragma unroll
        for (int st = 0; st < 9; ++st) {
#pragma unroll
            for (int j = 0; j < 4; ++j) { const float e = (sacc[st][j] == -INFINITY) ? 0.f : __expf(sacc[st][j] - mx); sacc[st][j] = e; sum += e; }
        }
        sum += __shfl_xor(sum, 16); sum += __shfl_xor(sum, 32);
        const float inv = 1.0f / sum;
        if (qp == 0) LSE[((size_t)g * T + tokb + qpos) * 8 + h] = mx + __logf(sum);
        f32x4 oacc[4];
#pragma unroll
        for (int nt = 0; nt < 4; ++nt) oacc[nt] = (f32x4){0.f, 0.f, 0.f, 0.f};
        const LAS unsigned char* vb = VTL + r * DVP + (16 * wave + 4 * qp) * 2;
#pragma unroll
        for (int u = 0; u < 5; ++u) {
            u32x4_t w;
            w[0] = cvt_pk_bf16(sacc[2 * u][0], sacc[2 * u][1]); w[1] = cvt_pk_bf16(sacc[2 * u][2], sacc[2 * u][3]);
            if (u < 4) { w[2] = cvt_pk_bf16(sacc[2 * u + 1][0], sacc[2 * u + 1][1]); w[3] = cvt_pk_bf16(sacc[2 * u + 1][2], sacc[2 * u + 1][3]); } else { w[2] = 0u; w[3] = 0u; }
            const bf16x8_t pfr = __builtin_bit_cast(bf16x8_t, w);
#pragma unroll
            for (int nt = 0; nt < 4; ++nt) {
                const LAS unsigned char* bp = vb + nt * 16 * DVP + u * 64;
                const u32x2_t lo = *(const LAS u32x2_t*)bp, hi = *(const LAS u32x2_t*)(bp + 32);
                u32x4_t bw; bw[0] = lo[0]; bw[1] = lo[1]; bw[2] = hi[0]; bw[3] = hi[1];
                oacc[nt] = __builtin_amdgcn_mfma_f32_16x16x32_bf16(pfr, __builtin_bit_cast(bf16x8_t, bw), oacc[nt], 0, 0, 0);
            }
        }
        bf16_t* ob = (g == 2) ? Yo : (OB01 + (size_t)g * T * 512);
        const int opitch = (g == 2) ? 1024 : 512;
#pragma unroll
        for (int j = 0; j < 4; ++j) {
            const float is = __shfl(inv, qp * 4 + j);
            const int tq = tokb + (128 * nbi + 16 * wave + 4 * qp + j) * dil + res;
            bf16_t* op = ob + (size_t)tq * opitch + h * 64 + r;
#pragma unroll
            for (int nt = 0; nt < 4; ++nt) op[16 * nt] = f2bf(oacc[nt][j] * is);
        }
        unit = nxt;
    }
    __syncthreads();
}
#undef DIL_ISSUE
#undef DIL_DECODE
__device__ __forceinline__ void dil_combine(const bf16_t* OB01, bf16_t* Yo, const float* LSE) {
    const int tid = opaque_tid();
    for (int idx = blockIdx.x * 512 + tid; idx < T * 64; idx += gridDim.x * 512) {
        const int t = idx >> 6, c8 = (idx & 63) * 8, h = c8 >> 6;
        const float l0 = LSE[((size_t)0 * T + t) * 8 + h], l1 = LSE[((size_t)1 * T + t) * 8 + h], l2 = LSE[((size_t)2 * T + t) * 8 + h];
        const float m = fmaxf(l0, fmaxf(l1, l2));
        float w0 = __expf(l0 - m), w1 = __expf(l1 - m), w2 = __expf(l2 - m);
        const float is = 1.0f / (w0 + w1 + w2); w0 *= is; w1 *= is; w2 *= is;
        const u32x4_t a = *(const u32x4_t*)(OB01 + (size_t)t * 512 + c8), bq = *(const u32x4_t*)(OB01 + (size_t)T * 512 + (size_t)t * 512 + c8), c = *(const u32x4_t*)(Yo + (size_t)t * 1024 + c8);
        u32x4_t o;
#pragma unroll
        for (int e = 0; e < 4; ++e) o[e] = cvt_pk_bf16(w0 * bflo(a[e]) + w1 * bflo(bq[e]) + w2 * bflo(c[e]), w0 * bfhi(a[e]) + w1 * bfhi(bq[e]) + w2 * bfhi(c[e]));
        *(u32x4_t*)(Yo + (size_t)t * 1024 + c8) = o;
    }
}

constexpr size_t TABB_WSB = 1280 * 1024, TABB_PWT = TABB_WSB + 4 * 128 * 128 * 2;
constexpr int EM_AL = RTILE, EM_DL = RTILE + 144 * RP;
__device__ __forceinline__ void even_mix_units(LAS unsigned char* lds, const bf16_t* Z0, const float* ssv, const bf16_t* WSB, const bf16_t* PWT, const float* sgu_norm, const float* sgu_b, bf16_t* Yo) {
    const int tid = opaque_tid(), lane = tid & 63, r = lane & 15, qp = lane >> 4;
    const int wave = __builtin_amdgcn_readfirstlane(tid >> 6);
    LAS unsigned char* VT = lds; LAS unsigned char* AL = lds + EM_AL; LAS unsigned char* DL = lds + EM_DL;
    for (int unit = blockIdx.x; unit < 2048; unit += gridDim.x) {
        const int chunk = unit >> 2, g = unit & 3, tok0 = chunk * 128, pos0 = tok0 & 2047, win = 2 << g;
        __syncthreads();
        for (int it = tid; it < 2048; it += 512) {
            const int row = it & 127, c8 = (it >> 7) * 8;
            const float rs = row_rstd(ssv, 8, tok0 + row, 1.0f / 512.0f);
            const u32x4_t a = *(const u32x4_t*)(Z0 + (size_t)(tok0 + row) * EVEN_IN + 1024 + g * 128 + c8);
#pragma unroll
            for (int e = 0; e < 4; ++e) {
                *(LAS unsigned short*)(VT + (c8 + 2 * e) * RP + row * 2) = f2bf(bflo(a[e]) * rs);
                *(LAS unsigned short*)(VT + (c8 + 2 * e + 1) * RP + row * 2) = f2bf(bfhi(a[e]) * rs);
            }
        }
        for (int it = tid; it < 143 * 16; it += 512) {
            const int rr = it >> 4, c8 = (it & 15) * 8;
            const bool valid = pos0 - 15 + rr >= 0;
            u32x4_t a = *(const u32x4_t*)(Z0 + (size_t)(valid ? tok0 - 15 + rr : tok0) * EVEN_IN + g * 128 + c8);
            if (!valid) a = (u32x4_t){0u, 0u, 0u, 0u};
            *(LAS u32x4_t*)(AL + rr * RP + c8 * 2) = a;
        }
        __syncthreads();
        for (int it = tid; it < 2048; it += 512) {
            const int t = it >> 4, c8 = (it & 15) * 8;
            float sum[8];
#pragma unroll
            for (int e = 0; e < 8; ++e) sum[e] = 0.f;
            for (int jj = 0; jj < win; ++jj) {
                const u32x4_t a = *(const LAS u32x4_t*)(AL + (t + 15 - jj) * RP + c8 * 2);
#pragma unroll
                for (int e = 0; e < 4; ++e) { sum[2 * e] += bflo(a[e]); sum[2 * e + 1] += bfhi(a[e]); }
            }
            const u32x4_t cur = *(const LAS u32x4_t*)(AL + (t + 15) * RP + c8 * 2);
            const float ic = 1.0f / (float)min(pos0 + t + 1, win);
            u32x4_t w;
#pragma unroll
            for (int e = 0; e < 4; ++e) w[e] = cvt_pk_bf16(sum[2 * e] * ic - bflo(cur[e]), sum[2 * e + 1] * ic - bfhi(cur[e]));
            *(LAS u32x4_t*)(DL + t * RP + c8 * 2) = w;
        }
        __syncthreads();
        {
            f32x4 acc[8];
#pragma unroll
            for (int nt = 0; nt < 8; ++nt) acc[nt] = (f32x4){0.f, 0.f, 0.f, 0.f};
#pragma unroll
            for (int ks = 0; ks < 4; ++ks) {
                if (32 * ks <= 16 * wave + 15) {
                    const bf16x8_t a = *(const bf16x8_t*)(WSB + (size_t)g * 16384 + (16 * wave + r) * 128 + 32 * ks + 8 * qp);
#pragma unroll
                    for (int nt = 0; nt < 8; ++nt) {
                        const bf16x8_t bv = *(const LAS bf16x8_t*)(VT + (16 * nt + r) * RP + (32 * ks + 8 * qp) * 2);
                        acc[nt] = __builtin_amdgcn_mfma_f32_16x16x32_bf16(a, bv, acc[nt], 0, 0, 0);
                    }
                }
            }
#pragma unroll
            for (int j = 0; j < 4; ++j) {
                const int t = 16 * wave + 4 * qp + j;
                const float bb = sgu_b[g * 128 + t];
                const bf16_t* up = Z0 + (size_t)(tok0 + t) * EVEN_IN + 512 + g * 128 + r;
                bf16_t* yp = Yo + (size_t)(tok0 + t) * 1024 + 512 + g * 128 + r;
#pragma unroll
                for (int nt = 0; nt < 8; ++nt) yp[16 * nt] = f2bf(bf2f(up[16 * nt]) * (acc[nt][j] * sgu_norm[g * 128 + 16 * nt + r] + bb));
            }
        }
        {
            f32x4 acc[8];
#pragma unroll
            for (int nt = 0; nt < 8; ++nt) acc[nt] = (f32x4){0.f, 0.f, 0.f, 0.f};
#pragma unroll
            for (int ks = 0; ks < 4; ++ks) {
                const bf16x8_t a = *(const LAS bf16x8_t*)(DL + (16 * wave + r) * RP + (32 * ks + 8 * qp) * 2);
#pragma unroll
                for (int nt = 0; nt < 8; ++nt) {
                    const bf16x8_t bv = *(const bf16x8_t*)(PWT + (size_t)g * 16384 + (16 * nt + r) * 128 + 32 * ks + 8 * qp);
                    acc[nt] = __builtin_amdgcn_mfma_f32_16x16x32_bf16(a, bv, acc[nt], 0, 0, 0);
                }
            }
#pragma unroll
            for (int j = 0; j < 4; ++j) {
                bf16_t* yp = Yo + (size_t)(tok0 + 16 * wave + 4 * qp + j) * 1024 + g * 128 + r;
#pragma unroll
                for (int nt = 0; nt < 8; ++nt) yp[16 * nt] = f2bf(acc[nt][j]);
            }
        }
    }
    __syncthreads();
}
#define PHASE_IDS() const int tid = opaque_tid(), lane = tid & 63, wave = tid >> 6; const int gw = blockIdx.x * 8 + wave, nw = gridDim.x * 8; const int gt = blockIdx.x * 512 + tid, nt = gridDim.x * 512; (void)lane; (void)gw; (void)nw; (void)gt; (void)nt;
#include <vector>

#define XB_TMO      128
#define XB_XCNT(j)  (256  + 64 * (j))
#define XB_XSUB(j)  (1280 + 64 * (j))
#define XB_XGEN(j)  (2304 + 64 * (j))
#define XB_TOP      3328
#define XB_TOPGEN   3392
#define XCD_BAR_WORDS 3456
#define XB_SPIN_CAP (1u << 18)

__device__ __forceinline__ unsigned xb_ld(unsigned* p)              { return __hip_atomic_load(p, __ATOMIC_RELAXED, __HIP_MEMORY_SCOPE_AGENT); }
__device__ __forceinline__ unsigned xb_add(unsigned* p, unsigned v) { return __hip_atomic_fetch_add(p, v, __ATOMIC_RELAXED, __HIP_MEMORY_SCOPE_AGENT); }
__device__ __forceinline__ unsigned xb_xcc_id() { return (unsigned)__builtin_amdgcn_s_getreg((3 << 11) | 20) & 0xFu; }
#define XB_SPIN(cond, bar) do { unsigned _sp = 0; while (cond) { __builtin_amdgcn_s_sleep(1); \
    if ((++_sp & 255u) == 0u) { if (xb_ld(&(bar)[XB_TMO])) break; if (_sp > XB_SPIN_CAP) { atomicAdd(&(bar)[XB_TMO], 1u); break; } } } } while (0)

struct XcdBarrier {
    unsigned* bar; unsigned x;
    volatile LAS unsigned* st;
};

__device__ __forceinline__ XcdBarrier xcd_barrier_post(unsigned* bar, volatile LAS unsigned* st) {
    XcdBarrier b; b.bar = bar; b.x = xb_xcc_id(); b.st = st;
    if (threadIdx.x == 0) (void)xb_add(&bar[XB_XCNT(b.x)], 1u);
    return b;
}
__device__ __forceinline__ void xcd_barrier_complete(unsigned* bar, unsigned x, unsigned& nloc, unsigned& nx) {
    const unsigned G = gridDim.x * gridDim.y * gridDim.z;
    unsigned sum, cnt, mine, sp = 0u;
    for (;;) {
        sum = 0u; cnt = 0u; mine = 0u;
#pragma unroll
        for (unsigned j = 0; j < 16; ++j) { const unsigned c = xb_ld(&bar[XB_XCNT(j)]); sum += c; cnt += (c > 0u) ? 1u : 0u; mine = (j == x) ? c : mine; }
        if (sum == G) break;
        __builtin_amdgcn_s_sleep(1);
        if ((++sp & 255u) == 0u) { if (xb_ld(&bar[XB_TMO])) break; if (sp > XB_SPIN_CAP) { atomicAdd(&bar[XB_TMO], 1u); break; } }
    }
    nloc = mine > 0u ? mine : 1u; nx = cnt > 0u ? cnt : 1u;
}

__device__ __forceinline__ void xcd_barrier(const XcdBarrier& b) {
    asm volatile("s_waitcnt vmcnt(0)" ::: "memory");
    __syncthreads();
    if (threadIdx.x == 0) {
        unsigned* bar = b.bar;
        __builtin_amdgcn_s_waitcnt(0);
        unsigned nloc = b.st[0], nx = b.st[1];
        if (nloc == 0u) { xcd_barrier_complete(bar, b.x, nloc, nx); b.st[0] = nloc; b.st[1] = nx; }
        const unsigned old = xb_add(&bar[XB_XSUB(b.x)], 1u);
        const unsigned gen = old / nloc;
        if (old + 1u == (gen + 1u) * nloc) {
            __builtin_amdgcn_fence(__ATOMIC_RELEASE, "agent");
            asm volatile("s_waitcnt vmcnt(0)" ::: "memory");
            const unsigned og = xb_add(&bar[XB_TOP], 1u);
            const unsigned tg = og / nx;
            if (og + 1u == (tg + 1u) * nx) xb_add(&bar[XB_TOPGEN], 1u);
            else XB_SPIN(xb_ld(&bar[XB_TOPGEN]) == tg, bar);
            __builtin_amdgcn_fence(__ATOMIC_ACQUIRE, "agent");
            xb_add(&bar[XB_XGEN(b.x)], 1u);
            asm volatile("s_waitcnt vmcnt(0)" ::: "memory");
        } else {
            XB_SPIN(xb_ld(&bar[XB_XGEN(b.x)]) == gen, bar);
            __builtin_amdgcn_fence(__ATOMIC_ACQUIRE, "agent");
            asm volatile("s_waitcnt vmcnt(0)" ::: "memory");
        }
    }
    __syncthreads();
}


#ifndef REP_GEMM
#define REP_GEMM 1
#endif
#ifndef REP_EM
#define REP_EM 1
#endif
#ifndef REP_DIL
#define REP_DIL 1
#endif
#ifndef REP_R1
#define REP_R1 1
#endif
#ifndef REP_R3
#define REP_R3 1
#endif
#ifndef REP_PRO
#define REP_PRO 1
#endif
#ifndef REP_SYNC
#define REP_SYNC 1
#endif
#define GSYNC() do { for (int rep_ = 0; rep_ < REP_SYNC; ++rep_) xcd_barrier(xb); } while (0)
constexpr int LDS_BYTES = 144 * 1024;

__global__ void __launch_bounds__(512) fwd_mega(Params p) {
    __shared__ __attribute__((aligned(16))) unsigned char lds_raw[LDS_BYTES];
    LAS unsigned char* lds = (LAS unsigned char*)lds_raw;
    cg::grid_group grid = cg::this_grid();
    __shared__ uint4 xb_words;
    if (threadIdx.x == 0) xb_words = make_uint4(0u, 0u, 0u, 0u);
    __syncthreads();
    const XcdBarrier xb = xcd_barrier_post((unsigned*)(p.ws + WS_BAR), (volatile LAS unsigned*)&xb_words);
    const float* x = p.in[0]; const float* mem = p.in[1];
    const float* even_mix_norm = p.in[2]; const float* even_w_in = p.in[3]; const float* pool_w = p.in[4]; const float* pool_scale = p.in[5];
    const float* sgu_norm = p.in[6]; const float* sgu_w = p.in[7]; const float* sgu_b = p.in[8]; const float* even_w_out = p.in[9];
    const float* odd_mix_norm = p.in[10]; const float* odd_w_in = p.in[11]; const float* odd_w_out = p.in[12];
    const float* xattn_norm = p.in[13]; const float* mem_norm = p.in[14]; const float* xattn_wq = p.in[15]; const float* xattn_wkv = p.in[16]; const float* xattn_wo = p.in[17];
    const float* ffn_norm = p.in[18]; const float* ffn_w_gate_up = p.in[19]; const float* ffn_w_down = p.in[20]; const float* final_norm = p.in[21];
    float* H = p.out;
    bf16_t* HB = (bf16_t*)(p.ws + WS_HB); bf16_t* Z = (bf16_t*)(p.ws + WS_Z); bf16_t* Y = (bf16_t*)(p.ws + WS_Y); bf16_t* WB = (bf16_t*)(p.ws + WS_W);
    bf16_t* MEMN = (bf16_t*)(p.ws + WS_MEMN); bf16_t* KV = (bf16_t*)(p.ws + WS_KV); float* SS = (float*)(p.ws + WS_SS); float* TAB = (float*)(p.ws + WS_TAB); float* SD = (float*)(p.ws + WS_SIDE); bf16_t* RET = (bf16_t*)(p.ws + WS_RET); LAS float* sred = (LAS float*)lds;

    for (int rep_ = 0; rep_ < REP_PRO; ++rep_) {
        LAS float* tile = (LAS float*)lds;
        conv_weight(even_w_in, even_mix_norm, WB + W_EIN, 1024, EVEN_IN, EVEN_IN, 0, tile);
        conv_weight(even_w_out, nullptr, WB + W_EOUT, 1024, 1024, 1024, 0, tile);
        conv_weight(odd_w_in, odd_mix_norm, WB + W_OIN, 1024, ODD_IN, ODD_IN, 1, tile);
        conv_weight(odd_w_out, nullptr, WB + W_OOUT, 1024, 1024, 1024, 0, tile);
        for (int l = 0; l < 2; ++l) {
            bf16_t* wl = WB + W_L0 + (size_t)l * WL_SIZE;
            conv_weight(xattn_wq + (size_t)l * 1024 * 1024, xattn_norm + l * 1024, wl + WL_Q, 1024, 1024, 1024, 2, tile);
            conv_weight(xattn_wkv + (size_t)l * 1024 * 2048, nullptr, wl + WL_KV, 1024, 2048, 2048, 0, tile);
            conv_weight(xattn_wo + (size_t)l * 1024 * 1024, nullptr, wl + WL_O, 1024, 1024, 1024, 0, tile);
            conv_weight(ffn_w_gate_up + (size_t)l * 1024 * GU, ffn_norm + l * 1024, wl + WL_GU, 1024, GU, GU, 3, tile);
            conv_weight(ffn_w_down + (size_t)l * DFF * 1024, nullptr, wl + WL_DN, DFF, 1024, 1024, 0, tile);
        }
        PHASE_IDS();
        for (int row0 = gw * 4; row0 < T; row0 += nw * 4) {
            float4 v[4][4];
#pragma unroll
            for (int rr = 0; rr < 4; ++rr)
#pragma unroll
                for (int i = 0; i < 4; ++i) v[rr][i] = ((const float4*)(x + (size_t)(row0 + rr) * 1024))[lane + 64 * i];
#pragma unroll
            for (int rr = 0; rr < 4; ++rr) {
                float s = 0.f;
#pragma unroll
                for (int i = 0; i < 4; ++i) {
                    const float4 q = v[rr][i];
                    s += (q.x * q.x + q.y * q.y) + (q.z * q.z + q.w * q.w);
                    uint2 w; w.x = cvt_pk_bf16(q.x, q.y); w.y = cvt_pk_bf16(q.z, q.w);
                    *(uint2*)(HB + (size_t)(row0 + rr) * 1024 + 4 * (lane + 64 * i)) = w;
                }
                s = wave_sum(s);
                if (lane < 4) SS[(size_t)(row0 + rr) * 16 + lane] = (lane == 0) ? s : 0.f;
            }
        }
        for (int row = gw; row < MROWS; row += nw) {
            const float4* xr = (const float4*)(mem + (size_t)row * 1024);
            float4 v[4]; float s = 0.f;
#pragma unroll
            for (int i = 0; i < 4; ++i) { v[i] = xr[lane + 64 * i]; s += (v[i].x * v[i].x + v[i].y * v[i].y) + (v[i].z * v[i].z + v[i].w * v[i].w); }
            s = wave_sum(s);
            const float rs = rsqrtf(s * (1.0f / 1024.0f) + 1e-6f);
#pragma unroll
            for (int l = 0; l < 2; ++l)
#pragma unroll
                for (int i = 0; i < 4; ++i) {
                    const float4 g = *(const float4*)(mem_norm + l * 1024 + 4 * (lane + 64 * i));
                    uint2 w; w.x = cvt_pk_bf16(v[i].x * rs * g.x, v[i].y * rs * g.y); w.y = cvt_pk_bf16(v[i].z * rs * g.z, v[i].w * rs * g.w);
                    *(uint2*)(MEMN + (size_t)l * MROWS * 1024 + (size_t)row * 1024 + 4 * (lane + 64 * i)) = w;
                }
        }
        for (int i = gt; i < 32 * 1024; i += nt) { const int b = i >> 10, k = i & 1023; SD[SD_H + k * 32 + b] = x[(size_t)b * 2048 * 1024 + k]; }
        {
            bf16_t* WSBw = (bf16_t*)(p.ws + WS_TAB + TABB_WSB); bf16_t* PWTw = (bf16_t*)(p.ws + WS_TAB + TABB_PWT);
            for (int i = gt; i < 4 * 128 * 128; i += nt) {
                const int g = i >> 14, a = (i >> 7) & 127, c = i & 127;
                WSBw[i] = f2bf(c <= a ? sgu_w[i] : 0.f);
                PWTw[i] = f2bf(pool_w[(size_t)g * 16384 + c * 128 + a] * pool_scale[g * 128 + a]);
            }
        }
        for (int i = gt; i < 2048 * 8; i += nt) { float s, c; sincos_d((double)(i >> 3) * p.inv_dil[i & 7], s, c); TAB[TAB_DC + i] = c; TAB[TAB_DS + i] = s; }
        for (int i = gt; i < 2048 * 64; i += nt) { float s, c; sincos_d((double)(i >> 6) * p.inv_ret[i & 63], s, c); TAB[TAB_RC + i] = c; TAB[TAB_RS + i] = s; }
    }
    grid.sync();

    {
        side_rstd(SD + SD_H, 1024, 1.0f / 1024.0f, sred);
        InPlain in{SD + SD_H, even_mix_norm}; EpStore ep{SD + SD_Z, sred + SRED_RSTD, 1.0f, 1};
        side_gemv(even_w_in + 512, EVEN_IN, 1024, 1024, in, ep, sred);
    }
    for (int g4 = 0; g4 < 4; ++g4) {
        const int l = g4 >> 1, isv = g4 & 1;
        const bf16_t* mn = MEMN + (size_t)l * MROWS * 1024; const bf16_t* wk = WB + W_L0 + (size_t)l * WL_SIZE + WL_KV;
        Epi<EP_PLAIN> E{KV + (size_t)l * MROWS * 2048 + (size_t)isv * MROWS * 1024, isv ? MROWS : 1024, nullptr, 0, nullptr, nullptr, nullptr};
        for (int rep_ = 0; rep_ < REP_GEMM; ++rep_) run_gemm<EP_PLAIN>(lds, isv ? wk + (size_t)1024 * 1024 : mn, isv ? mn : wk, isv ? 1024 : MROWS, isv ? MROWS : 1024, 1024, E, isv ? (int)(gridDim.x >> 1) : 0);
    }

    for (int layer = 0; layer < 2; ++layer) {
        const bf16_t* wl = WB + W_L0 + (size_t)layer * WL_SIZE;
        float* ss_base = SS + (size_t)(layer * 3 + 2) * SS_STRIDE;
        const float* ss_prev = (layer == 0) ? SS : SS + (size_t)4 * SS_STRIDE;
        const int ns_prev = (layer == 0) ? 4 : 16;
        if (layer == 0) {
            { Epi<EP_EVEN_IN> E{Z, EVEN_IN, ss_prev, ns_prev, nullptr, nullptr, SS + SS_STRIDE};
              for (int rep_ = 0; rep_ < REP_GEMM; ++rep_) run_gemm<EP_EVEN_IN>(lds, HB, WB + W_EIN, T, EVEN_IN, 1024, E); }
            GSYNC();
            {
                side_rstd(SD + SD_Z + 512 * 32, 512, 1.0f / 512.0f, sred);
                InSgu in{SD + SD_Z, sgu_w, sgu_b, sgu_norm, sred + SRED_RSTD};
                side_gemv_ks(even_w_out + (size_t)512 * 1024, 1024, 512, 1024, in, SD + SD_H, sred);
            }
            for (int rep_ = 0; rep_ < REP_EM; ++rep_) even_mix_units(lds, Z, SS + SS_STRIDE, (const bf16_t*)(p.ws + WS_TAB + TABB_WSB), (const bf16_t*)(p.ws + WS_TAB + TABB_PWT), sgu_norm, sgu_b, Y);
            GSYNC();
        } else {
            {
                side_rstd(SD + SD_H, 1024, 1.0f / 1024.0f, sred);
                InPlain in{SD + SD_H, ffn_norm}; EpStore ep{SD + SD_Z, sred + SRED_RSTD, 1.0f, 0};
                side_gemv(ffn_w_gate_up, GU, 1024, GU, in, ep, sred);
            }
            { Epi<EP_ODD_IN> E{Z, ODD_IN, ss_prev, ns_prev, nullptr, nullptr, nullptr};
              for (int rep_ = 0; rep_ < REP_GEMM; ++rep_) run_gemm<EP_ODD_IN>(lds, HB, WB + W_OIN, T, ODD_IN, 1024, E); }
            GSYNC();
            {
                InSwiglu in{SD + SD_Z};
                side_gemv_ks(ffn_w_down, 1024, DFF, 1024, in, SD + SD_H, sred);
            }
            for (int rep_ = 0; rep_ < REP_R1; ++rep_) ret_r1(lds, Z, TAB, RET);
            for (int rep_ = 0; rep_ < REP_DIL; ++rep_) dil_units(lds, Z, TAB, (bf16_t*)H, Y, SS + (size_t)6 * SS_STRIDE);
            GSYNC();
            {
                side_rstd(SD + SD_H, 1024, 1.0f / 1024.0f, sred);
                InPlain in{SD + SD_H, odd_mix_norm}; EpStore ep{SD + SD_Z, sred + SRED_RSTD, 1.0f, 0};
                side_gemv(odd_w_in + 1536, ODD_IN, 1024, 1024, in, ep, sred);
            }
            dil_combine((const bf16_t*)H, Y, SS + (size_t)6 * SS_STRIDE);
            ret_r2(RET);
            GSYNC();
            for (int rep_ = 0; rep_ < REP_R3; ++rep_) ret_r3(lds, Z, TAB, RET, SD + SD_Z, Y);
            GSYNC();
        }

        for (int sub = 0; sub < 3; ++sub) {
            const bf16_t* A = Y; const bf16_t* Bt = (layer == 0) ? (WB + W_EOUT) : (WB + W_OOUT); int K = 1024;
            if (sub == 1) {
                if (layer == 0) {
                PHASE_IDS();
                for (int item = gw; item < 4096; item += nw) {
                    const int i = item >> 2, h = item & 3;
                    const float4 w = *(const float4*)(xattn_wkv + (size_t)i * 2048 + h * 256 + lane * 4);
                    const float* qb = SD + SD_Q + (size_t)(h * 256 + lane * 4) * 32;
                    float mine = 0.f;
#pragma unroll
                    for (int b4 = 0; b4 < 8; ++b4) {
                        const float4 q0 = *(const float4*)(qb + b4 * 4), q1 = *(const float4*)(qb + 32 + b4 * 4), q2 = *(const float4*)(qb + 64 + b4 * 4), q3 = *(const float4*)(qb + 96 + b4 * 4);
                        const float s0 = wave_sum((w.x * q0.x + w.y * q1.x) + (w.z * q2.x + w.w * q3.x)), s1 = wave_sum((w.x * q0.y + w.y * q1.y) + (w.z * q2.y + w.w * q3.y));
                        const float s2 = wave_sum((w.x * q0.z + w.y * q1.z) + (w.z * q2.z + w.w * q3.z)), s3 = wave_sum((w.x * q0.w + w.y * q1.w) + (w.z * q2.w + w.w * q3.w));
                        if (lane == b4 * 4 + 0) mine = s0; if (lane == b4 * 4 + 1) mine = s1; if (lane == b4 * 4 + 2) mine = s2; if (lane == b4 * 4 + 3) mine = s3;
                    }
                    if (lane < 32) SD[SD_R + (size_t)(lane * 4 + h) * 1024 + i] = mine;
                }
            }
                { Epi<EP_SCALE> E{Y, 1024, ss_base, 16, nullptr, nullptr, nullptr};
                  for (int rep_ = 0; rep_ < REP_GEMM; ++rep_) run_gemm<EP_SCALE>(lds, HB, wl + WL_Q, T, 1024, 1024, E); }
                GSYNC();
                if (layer == 0) {
                    PHASE_IDS();
                    for (int item = gw; item < 8192; item += nw) {
                        const int b = item >> 8;
                        const float4* mr = (const float4*)(mem + (size_t)item * 1024);
                        float ssq = 0.f, a0 = 0.f, a1 = 0.f, a2 = 0.f, a3 = 0.f;
#pragma unroll
                        for (int q = 0; q < 4; ++q) {
                            const int idx = lane + 64 * q;
                            const float4 m = mr[idx], g = ((const float4*)mem_norm)[idx];
                            ssq += (m.x * m.x + m.y * m.y) + (m.z * m.z + m.w * m.w);
                            const float4 mg = make_float4(m.x * g.x, m.y * g.y, m.z * g.z, m.w * g.w);
                            const float4 r0 = ((const float4*)(SD + SD_R + (size_t)(b * 4 + 0) * 1024))[idx], r1 = ((const float4*)(SD + SD_R + (size_t)(b * 4 + 1) * 1024))[idx];
                            const float4 r2 = ((const float4*)(SD + SD_R + (size_t)(b * 4 + 2) * 1024))[idx], r3 = ((const float4*)(SD + SD_R + (size_t)(b * 4 + 3) * 1024))[idx];
                            a0 += (mg.x * r0.x + mg.y * r0.y) + (mg.z * r0.z + mg.w * r0.w); a1 += (mg.x * r1.x + mg.y * r1.y) + (mg.z * r1.z + mg.w * r1.w);
                            a2 += (mg.x * r2.x + mg.y * r2.y) + (mg.z * r2.z + mg.w * r2.w); a3 += (mg.x * r3.x + mg.y * r3.y) + (mg.z * r3.z + mg.w * r3.w);
                        }
                        ssq = wave_sum(ssq); a0 = wave_sum(a0); a1 = wave_sum(a1); a2 = wave_sum(a2); a3 = wave_sum(a3);
                        const float rs = rsqrtf(ssq * (1.0f / 1024.0f) + 1e-6f);
                        if (lane == 0) { const int j = item & 255; float* pp = SD + SD_P + (size_t)b * 4 * 256 + j; pp[0] = a0 * rs; pp[256] = a1 * rs; pp[512] = a2 * rs; pp[768] = a3 * rs; SD[SD_M + item] = rs; }
                    }
                }
                xattn_phase(lds, Y, KV + (size_t)layer * MROWS * 2048, KV + (size_t)layer * MROWS * 2048 + (size_t)MROWS * 1024);
                GSYNC();
                Bt = wl + WL_O;
            } else if (sub == 2) {
                if (layer == 0) {
                InHead in{SD + SD_T}; EpStore ep{SD + SD_O, nullptr, 1.0f, 0};
                side_gemv(xattn_wkv + 1024, 2048, 1024, 1024, in, ep, sred);
            }
                { Epi<EP_GU> E{Z, DFF, ss_base + SS_STRIDE, 16, nullptr, nullptr, nullptr};
                  for (int rep_ = 0; rep_ < REP_GEMM; ++rep_) run_gemm<EP_GU>(lds, HB, wl + WL_GU, T, GU, 1024, E); }
                GSYNC();
                A = Z; Bt = wl + WL_DN; K = DFF;
            }
            if (layer == 0 && sub == 0) {
                side_rstd(SD + SD_H, 1024, 1.0f / 1024.0f, sred);
                InPlain in{SD + SD_H, xattn_norm}; EpStore ep{SD + SD_Q, sred + SRED_RSTD, 0.0625f, 0};
                side_gemv(xattn_wq, 1024, 1024, 1024, in, ep, sred);
            }
            if (layer == 0 && sub == 1) {
                    PHASE_IDS();
                    LAS float* pl = sred; LAS float* prt = sred + 1024;
                    for (int item = blockIdx.x; item < 256; item += gridDim.x) {
                        const int b = item >> 3, il = tid & 127, i = (item & 7) * 128 + il, jg = tid >> 7;
                        if (wave < 4) {
                            const float* sp = SD + SD_P + (size_t)(b * 4 + wave) * 256;
                            float e0 = sp[lane], e1 = sp[lane + 64], e2 = sp[lane + 128], e3 = sp[lane + 192];
                            const float mx = wave_max(fmaxf(fmaxf(e0, e1), fmaxf(e2, e3)));
                            e0 = __expf(e0 - mx); e1 = __expf(e1 - mx); e2 = __expf(e2 - mx); e3 = __expf(e3 - mx);
                            const float inv = 1.0f / wave_sum((e0 + e1) + (e2 + e3));
                            const float* rm = SD + SD_M + b * 256;
                            pl[wave * 256 + lane] = e0 * inv * rm[lane]; pl[wave * 256 + lane + 64] = e1 * inv * rm[lane + 64];
                            pl[wave * 256 + lane + 128] = e2 * inv * rm[lane + 128]; pl[wave * 256 + lane + 192] = e3 * inv * rm[lane + 192];
                        }
                        __syncthreads();
                        float t0 = 0.f, t1 = 0.f, t2 = 0.f, t3 = 0.f;
                        const float* mc = mem + (size_t)b * 256 * 1024 + (size_t)(jg * 64) * 1024 + i;
#pragma unroll 16
                        for (int j = 0; j < 64; ++j) { const float m = mc[(size_t)j * 1024]; const int jj = jg * 64 + j; t0 += pl[jj] * m; t1 += pl[256 + jj] * m; t2 += pl[512 + jj] * m; t3 += pl[768 + jj] * m; }
                        prt[(jg * 4 + 0) * 128 + il] = t0; prt[(jg * 4 + 1) * 128 + il] = t1; prt[(jg * 4 + 2) * 128 + il] = t2; prt[(jg * 4 + 3) * 128 + il] = t3;
                        __syncthreads();
                        {
                            const int hh = tid >> 7;
                            const float tsum = (prt[(0 * 4 + hh) * 128 + il] + prt[(1 * 4 + hh) * 128 + il]) + (prt[(2 * 4 + hh) * 128 + il] + prt[(3 * 4 + hh) * 128 + il]);
                            SD[SD_T + ((size_t)hh * 1024 + i) * 32 + b] = tsum * mem_norm[i];
                        }
                        __syncthreads();
                    }
                }
            if (layer == 0 && sub == 2) {
                    InPlain in{SD + SD_O, nullptr};
                    side_gemv_ks(xattn_wo, 1024, 1024, 1024, in, SD + SD_H, sred);
                }
            { Epi<EP_RES> E{HB, 1024, nullptr, 0, HB, nullptr, ss_base + (size_t)sub * SS_STRIDE};
              run_gemm<EP_RES>(lds, A, Bt, T, 1024, K, E); }
            GSYNC();
        }
    }

    {
        const float* ssf = SS + (size_t)7 * SS_STRIDE;
        PHASE_IDS();
        for (int row = gw; row < T; row += nw) {
            const float sp = (lane < 16) ? ssf[(size_t)row * 16 + lane] : 0.f;
            const float rs = rsqrtf(wave_sum(sp) * (1.0f / 1024.0f) + 1e-6f);
            float4* hr = (float4*)(H + (size_t)row * 1024);
            const uint2* hb = (const uint2*)(HB + (size_t)row * 1024);
#pragma unroll
            for (int i = 0; i < 4; ++i) {
                const uint2 q = hb[lane + 64 * i];
                const float4 g = ((const float4*)final_norm)[lane + 64 * i];
                float4 v; v.x = bflo(q.x) * rs * g.x; v.y = bfhi(q.x) * rs * g.y; v.z = bflo(q.y) * rs * g.z; v.w = bfhi(q.y) * rs * g.w;
                hr[lane + 64 * i] = v;
            }
        }
    }
}

extern "C" void kernel_launch(void* const* d_in, const int* in_sizes, int n_in, void* d_out, int out_size, void* d_ws, size_t ws_size, hipStream_t stream) {
    static int grid_blocks = 0;
    if (grid_blocks == 0) {
        if (n_in != 22 || out_size != T * DM || ws_size < WS_END) { fprintf(stderr, "kernel_launch: unexpected shapes (n_in %d, out %d, ws %zu)\n", n_in, out_size, ws_size); grid_blocks = -1; return; }
        int dev = 0, cus = 0, per_cu = 0;
        hipGetDevice(&dev);
        hipDeviceGetAttribute(&cus, hipDeviceAttributeMultiprocessorCount, dev);
        hipOccupancyMaxActiveBlocksPerMultiprocessor(&per_cu, fwd_mega, 512, 0);
        if (per_cu < 1) per_cu = 1;
        if (per_cu > 1) per_cu = 1;
        grid_blocks = cus * per_cu;
    }
    if (grid_blocks < 0) return;
    Params p;
    memset(&p, 0, sizeof(p));
    for (int i = 0; i < 22; ++i) p.in[i] = (const float*)d_in[i];
    p.out = (float*)d_out; p.ws = (unsigned char*)d_ws;
    for (int i = 0; i < 8; ++i) p.inv_dil[i] = std::exp(-((double)i / 8.0) * std::log(500000.0));
    for (int i = 0; i < 64; ++i) p.inv_ret[i] = std::exp(-((double)i / 64.0) * std::log(10000.0));
    (void)hipMemsetAsync((char*)d_ws + WS_BAR, 0, XCD_BAR_WORDS * 4, stream);
    void* args[] = {&p};
    hipError_t e = hipLaunchCooperativeKernel((void*)fwd_mega, dim3(grid_blocks), dim3(512), args, 0, stream);
    if (e != hipSuccess) fprintf(stderr, "cooperative launch failed: %s (grid %d)\n", hipGetErrorString(e), grid_blocks);
}
```

```cpp
#include <hip/hip_runtime.h>
#include <hip/hip_cooperative_groups.h>
#include <cstdio>
#include <cmath>
namespace cg = cooperative_groups;
#include <cstring>
namespace pg8 {
#define PG8_LAS __attribute__((address_space(3)))
typedef unsigned short bf16_t;
typedef short bf16x8 __attribute__((ext_vector_type(8)));
typedef float f32x4 __attribute__((ext_vector_type(4)));
typedef unsigned u32x4 __attribute__((ext_vector_type(4)));
constexpr int BM = 256, BK = 64, HALF = 128, HTB = HALF * BK * 2  , STAGE_BYTES = 8 * HTB, NXCD = 8, WGM = 8;

__host__ __device__ __forceinline__ int lds_byte(int r, int c) { const int st = (r >> 4) * 2 + (c >> 5), rr = r & 15, cc = c & 31, ob = rr * 64 + cc * 2; return st * 1024 + (ob ^ (((ob >> 9) & 1) << 5)); }
__host__ __device__ __forceinline__ void stage_rc(int b, int& R, int& C) { const int st = b / 1024, sb = b % 1024, swz = sb ^ (((sb >> 9) & 1) << 5); R = (st >> 1) * 16 + swz / 64; C = (st & 1) * 32 + (swz % 64) / 2; }
__host__ __device__ __forceinline__ int perm32(int rho) { const int n = rho >> 4, i = rho & 15; return 8 * (i >> 2) + 4 * n + (i & 3); }

struct Unit { int pm, pn; };
struct Gemm { const bf16_t* A; const bf16_t* Bt; int M, N, K; };

struct StaticOrder {
    int nM, nN, nwg, G, c;
    __host__ __device__ void init(int M, int N, int G_, int c_) { nM = M / BM; nN = N / BM; nwg = nM * nN; G = G_; c = c_; }
    __host__ __device__ bool next(int i, Unit& u) const {
        const long L = (long)i * G + c; if (L >= nwg) return false;
        int wgid = (int)L; { const int q = nwg / NXCD, r = nwg % NXCD, xcd = wgid % NXCD, off = wgid / NXCD; wgid = (xcd < r ? xcd * (q + 1) : r * (q + 1) + (xcd - r) * q) + off; }
        const int nig = WGM * nN, gid = wgid / nig, fm = gid * WGM, gsz = (nM - fm) < WGM ? (nM - fm) : WGM;
        u.pm = fm + ((wgid % nig) % gsz); u.pn = (wgid % nig) / gsz; return true;
    }
    __device__ __forceinline__ void a_ready(const Unit&) const {}
    __device__ __forceinline__ void done(const Unit&) const {}
};
__device__ __forceinline__ unsigned cvt_pk_bf16(float lo, float hi) { unsigned r; asm volatile("v_cvt_pk_bf16_f32 %0, %1, %2" : "=v"(r) : "v"(lo), "v"(hi)); return r; }
typedef float f32x2 __attribute__((ext_vector_type(2)));
template <class Epi, class Sched, bool ALIGN_EPI = false, bool SP2 = false>
__device__ __forceinline__ void gemm_phase(PG8_LAS unsigned char* lds, const Gemm g, const Sched& S, const Epi& E) {
    int tid_o = threadIdx.x; asm volatile("" : "+v"(tid_o));
    const int tid = tid_o, wid = __builtin_amdgcn_readfirstlane(tid >> 6), lane = tid & 63, wr = wid >> 2, wc = wid & 3, fr = lane & 15, fq = lane >> 4;
    const int K = g.K, nt = K / BK;
    unsigned voffA[2], voffB[2];
#pragma unroll
    for (int i = 0; i < 2; ++i) { int R, C; stage_rc(tid * 16 + i * 8192, R, C); const int Rb = Epi::PERM ? ((R & ~31) + perm32(R & 31)) : R;
        voffA[i] = (unsigned)(R * K + C) * 2u; voffB[i] = (unsigned)(Rb * K + C) * 2u; }
    const size_t kstep = (size_t)(BK * 2);
    const size_t hstep = (size_t)HALF * K * 2;
    const size_t tstep = 2 * hstep;
    const unsigned ldsw = (unsigned)wid * 1024u;
    const int aoff = lds_byte(wr * 64 + fr, fq * 8), boff = lds_byte(wc * 32 + fr, fq * 8);
#define PG8_SA(b, h) (((b) * 2 + (h)) * HTB)
#define PG8_SB(b, h) ((4 + (b) * 2 + (h)) * HTB)
#define PG8_STAGE(bufoff, gbase, voff) do { const char* _gb = (const char*)(gbase); asm volatile("" : "+s"(_gb)); _Pragma("unroll") for (int _i = 0; _i < 2; ++_i) \
        __builtin_amdgcn_global_load_lds((const unsigned*)(_gb + (voff)[_i]), (PG8_LAS unsigned*)(lds + (bufoff) + ldsw + _i * 8192), 16, 0, 0); } while (0)
#define PG8_LDA(dst, b, h) do { _Pragma("unroll") for (int m = 0; m < 4; ++m) _Pragma("unroll") for (int k = 0; k < 2; ++k) dst[m][k] = *(const PG8_LAS bf16x8*)(lds + PG8_SA(b, h) + aoff + m * 2048 + k * 1024); } while (0)
#define PG8_LDB(dst, b, h) do { _Pragma("unroll") for (int n = 0; n < 2; ++n) _Pragma("unroll") for (int k = 0; k < 2; ++k) dst[n][k] = *(const PG8_LAS bf16x8*)(lds + PG8_SB(b, h) + boff + n * 2048 + k * 1024); } while (0)
#define PG8_MMA(ai, bj, At, Bt) do { __builtin_amdgcn_s_setprio(1); _Pragma("unroll") for (int m = 0; m < 4; ++m) _Pragma("unroll") for (int n = 0; n < 2; ++n) _Pragma("unroll") for (int k = 0; k < 2; ++k) \
        acc[ai][bj][m][n] = __builtin_amdgcn_mfma_f32_16x16x32_bf16(Bt[n][k], At[m][k], acc[ai][bj][m][n], 0, 0, 0); __builtin_amdgcn_s_setprio(0); } while (0)
#define PG8_WAIT_V(n) asm volatile("s_waitcnt vmcnt(" #n ")" ::: "memory")
#define PG8_WAIT_L(n) asm volatile("s_waitcnt lgkmcnt(" #n ")" ::: "memory")
#define PG8_BAR __builtin_amdgcn_s_barrier()
#define PG8_SCHED __builtin_amdgcn_sched_barrier(0)
    Unit cur, nxt; int ui = 0;
    if (!S.next(0, cur)) return;
    f32x4 acc[2][2][4][2];
#pragma unroll
    for (int a = 0; a < 2; ++a)
#pragma unroll
        for (int b = 0; b < 2; ++b)
#pragma unroll
            for (int m = 0; m < 4; ++m)
#pragma unroll
                for (int n = 0; n < 2; ++n) acc[a][b][m][n] = (f32x4){0.f, 0.f, 0.f, 0.f};
    bf16x8 At[4][2], B0[2][2], B1[2][2];
    const char* cA = (const char*)g.A + (size_t)cur.pm * tstep; const char* cB = (const char*)g.Bt + (size_t)cur.pn * tstep;
    S.a_ready(cur);
    if constexpr (SP2) {
        PG8_STAGE(PG8_SB(0, 0), cB, voffB); PG8_STAGE(PG8_SB(0, 1), cB + hstep, voffB); PG8_STAGE(PG8_SA(0, 0), cA, voffA); PG8_STAGE(PG8_SA(0, 1), cA + hstep, voffA);
        if (wr == 1) PG8_BAR;
        PG8_WAIT_V(2); PG8_BAR;
        PG8_STAGE(PG8_SB(1, 0), cB + kstep, voffB); PG8_STAGE(PG8_SA(1, 0), cA + kstep, voffA); PG8_STAGE(PG8_SB(1, 1), cB + hstep + kstep, voffB);
        PG8_WAIT_V(6); PG8_BAR;
    } else {
        PG8_STAGE(PG8_SB(0, 0), cB, voffB); PG8_STAGE(PG8_SA(0, 0), cA, voffA); PG8_STAGE(PG8_SB(0, 1), cB + hstep, voffB); PG8_STAGE(PG8_SA(0, 1), cA + hstep, voffA);
        if (wr == 1) PG8_BAR;
        PG8_WAIT_V(4); PG8_BAR;
        PG8_STAGE(PG8_SB(1, 0), cB + kstep, voffB); PG8_STAGE(PG8_SA(1, 0), cA + kstep, voffA); PG8_STAGE(PG8_SB(1, 1), cB + hstep + kstep, voffB);
        PG8_WAIT_V(6); PG8_BAR;
    }
    for (;;) {
        const bool has_next = S.next(ui + 1, nxt);
        const char* nA = has_next ? (const char*)g.A + (size_t)nxt.pm * tstep : cA; const char* nB = has_next ? (const char*)g.Bt + (size_t)nxt.pn * tstep : cB;
        for (int t = 0; t < nt; t += 2) {
            const bool last = (t == nt - 2);
            const char* a1 = cA + (size_t)(t + 1) * kstep;
            const char* a2 = last ? nA : cA + (size_t)(t + 2) * kstep; const char* b2 = last ? nB : cB + (size_t)(t + 2) * kstep;
            const char* a3 = a2 + kstep; const char* b3 = b2 + kstep;
            if (last && has_next) S.a_ready(nxt);
            if constexpr (SP2) {
            PG8_LDB(B0, 0, 0); PG8_LDB(B1, 0, 1); PG8_SCHED; PG8_LDA(At, 0, 0); PG8_STAGE(PG8_SA(1, 1), a1 + hstep, voffA);
            PG8_WAIT_V(8); PG8_WAIT_L(0); PG8_BAR; PG8_MMA(0, 0, At, B0); PG8_MMA(0, 1, At, B1); PG8_BAR; PG8_SCHED;
            PG8_LDA(At, 0, 1); PG8_STAGE(PG8_SB(0, 0), b2, voffB); PG8_STAGE(PG8_SB(0, 1), b2 + hstep, voffB); PG8_STAGE(PG8_SA(0, 0), a2, voffA);
            PG8_WAIT_V(8); PG8_WAIT_L(0); PG8_BAR; PG8_MMA(1, 0, At, B0); PG8_MMA(1, 1, At, B1); PG8_BAR; PG8_SCHED;
            PG8_LDB(B0, 1, 0); PG8_LDB(B1, 1, 1); PG8_SCHED; PG8_LDA(At, 1, 0); PG8_STAGE(PG8_SA(0, 1), a2 + hstep, voffA);
            PG8_WAIT_V(8); PG8_WAIT_L(0); PG8_BAR; PG8_MMA(0, 0, At, B0); PG8_MMA(0, 1, At, B1); PG8_BAR; PG8_SCHED;
            PG8_LDA(At, 1, 1); PG8_STAGE(PG8_SB(1, 0), b3, voffB); PG8_STAGE(PG8_SB(1, 1), b3 + hstep, voffB); PG8_STAGE(PG8_SA(1, 0), a3, voffA);
            PG8_WAIT_V(8); PG8_WAIT_L(0); PG8_BAR; PG8_MMA(1, 0, At, B0); PG8_MMA(1, 1, At, B1); PG8_BAR; PG8_SCHED;
            } else {
            PG8_LDB(B0, 0, 0); PG8_SCHED; PG8_LDA(At, 0, 0); PG8_STAGE(PG8_SA(1, 1), a1 + hstep, voffA);
            PG8_WAIT_L(8); PG8_BAR; PG8_WAIT_L(0); PG8_MMA(0, 0, At, B0); PG8_BAR; PG8_SCHED;
            PG8_LDB(B1, 0, 1); PG8_STAGE(PG8_SB(0, 0), b2, voffB);
            PG8_BAR; PG8_WAIT_L(0); PG8_MMA(0, 1, At, B1); PG8_BAR;
            PG8_LDA(At, 0, 1); PG8_STAGE(PG8_SA(0, 0), a2, voffA);
            PG8_BAR; PG8_WAIT_L(0); PG8_MMA(1, 0, At, B0); PG8_BAR; PG8_SCHED;
            PG8_STAGE(PG8_SB(0, 1), b2 + hstep, voffB);
            PG8_WAIT_V(6); PG8_BAR; PG8_MMA(1, 1, At, B1); PG8_BAR;
            PG8_LDB(B0, 1, 0); PG8_SCHED; PG8_LDA(At, 1, 0); PG8_STAGE(PG8_SA(0, 1), a2 + hstep, voffA);
            PG8_WAIT_L(8); PG8_BAR; PG8_WAIT_L(0); PG8_MMA(0, 0, At, B0); PG8_BAR; PG8_SCHED;
            PG8_LDB(B1, 1, 1); PG8_STAGE(PG8_SB(1, 0), b3, voffB);
            PG8_BAR; PG8_WAIT_L(0); PG8_MMA(0, 1, At, B1); PG8_BAR;
            PG8_LDA(At, 1, 1); PG8_STAGE(PG8_SA(1, 0), a3, voffA);
            PG8_BAR; PG8_WAIT_L(0); PG8_MMA(1, 0, At, B0); PG8_BAR; PG8_SCHED;
            PG8_STAGE(PG8_SB(1, 1), b3 + hstep, voffB);
            PG8_WAIT_V(6); PG8_BAR; PG8_MMA(1, 1, At, B1); PG8_BAR;
            }
        }
        if constexpr (ALIGN_EPI) { if (wr == 0) PG8_BAR; }
        if constexpr (!Epi::AFTER_DRAIN) { E(acc, cur, wr, wc, fr, fq); S.done(cur); }
        if (!has_next) break;
#pragma unroll
        for (int a = 0; a < 2; ++a)
#pragma unroll
            for (int b = 0; b < 2; ++b)
#pragma unroll
                for (int m = 0; m < 4; ++m)
#pragma unroll
                    for (int n = 0; n < 2; ++n) acc[a][b][m][n] = (f32x4){0.f, 0.f, 0.f, 0.f};
        cur = nxt; cA = nA; cB = nB; ++ui;
        if constexpr (ALIGN_EPI) { if (wr == 1) PG8_BAR; }
    }
    PG8_WAIT_V(0);
    if constexpr (!ALIGN_EPI) { if (wr == 0) PG8_BAR; }
    PG8_BAR;
    if constexpr (Epi::AFTER_DRAIN) { E.fused(acc, cur, wr, wc, fr, fq, lds, wid, lane); S.done(cur); }
#undef PG8_SA
#undef PG8_SB
#undef PG8_STAGE
#undef PG8_LDA
#undef PG8_LDB
#undef PG8_MMA
#undef PG8_WAIT_V
#undef PG8_WAIT_L
#undef PG8_BAR
#undef PG8_SCHED
}
}

using pg8::bf16_t; using pg8::f32x4; using pg8::Unit; using pg8::cvt_pk_bf16;
#define LAS __attribute__((address_space(3)))
constexpr int T = 65536, DM = 1024, SEQ = 2048, MROWS = 8192;
constexpr int EVEN_IN = 1536, ODD_IN = 3584, DFF = 2816, GU = 5632;
constexpr size_t MiB = 1024ull * 1024ull;
constexpr size_t WS_HB = 0, WS_Z = 128 * MiB, WS_Y = 576 * MiB, WS_W = 704 * MiB, WS_MEMN = 768 * MiB, WS_KV = 800 * MiB, WS_SS = 864 * MiB, WS_TAB = 896 * MiB, WS_SIDE = 898 * MiB, WS_RET = 906 * MiB, WS_BAR = 970 * MiB, WS_END = 971 * MiB;
constexpr size_t W_EIN = 0, W_EOUT = W_EIN + 1536ull * 1024, W_OIN = W_EOUT + 1024ull * 1024, W_OOUT = W_OIN + 3584ull * 1024, W_L0 = W_OOUT + 1024ull * 1024;
constexpr size_t WL_Q = 0, WL_KV = 1024ull * 1024, WL_O = WL_KV + 2048ull * 1024, WL_GU = WL_O + 1024ull * 1024, WL_DN = WL_GU + 5632ull * 1024, WL_SIZE = WL_DN + 1024ull * 2816;
static_assert((W_L0 + 2 * WL_SIZE) * 2 <= 64 * MiB, "weights region");
constexpr size_t SS_STRIDE = (size_t)T * 16;
constexpr size_t TAB_DC = 0, TAB_DS = 2048 * 8, TAB_RC = 2 * 2048 * 8, TAB_RS = TAB_RC + 2048 * 64;
constexpr size_t SD_H = 0, SD_Z = SD_H + 1024 * 32, SD_Q = SD_Z + 5632 * 32, SD_R = SD_Q + 1024 * 32, SD_P = SD_R + 32 * 4 * 1024, SD_M = SD_P + 32 * 4 * 256, SD_T = SD_M + 32 * 256, SD_O = SD_T + 4 * 1024 * 32, SD_END = SD_O + 1024 * 32;
static_assert(SD_END * 4 <= 8 * MiB, "side region");

typedef short bf16x8_t __attribute__((ext_vector_type(8)));
typedef unsigned u32x4_t __attribute__((ext_vector_type(4)));
typedef unsigned u32x2_t __attribute__((ext_vector_type(2)));
struct Params {
    const float* in[22];
    float* out;
    unsigned char* ws;
    double inv_dil[8];
    double inv_ret[64];
};

__device__ __forceinline__ int opaque_tid() { int t = threadIdx.x; asm volatile("" : "+v"(t)); return t; }
__device__ __forceinline__ int xcd_unit(int it, int total) {
    const int G = (int)gridDim.x, bx = (int)blockIdx.x;
    if ((G & 7) || (total & 7)) { const int u = it * G + bx; return u < total ? u : -1; }
    const int per = total >> 3, ny = G >> 3, idx = it * ny + (bx >> 3);
    return idx < per ? (bx & 7) * per + idx : -1;
}
#define LDS_BARRIER() do { asm volatile("s_waitcnt lgkmcnt(0)" ::: "memory"); __builtin_amdgcn_s_barrier(); asm volatile("" ::: "memory"); } while (0)
__device__ __forceinline__ float bf2f(unsigned short v) { return __uint_as_float((unsigned)v << 16); }
__device__ __forceinline__ float bflo(unsigned v) { return __uint_as_float(v << 16); }
__device__ __forceinline__ float bfhi(unsigned v) { return __uint_as_float(v & 0xffff0000u); }
__device__ __forceinline__ unsigned short f2bf(float f) { return (unsigned short)(cvt_pk_bf16(f, 0.f) & 0xffffu); }
__device__ __forceinline__ float dot8(const uint4 a, const uint4 b) {
    float s = bflo(a.x) * bflo(b.x); s += bfhi(a.x) * bfhi(b.x);
    s += bflo(a.y) * bflo(b.y); s += bfhi(a.y) * bfhi(b.y);
    s += bflo(a.z) * bflo(b.z); s += bfhi(a.z) * bfhi(b.z);
    s += bflo(a.w) * bflo(b.w); s += bfhi(a.w) * bfhi(b.w);
    return s;
}
__device__ __forceinline__ float wave_sum(float v) {
#pragma unroll
    for (int o = 32; o >= 1; o >>= 1) v += __shfl_xor(v, o);
    return v;
}
__device__ __forceinline__ float wave_max(float v) {
#pragma unroll
    for (int o = 32; o >= 1; o >>= 1) v = fmaxf(v, __shfl_xor(v, o));
    return v;
}
__device__ __forceinline__ float silu_f(float x) { return x * __builtin_amdgcn_rcpf(1.0f + __builtin_amdgcn_exp2f(-1.4426950408889634f * x)); }
__device__ __forceinline__ float gelu_tanh_f(float x) {
    const float y = 1.5957691216057308f * (x + 0.044715f * x * x * x);
    return x * __builtin_amdgcn_rcpf(1.0f + __builtin_amdgcn_exp2f(-1.4426950408889634f * y));
}
__device__ __forceinline__ float row_rstd(const float* ss, int nslot, int row, float inv_dim) {
    float s = 0.f;
    for (int i = 0; i < nslot; i += 4) { const float4 v = *(const float4*)(ss + (size_t)row * 16 + i); s += (v.x + v.y) + (v.z + v.w); }
    return rsqrtf(s * inv_dim + 1e-6f);
}
__device__ __forceinline__ float coop_rstd(const float* ss, int nslot, int row, int fq, float inv_dim) {
    float s = 0.f;
    if (4 * fq < nslot) { const float4 v = *(const float4*)(ss + (size_t)row * 16 + 4 * fq); s = (v.x + v.y) + (v.z + v.w); }
    s += __shfl_xor(s, 16); s += __shfl_xor(s, 32);
    return rsqrtf(s * inv_dim + 1e-6f);
}

enum { EP_EVEN_IN = 0, EP_RES = 1, EP_SCALE = 2, EP_GU = 3, EP_ODD_IN = 4, EP_PLAIN = 5 };
template <int MODE> struct Epi {
    static constexpr bool PERM = true, AFTER_DRAIN = false;
    bf16_t* O; int ldo;
    const float* ss_in; int ns_in;
    const bf16_t* res; float* hout;
    float* ss_out;
    __device__ __forceinline__ void operator()(const f32x4 (&acc)[2][2][4][2], const Unit& u, int wr, int wc, int fr_in, int fq_in) const {
        int fr = fr_in, fq = fq_in;
        asm volatile("" : "+v"(fr), "+v"(fq));
        const int row00 = u.pm * 256 + wr * 64 + fr;
        float rsv[2][4];
        if (MODE == EP_EVEN_IN || MODE == EP_SCALE || MODE == EP_GU || MODE == EP_ODD_IN) {
            float part[2][4];
#pragma unroll
            for (int ai = 0; ai < 2; ++ai)
#pragma unroll
                for (int m = 0; m < 4; ++m) {
                    float sp = 0.f;
                    if (4 * fq < ns_in) { const float4 v = *(const float4*)(ss_in + (size_t)(row00 + ai * 128 + m * 16) * 16 + 4 * fq); sp = (v.x + v.y) + (v.z + v.w); }
                    part[ai][m] = sp;
                }
#pragma unroll
            for (int ai = 0; ai < 2; ++ai)
#pragma unroll
                for (int m = 0; m < 4; ++m) { float sp = part[ai][m]; sp += __shfl_xor(sp, 16); sp += __shfl_xor(sp, 32); rsv[ai][m] = rsqrtf(sp * (1.0f / 1024.0f) + 1e-6f); }
        } else {
#pragma unroll
            for (int ai = 0; ai < 2; ++ai)
#pragma unroll
                for (int m = 0; m < 4; ++m) rsv[ai][m] = 1.0f;
        }
#pragma unroll
        for (int ai = 0; ai < 2; ++ai) {
            u32x4_t rres[4][2];
            if (MODE == EP_RES) {
#pragma unroll
                for (int m = 0; m < 4; ++m)
#pragma unroll
                    for (int bj = 0; bj < 2; ++bj) rres[m][bj] = *(const u32x4_t*)(res + (size_t)(row00 + ai * 128 + m * 16) * 1024 + u.pn * 256 + bj * 128 + wc * 32 + fq * 8);
            }
#pragma unroll
            for (int m = 0; m < 4; ++m) {
                const int row = row00 + ai * 128 + m * 16;
                const float rs = rsv[ai][m];
                if (MODE == EP_GU) {
                    const f32x4 g0 = acc[ai][0][m][0] * rs, g1 = acc[ai][0][m][1] * rs, u0 = acc[ai][1][m][0] * rs, u1 = acc[ai][1][m][1] * rs;
                    uint4 w;
                    w.x = cvt_pk_bf16(silu_f(g0[0]) * u0[0], silu_f(g0[1]) * u0[1]); w.y = cvt_pk_bf16(silu_f(g0[2]) * u0[2], silu_f(g0[3]) * u0[3]);
                    w.z = cvt_pk_bf16(silu_f(g1[0]) * u1[0], silu_f(g1[1]) * u1[1]); w.w = cvt_pk_bf16(silu_f(g1[2]) * u1[2], silu_f(g1[3]) * u1[3]);
                    *(uint4*)(O + (size_t)row * ldo + u.pn * 128 + wc * 32 + fq * 8) = w;
                } else {
                    float sq = 0.f;
#pragma unroll
                    for (int bj = 0; bj < 2; ++bj) {
                        const int col0 = u.pn * 256 + bj * 128 + wc * 32 + fq * 8;
                        f32x4 v0 = acc[ai][bj][m][0] * rs, v1 = acc[ai][bj][m][1] * rs;
                        if (MODE == EP_EVEN_IN) {
                            if (u.pn >= 2) {
#pragma unroll
                                for (int j = 0; j < 4; ++j) { v0[j] = gelu_tanh_f(v0[j]); v1[j] = gelu_tanh_f(v1[j]); }
                            }
                            if (u.pn >= 4) sq += (v0[0] * v0[0] + v0[1] * v0[1]) + (v0[2] * v0[2] + v0[3] * v0[3]) + (v1[0] * v1[0] + v1[1] * v1[1]) + (v1[2] * v1[2] + v1[3] * v1[3]);
                        }
                        if (MODE == EP_ODD_IN) {
                            if (u.pn >= 12) {
#pragma unroll
                                for (int j = 0; j < 4; ++j) { v0[j] = silu_f(v0[j]); v1[j] = silu_f(v1[j]); }
                            }
                        }
                        if (MODE == EP_RES) {
                            { const u32x4_t rr = rres[m][bj];
                              v0[0] += bflo(rr[0]); v0[1] += bfhi(rr[0]); v0[2] += bflo(rr[1]); v0[3] += bfhi(rr[1]); v1[0] += bflo(rr[2]); v1[1] += bfhi(rr[2]); v1[2] += bflo(rr[3]); v1[3] += bfhi(rr[3]); }
                            sq += (v0[0] * v0[0] + v0[1] * v0[1]) + (v0[2] * v0[2] + v0[3] * v0[3]) + (v1[0] * v1[0] + v1[1] * v1[1]) + (v1[2] * v1[2] + v1[3] * v1[3]);
                        }
                        uint4 w;
                        w.x = cvt_pk_bf16(v0[0], v0[1]); w.y = cvt_pk_bf16(v0[2], v0[3]); w.z = cvt_pk_bf16(v1[0], v1[1]); w.w = cvt_pk_bf16(v1[2], v1[3]);
                        *(uint4*)(O + (size_t)row * ldo + col0) = w;
                    }
                    if (MODE == EP_RES) {
                        sq += __shfl_xor(sq, 16); sq += __shfl_xor(sq, 32);
                        if (fq == 0) ss_out[(size_t)row * 16 + u.pn * 4 + wc] = sq;
                    }
                    if (MODE == EP_EVEN_IN) {
                        if (u.pn >= 4) {
                            sq += __shfl_xor(sq, 16); sq += __shfl_xor(sq, 32);
                            if (fq == 0) ss_out[(size_t)row * 16 + (u.pn - 4) * 4 + wc] = sq;
                        }
                    }
                }
            }
            asm volatile("" ::: "memory");
        }
    }
};

#ifndef GEMM_ALIGN
#define GEMM_ALIGN true
#endif
#ifndef GEMM_SP2
#define GEMM_SP2 true
#endif
template <int MODE>
__device__ __forceinline__ void run_gemm(LAS unsigned char* lds, const bf16_t* A, const bf16_t* Bt, int M, int N, int K, const Epi<MODE>& E, int rot = 0) {
#if defined(T_ONLYMODE)
    if (MODE != T_ONLYMODE) return;
#endif
    pg8::Gemm g{A, Bt, M, N, K};
    pg8::StaticOrder S; S.init(M, N, (int)gridDim.x, (int)((blockIdx.x + rot) % gridDim.x));
    pg8::gemm_phase<Epi<MODE>, pg8::StaticOrder, GEMM_ALIGN, GEMM_SP2>(lds, g, S, E);
}

__device__ __forceinline__ void conv_weight(const float* W, const float* gain, bf16_t* Bt, int K, int Nsrc, int N, int mode, LAS float*) {
    const int tid = opaque_tid(), nkt = K / 64, nnt = N / 64;
    const int tx = tid & 63, kq = tid >> 6;
    for (int tix = blockIdx.x; tix < nkt * nnt; tix += gridDim.x) {
        const int kt = tix % nkt, ntl = tix / nkt, k0 = kt * 64 + kq * 8, np = ntl * 64 + tx;
        int src = np; float cs = 1.0f;
        if (mode == 1) { if (np < 512) cs = 0.125f; else if (np >= 2048 && np < 2560) cs = 0.08838834764831845f; }
        else if (mode == 2) cs = 0.0625f;
        else if (mode == 3) { const int pn = np >> 8, r = np & 255; src = (r < 128) ? (pn * 128 + r) : (DFF + pn * 128 + (r - 128)); }
        float v[8];
#pragma unroll
        for (int j = 0; j < 8; ++j) v[j] = W[(size_t)(k0 + j) * Nsrc + src];
        if (gain) {
            const float4 g0 = *(const float4*)(gain + k0), g1 = *(const float4*)(gain + k0 + 4);
            v[0] *= g0.x; v[1] *= g0.y; v[2] *= g0.z; v[3] *= g0.w; v[4] *= g1.x; v[5] *= g1.y; v[6] *= g1.z; v[7] *= g1.w;
        }
        uint4 w;
        w.x = cvt_pk_bf16(v[0] * cs, v[1] * cs); w.y = cvt_pk_bf16(v[2] * cs, v[3] * cs); w.z = cvt_pk_bf16(v[4] * cs, v[5] * cs); w.w = cvt_pk_bf16(v[6] * cs, v[7] * cs);
        *(uint4*)(Bt + (size_t)np * K + k0) = w;
    }
}

__device__ __forceinline__ void sincos_d(double a, float& s_out, float& c_out) {
    const double k = rint(a * 0.63661977236758134308);
    const double r = (a - k * 1.57079632679489655800) - k * 6.12323399573676603587e-17;
    const double r2 = r * r;
    double sp = -1.0 / 1307674368000.0;
    sp = sp * r2 + 1.0 / 6227020800.0; sp = sp * r2 - 1.0 / 39916800.0; sp = sp * r2 + 1.0 / 362880.0; sp = sp * r2 - 1.0 / 5040.0; sp = sp * r2 + 1.0 / 120.0; sp = sp * r2 - 1.0 / 6.0; sp = sp * r2 + 1.0;
    const double sn = sp * r;
    double cp = 1.0 / 20922789888000.0;
    cp = cp * r2 - 1.0 / 87178291200.0; cp = cp * r2 + 1.0 / 479001600.0; cp = cp * r2 - 1.0 / 3628800.0; cp = cp * r2 + 1.0 / 40320.0; cp = cp * r2 - 1.0 / 720.0; cp = cp * r2 + 1.0 / 24.0; cp = cp * r2 - 0.5; cp = cp * r2 + 1.0;
    const int q = ((int)k) & 3;
    double s, c;
    if (q == 0) { s = sn; c = cp; } else if (q == 1) { s = cp; c = -sn; } else if (q == 2) { s = -sn; c = -cp; } else { s = -cp; c = sn; }
    s_out = (float)s; c_out = (float)c;
}


constexpr int SRED_RSTD = 512;
constexpr int SRED_GEMV = 1024;
__device__ __forceinline__ void side_rstd(const float* v_t, int K, float inv_dim, LAS float* red) {
    const int tid = opaque_tid(), b = tid & 31, part = tid >> 5;
    float s = 0.f;
    float s1 = 0.f, s2 = 0.f, s3 = 0.f;
    for (int k = part; k < K; k += 128) {
        const float x0 = v_t[k * 32 + b], x1 = v_t[(k + 16) * 32 + b], x2 = v_t[(k + 32) * 32 + b], x3 = v_t[(k + 48) * 32 + b];
        const float x4 = v_t[(k + 64) * 32 + b], x5 = v_t[(k + 80) * 32 + b], x6 = v_t[(k + 96) * 32 + b], x7 = v_t[(k + 112) * 32 + b];
        s += x0 * x0 + x4 * x4; s1 += x1 * x1 + x5 * x5; s2 += x2 * x2 + x6 * x6; s3 += x3 * x3 + x7 * x7;
    }
    s = (s + s1) + (s2 + s3);
    red[tid] = s;
    __syncthreads();
    if (tid < 32) { float t = 0.f; for (int q = 0; q < 16; ++q) t += red[q * 32 + tid]; red[SRED_RSTD + tid] = rsqrtf(t * inv_dim + 1e-6f); }
    __syncthreads();
}
constexpr int SRED_IN = SRED_GEMV + 8 * 32 * 64;
template <class InF, class EpiF>
__device__ __forceinline__ void side_gemv(const float* W, int ldw, int K, int N, const InF& in, const EpiF& epi, LAS float* red) {
    const int tid = opaque_tid(), lane = tid & 63;
    const int kg = __builtin_amdgcn_readfirstlane(tid >> 6);
    const int ns = K >> 8;
    for (int c = blockIdx.x; c < (N >> 6); c += gridDim.x) {
        float acc[32];
#pragma unroll
        for (int b = 0; b < 32; ++b) acc[b] = 0.f;
        float xs[16];
        int t0 = tid; asm volatile("" : "+v"(t0));
#pragma unroll
        for (int i = 0; i < 16; ++i) { const int idx = t0 + 512 * i, k = idx >> 5; xs[i] = in.v(k, idx & 31, c) * in.ws(k); }
        __syncthreads();
#pragma unroll
        for (int i = 0; i < 16; ++i) red[SRED_IN + t0 + 512 * i] = xs[i];
        __syncthreads();
        for (int sl = 0; sl < ns; ++sl) {
            const int ks = sl << 8;
            LAS float* xin = red + SRED_IN + (sl & 1) * 8192;
            const float* wp = W + (size_t)(ks + 32 * kg) * ldw + c * 64 + lane;
            float w[32];
#pragma unroll
            for (int i = 0; i < 32; ++i) w[i] = wp[(size_t)i * ldw];
            LAS float* wl = red + SRED_GEMV + (kg * 32) * 64 + lane;
#pragma unroll
            for (int i = 0; i < 32; ++i) wl[i * 64] = w[i];
            asm volatile("" ::: "memory");
            int t1 = tid; asm volatile("" : "+v"(t1));
            if (sl + 1 < ns) {
#pragma unroll
                for (int i = 0; i < 16; ++i) { const int idx = t1 + 512 * i, k = ks + 256 + (idx >> 5); xs[i] = in.v(k, idx & 31, c) * in.ws(k); }
            }
#pragma unroll 1
            for (int k4 = 0; k4 < 8; ++k4) {
                const LAS f32x4* xv = (const LAS f32x4*)(xin + (32 * kg + k4 * 4) * 32);
                const float w0 = wl[(k4 * 4) * 64], w1 = wl[(k4 * 4 + 1) * 64], w2 = wl[(k4 * 4 + 2) * 64], w3 = wl[(k4 * 4 + 3) * 64];
#pragma unroll
                for (int q = 0; q < 8; ++q) {
                    const f32x4 x0 = xv[q], x1 = xv[8 + q], x2 = xv[16 + q], x3 = xv[24 + q];
                    acc[4 * q] += x0[0] * w0 + x1[0] * w1 + x2[0] * w2 + x3[0] * w3; acc[4 * q + 1] += x0[1] * w0 + x1[1] * w1 + x2[1] * w2 + x3[1] * w3;
                    acc[4 * q + 2] += x0[2] * w0 + x1[2] * w1 + x2[2] * w2 + x3[2] * w3; acc[4 * q + 3] += x0[3] * w0 + x1[3] * w1 + x2[3] * w2 + x3[3] * w3;
                }
            }
            if (sl + 1 < ns) {
                LAS float* xnx = red + SRED_IN + ((sl + 1) & 1) * 8192;
#pragma unroll
                for (int i = 0; i < 16; ++i) xnx[t1 + 512 * i] = xs[i];
            }
            __syncthreads();
        }
#pragma unroll
        for (int b = 0; b < 32; ++b) red[SRED_GEMV + (kg * 32 + b) * 64 + lane] = acc[b];
        __syncthreads();
#pragma unroll
        for (int i = 0; i < 4; ++i) {
            const int idx = tid + 512 * i, col = idx & 63, b = idx >> 6;
            float sum = 0.f;
#pragma unroll
            for (int g = 0; g < 8; ++g) sum += red[SRED_GEMV + (g * 32 + b) * 64 + col];
            epi(c * 64 + col, b, sum);
        }
        __syncthreads();
    }
}
template <class InF>
__device__ __forceinline__ void side_gemv_ks(const float* W, int ldw, int K, int N, const InF& in, float* h_t, LAS float* red) {
    const int tid = opaque_tid(), lane = tid & 63;
    const int kg = __builtin_amdgcn_readfirstlane(tid >> 6);
    const int ns = K >> 8, items = (N >> 6) * ns;
    for (int item = blockIdx.x; item < items; item += gridDim.x) {
        const int c = item / ns, ks = (item - c * ns) << 8;
        float xs[16];
        int t0 = tid; asm volatile("" : "+v"(t0));
#pragma unroll
        for (int i = 0; i < 16; ++i) { const int idx = t0 + 512 * i, k = ks + (idx >> 5); xs[i] = in.v(k, idx & 31, c) * in.ws(k); }
        float w[32];
        {
            const float* wp = W + (size_t)(ks + 32 * kg) * ldw + c * 64 + lane;
#pragma unroll
            for (int i = 0; i < 32; ++i) w[i] = wp[(size_t)i * ldw];
        }
        __syncthreads();
#pragma unroll
        for (int i = 0; i < 16; ++i) red[SRED_IN + t0 + 512 * i] = xs[i];
        LAS float* wl = red + SRED_GEMV + (kg * 32) * 64 + lane;
#pragma unroll
        for (int i = 0; i < 32; ++i) wl[i * 64] = w[i];
        __syncthreads();
        float acc[32];
#pragma unroll
        for (int b = 0; b < 32; ++b) acc[b] = 0.f;
        LAS float* xin = red + SRED_IN;
#pragma unroll 1
        for (int k4 = 0; k4 < 8; ++k4) {
            const LAS f32x4* xv = (const LAS f32x4*)(xin + (32 * kg + k4 * 4) * 32);
            const float w0 = wl[(k4 * 4) * 64], w1 = wl[(k4 * 4 + 1) * 64], w2 = wl[(k4 * 4 + 2) * 64], w3 = wl[(k4 * 4 + 3) * 64];
#pragma unroll
            for (int q = 0; q < 8; ++q) {
                const f32x4 x0 = xv[q], x1 = xv[8 + q], x2 = xv[16 + q], x3 = xv[24 + q];
                acc[4 * q] += x0[0] * w0 + x1[0] * w1 + x2[0] * w2 + x3[0] * w3; acc[4 * q + 1] += x0[1] * w0 + x1[1] * w1 + x2[1] * w2 + x3[1] * w3;
                acc[4 * q + 2] += x0[2] * w0 + x1[2] * w1 + x2[2] * w2 + x3[2] * w3; acc[4 * q + 3] += x0[3] * w0 + x1[3] * w1 + x2[3] * w2 + x3[3] * w3;
            }
        }
        __syncthreads();
#pragma unroll
        for (int b = 0; b < 32; ++b) red[SRED_GEMV + (kg * 32 + b) * 64 + lane] = acc[b];
        __syncthreads();
#pragma unroll
        for (int i = 0; i < 4; ++i) {
            const int idx = tid + 512 * i, col = idx & 63, b = idx >> 6;
            float sum = 0.f;
#pragma unroll
            for (int g = 0; g < 8; ++g) sum += red[SRED_GEMV + (g * 32 + b) * 64 + col];
            atomicAdd(h_t + (c * 64 + col) * 32 + b, sum);
        }
        __syncthreads();
    }
}
struct InPlain { const float* v_t; const float* gain; __device__ __forceinline__ float ws(int k) const { return gain ? gain[k] : 1.0f; } __device__ __forceinline__ float v(int k, int b, int) const { return v_t[k * 32 + b]; } };
struct InSgu { const float* z_t; const float* sgu_w; const float* sgu_b; const float* sgu_norm; const LAS float* rstdv;
    __device__ __forceinline__ float ws(int) const { return 1.0f; }
    __device__ __forceinline__ float v(int k, int b, int) const { const int g = k >> 7; return z_t[k * 32 + b] * (sgu_w[(size_t)g * 16384] * z_t[(512 + k) * 32 + b] * rstdv[b] * sgu_norm[k] + sgu_b[g * 128]); } };
struct InHead { const float* t_t; __device__ __forceinline__ float ws(int) const { return 1.0f; } __device__ __forceinline__ float v(int k, int b, int c) const { return t_t[((size_t)(c >> 2) * 1024 + k) * 32 + b]; } };
struct InSwiglu { const float* z_t; __device__ __forceinline__ float ws(int) const { return 1.0f; } __device__ __forceinline__ float v(int k, int b, int) const { return silu_f(z_t[k * 32 + b]) * z_t[(DFF + k) * 32 + b]; } };
struct EpStore { float* o_t; const LAS float* rstd; float scale; int act;
    __device__ __forceinline__ void operator()(int n, int b, float s) const { float v = s * scale * (rstd ? rstd[b] : 1.0f); if (act == 1) v = gelu_tanh_f(v); o_t[n * 32 + b] = v; } };
struct EpAdd { float* h_t; __device__ __forceinline__ void operator()(int n, int b, float s) const { h_t[n * 32 + b] += s; } };


__device__ __forceinline__ void xattn_phase(LAS unsigned char* lds, bf16_t* Yq, const bf16_t* Kmat, const bf16_t* VT) {
    const int tid = opaque_tid(), lane = tid & 63, r = lane & 15, qp = lane >> 4;
    const int wave = __builtin_amdgcn_readfirstlane(tid >> 6);
    constexpr int KS = 528;
    for (int trip = 0;; ++trip) {
        const int unit = xcd_unit(trip, 1024);
        if (unit < 0) break;
        const int b = unit >> 5, h = (unit >> 3) & 3, qb = unit & 7;
        __syncthreads();
        int tk = tid; asm volatile("" : "+v"(tk));
#pragma unroll
        for (int half = 0; half < 2; ++half) {
            u32x4_t tv[8];
#pragma unroll
            for (int i = 0; i < 8; ++i) { const int c = tk + 512 * (half * 8 + i), row = c >> 5, ch = c & 31; tv[i] = *(const u32x4_t*)(Kmat + (size_t)(b * 256 + row) * 1024 + h * 256 + ch * 8); }
#pragma unroll
            for (int i = 0; i < 8; ++i) { const int c = tk + 512 * (half * 8 + i), row = c >> 5, ch = c & 31; *(LAS u32x4_t*)(lds + row * KS + ch * 16) = tv[i]; }
        }
        __syncthreads();
        const int q0 = b * 2048 + qb * 256 + wave * 32;
        bf16x8_t pf[2][8];
        float inv[2];
        {
            f32x4 sacc[2][16];
#pragma unroll
            for (int kt = 0; kt < 16; ++kt) { sacc[0][kt] = (f32x4){0.f, 0.f, 0.f, 0.f}; sacc[1][kt] = (f32x4){0.f, 0.f, 0.f, 0.f}; }
            const bf16_t* qrow = Yq + (size_t)(q0 + r) * 1024 + h * 256 + qp * 8;
            const LAS unsigned char* kb = lds + r * KS + qp * 16; const LAS unsigned char* kb2 = kb + 8 * 16 * KS; asm volatile("" : "+v"(kb2));
            bf16x8_t qa = *(const bf16x8_t*)qrow, qb = *(const bf16x8_t*)(qrow + 16 * 1024);
#pragma unroll
            for (int ks = 0; ks < 8; ++ks) {
                const bf16x8_t qf0 = qa, qf1 = qb;
                if (ks < 7) { qa = *(const bf16x8_t*)(qrow + (ks + 1) * 32); qb = *(const bf16x8_t*)(qrow + 16 * 1024 + (ks + 1) * 32); }
#pragma unroll
                for (int kt = 0; kt < 16; ++kt) {
                    const bf16x8_t a = *(const LAS bf16x8_t*)((kt < 8 ? kb : kb2) + (kt & 7) * 16 * KS + ks * 64);
                    sacc[0][kt] = __builtin_amdgcn_mfma_f32_16x16x32_bf16(a, qf0, sacc[0][kt], 0, 0, 0);
                    sacc[1][kt] = __builtin_amdgcn_mfma_f32_16x16x32_bf16(a, qf1, sacc[1][kt], 0, 0, 0);
                }
            }
#pragma unroll
            for (int qt = 0; qt < 2; ++qt) {
                float mx = -INFINITY;
#pragma unroll
                for (int kt = 0; kt < 16; ++kt) mx = fmaxf(mx, fmaxf(fmaxf(sacc[qt][kt][0], sacc[qt][kt][1]), fmaxf(sacc[qt][kt][2], sacc[qt][kt][3])));
                mx = fmaxf(mx, __shfl_xor(mx, 16)); mx = fmaxf(mx, __shfl_xor(mx, 32));
                float sum = 0.f;
#pragma unroll
                for (int kt = 0; kt < 16; ++kt) {
#pragma unroll
                    for (int j = 0; j < 4; ++j) { const float e = __builtin_amdgcn_exp2f((sacc[qt][kt][j] - mx) * 1.4426950408889634f); sacc[qt][kt][j] = e; sum += e; }
                }
                sum += __shfl_xor(sum, 16); sum += __shfl_xor(sum, 32);
                inv[qt] = 1.0f / sum;
#pragma unroll
                for (int u = 0; u < 8; ++u) {
                    u32x4_t w;
                    w[0] = cvt_pk_bf16(sacc[qt][2 * u][0], sacc[qt][2 * u][1]); w[1] = cvt_pk_bf16(sacc[qt][2 * u][2], sacc[qt][2 * u][3]);
                    w[2] = cvt_pk_bf16(sacc[qt][2 * u + 1][0], sacc[qt][2 * u + 1][1]); w[3] = cvt_pk_bf16(sacc[qt][2 * u + 1][2], sacc[qt][2 * u + 1][3]);
                    pf[qt][u] = __builtin_bit_cast(bf16x8_t, w);
                }
            }
        }
        __syncthreads();
        int tv2 = tid; asm volatile("" : "+v"(tv2));
#pragma unroll 1
        for (int qd = 0; qd < 4; ++qd) {
            u32x4_t tv[4];
#pragma unroll
            for (int i = 0; i < 4; ++i) { const int c = tv2 + 512 * (qd * 4 + i), row = c >> 5, ch = c & 31; tv[i] = *(const u32x4_t*)(VT + (size_t)(h * 256 + row) * MROWS + b * 256 + ch * 8); }
#pragma unroll
            for (int i = 0; i < 4; ++i) { const int c = tv2 + 512 * (qd * 4 + i), row = c >> 5, ch = c & 31; *(LAS u32x4_t*)(lds + (((row & 15) << 4) | (row >> 4)) * KS + ch * 16) = tv[i]; }
        }
        __syncthreads();
        {
            f32x4 oacc[2][16];
#pragma unroll
            for (int nt = 0; nt < 16; ++nt) { oacc[0][nt] = (f32x4){0.f, 0.f, 0.f, 0.f}; oacc[1][nt] = (f32x4){0.f, 0.f, 0.f, 0.f}; }
            const LAS unsigned char* vb = lds + r * KS + qp * 8; const LAS unsigned char* vb2 = vb + 8 * 16 * KS; asm volatile("" : "+v"(vb2));
#pragma unroll
            for (int u = 0; u < 8; ++u)
#pragma unroll
                for (int nt = 0; nt < 16; ++nt) {
                    const LAS unsigned char* bp = (nt < 8 ? vb : vb2) + (nt & 7) * 16 * KS + u * 64;
                    const u32x2_t lo = *(const LAS u32x2_t*)bp, hi = *(const LAS u32x2_t*)(bp + 32);
                    u32x4_t w; w[0] = lo[0]; w[1] = lo[1]; w[2] = hi[0]; w[3] = hi[1];
                    const bf16x8_t bv = __builtin_bit_cast(bf16x8_t, w);
                    oacc[0][nt] = __builtin_amdgcn_mfma_f32_16x16x32_bf16(pf[0][u], bv, oacc[0][nt], 0, 0, 0);
                    oacc[1][nt] = __builtin_amdgcn_mfma_f32_16x16x32_bf16(pf[1][u], bv, oacc[1][nt], 0, 0, 0);
                }
            int r2 = r, qp2 = qp; asm volatile("" : "+v"(r2), "+v"(qp2));
#pragma unroll
            for (int qt = 0; qt < 2; ++qt)
#pragma unroll
                for (int j = 0; j < 4; ++j) {
                    const float is = __shfl(inv[qt], qp2 * 4 + j);
                    bf16_t* op = Yq + (size_t)(q0 + qt * 16 + qp2 * 4 + j) * 1024 + h * 256 + r2 * 16;
                    u32x4_t w0, w1;
#pragma unroll
                    for (int e = 0; e < 4; ++e) { w0[e] = cvt_pk_bf16(oacc[qt][2 * e][j] * is, oacc[qt][2 * e + 1][j] * is); w1[e] = cvt_pk_bf16(oacc[qt][8 + 2 * e][j] * is, oacc[qt][9 + 2 * e][j] * is); }
                    *(u32x4_t*)op = w0; *(u32x4_t*)(op + 8) = w1;
                }
        }
    }
    __syncthreads();
}

constexpr int RP = 272;
constexpr int RTILE = 128 * RP;
__device__ __forceinline__ float ret_lg2(int h) { return log2f(1.0f - exp2f(-5.0f - (float)h)); }
template <int TR>
__device__ __forceinline__ void ret_stage_rot(LAS unsigned char* dst, const bf16_t* Z1, int tok0, int col0, const float* TAB, float lg2, float sgn, int tid) {
    for (int it = tid; it < 1024; it += 512) {
        const int row = TR ? (it & 127) : (it >> 3), c8 = TR ? ((it >> 7) * 8) : ((it & 7) * 8);
        const bf16_t* zp = Z1 + (size_t)(tok0 + row) * ODD_IN + col0 + c8;
        const u32x4_t a = *(const u32x4_t*)zp, bq = *(const u32x4_t*)(zp + 64);
        const int pos = (tok0 + row) & 2047;
        const float4 c0 = *(const float4*)(TAB + TAB_RC + pos * 64 + c8), c1 = *(const float4*)(TAB + TAB_RC + pos * 64 + c8 + 4);
        const float4 s0 = *(const float4*)(TAB + TAB_RS + pos * 64 + c8), s1 = *(const float4*)(TAB + TAB_RS + pos * 64 + c8 + 4);
        const float sc = exp2f(sgn * (float)(row + 1) * lg2);
        const float x1[8] = {bflo(a[0]), bfhi(a[0]), bflo(a[1]), bfhi(a[1]), bflo(a[2]), bfhi(a[2]), bflo(a[3]), bfhi(a[3])};
        const float x2[8] = {bflo(bq[0]), bfhi(bq[0]), bflo(bq[1]), bfhi(bq[1]), bflo(bq[2]), bfhi(bq[2]), bflo(bq[3]), bfhi(bq[3])};
        const float cs[8] = {c0.x, c0.y, c0.z, c0.w, c1.x, c1.y, c1.z, c1.w};
        const float sn[8] = {s0.x, s0.y, s0.z, s0.w, s1.x, s1.y, s1.z, s1.w};
        float o1[8], o2[8];
#pragma unroll
        for (int e = 0; e < 8; ++e) { o1[e] = (x1[e] * cs[e] - x2[e] * sn[e]) * sc; o2[e] = (x1[e] * sn[e] + x2[e] * cs[e]) * sc; }
        if (TR == 0) {
            u32x4_t w1, w2;
#pragma unroll
            for (int e = 0; e < 4; ++e) { w1[e] = cvt_pk_bf16(o1[2 * e], o1[2 * e + 1]); w2[e] = cvt_pk_bf16(o2[2 * e], o2[2 * e + 1]); }
            *(LAS u32x4_t*)(dst + row * RP + c8 * 2) = w1; *(LAS u32x4_t*)(dst + row * RP + (64 + c8) * 2) = w2;
        } else {
#pragma unroll
            for (int e = 0; e < 8; ++e) {
                const int d1 = c8 + e, d2 = 64 + c8 + e;
                *(LAS unsigned short*)(dst + ((d1 & 7) * 16 + (d1 >> 3)) * RP + row * 2) = f2bf(o1[e]); *(LAS unsigned short*)(dst + ((d2 & 7) * 16 + (d2 >> 3)) * RP + row * 2) = f2bf(o2[e]);
            }
        }
    }
}
template <int PERM8>
__device__ __forceinline__ void stage_tr128(LAS unsigned char* dst, const bf16_t* src, int ld, int tok0, int col0, int tid) {
    for (int it = tid; it < 2048; it += 512) {
        const int row = it & 127, c8 = (it >> 7) * 8;
        const u32x4_t a = *(const u32x4_t*)(src + (size_t)(tok0 + row) * ld + col0 + c8);
#pragma unroll
        for (int e = 0; e < 4; ++e) {
            const int e0 = c8 + 2 * e, e1 = e0 + 1;
            *(LAS unsigned short*)(dst + (PERM8 ? ((e0 & 7) * 16 + (e0 >> 3)) : e0) * RP + row * 2) = (unsigned short)(a[e] & 0xffffu);
            *(LAS unsigned short*)(dst + (PERM8 ? ((e1 & 7) * 16 + (e1 >> 3)) : e1) * RP + row * 2) = (unsigned short)(a[e] >> 16);
        }
    }
}
__device__ __forceinline__ void ret_r1(LAS unsigned char* lds, const bf16_t* Z1, const float* TAB, bf16_t* RET) {
    const int tid = opaque_tid(), lane = tid & 63, r = lane & 15, qp = lane >> 4;
    const int wave = __builtin_amdgcn_readfirstlane(tid >> 6);
    LAS unsigned char* KT = lds; LAS unsigned char* VTL = lds + RTILE;
    for (int unit = blockIdx.x; unit < 2048; unit += gridDim.x) {
        const int b = unit >> 6, h = (unit >> 4) & 3, n = unit & 15, tok0 = b * 2048 + n * 128;
        const float lg2 = ret_lg2(h);
        __syncthreads();
        ret_stage_rot<1>(KT, Z1, tok0, 2048 + h * 128, TAB, lg2, -1.0f, tid);
        stage_tr128<0>(VTL, Z1, ODD_IN, tok0, 2560 + h * 128, tid);
        __syncthreads();
        f32x4 acc[8];
#pragma unroll
        for (int nt = 0; nt < 8; ++nt) acc[nt] = (f32x4){0.f, 0.f, 0.f, 0.f};
#pragma unroll
        for (int ks = 0; ks < 4; ++ks) {
            const bf16x8_t a = *(const LAS bf16x8_t*)(VTL + (16 * wave + r) * RP + (32 * ks + 8 * qp) * 2);
#pragma unroll
            for (int nt = 0; nt < 8; ++nt) {
                const bf16x8_t bv = *(const LAS bf16x8_t*)(KT + (16 * nt + r) * RP + (32 * ks + 8 * qp) * 2);
                acc[nt] = __builtin_amdgcn_mfma_f32_16x16x32_bf16(a, bv, acc[nt], 0, 0, 0);
            }
        }
        const float g128 = exp2f(128.0f * lg2);
        bf16_t* op = RET + (size_t)unit * 16384;
#pragma unroll
        for (int j = 0; j < 4; ++j) {
            u32x4_t w;
#pragma unroll
            for (int e = 0; e < 4; ++e) w[e] = cvt_pk_bf16(acc[2 * e][j] * g128, acc[2 * e + 1][j] * g128);
            *(u32x4_t*)(op + (16 * wave + 4 * qp + j) * 128 + 8 * r) = w;
        }
    }
    __syncthreads();
}
__device__ __forceinline__ void ret_r2(bf16_t* RET) {
    const int tid = opaque_tid();
    for (int idx = blockIdx.x * 512 + tid; idx < 128 * 8192; idx += gridDim.x * 512) {
        const int bh = idx >> 13, pr = idx & 8191;
        const float g128 = exp2f(128.0f * ret_lg2(bh & 3));
        unsigned* p = (unsigned*)(RET + (size_t)bh * 16 * 16384) + pr;
        unsigned v[16];
#pragma unroll
        for (int n = 0; n < 16; ++n) v[n] = p[(size_t)n * 8192];
        float s0 = 0.f, s1 = 0.f;
#pragma unroll
        for (int n = 0; n < 16; ++n) {
            p[(size_t)n * 8192] = cvt_pk_bf16(s0, s1);
            s0 = s0 * g128 + bflo(v[n]); s1 = s1 * g128 + bfhi(v[n]);
        }
    }
}
__device__ __forceinline__ void ret_r3(LAS unsigned char* lds, const bf16_t* Z1, const float* TAB, const bf16_t* RET, const float* SDZ, bf16_t* Yo) {
    const int tid = opaque_tid(), lane = tid & 63, r = lane & 15, qp = lane >> 4;
    const int wave = __builtin_amdgcn_readfirstlane(tid >> 6);
    LAS unsigned char* QL = lds; LAS unsigned char* KL = lds + RTILE; LAS unsigned char* VTL = lds + 2 * RTILE; LAS unsigned char* PL = lds + 3 * RTILE;
    for (int unit = blockIdx.x; unit < 2048; unit += gridDim.x) {
        const int b = unit >> 6, h = (unit >> 4) & 3, n = unit & 15, tok0 = b * 2048 + n * 128;
        const float lg2 = ret_lg2(h);
        __syncthreads();
        ret_stage_rot<0>(QL, Z1, tok0, 1536 + h * 128, TAB, lg2, 1.0f, tid);
        ret_stage_rot<0>(KL, Z1, tok0, 2048 + h * 128, TAB, lg2, -1.0f, tid);
        stage_tr128<1>(VTL, Z1, ODD_IN, tok0, 2560 + h * 128, tid);
        for (int it = tid; it < 2048; it += 512) { const int row = it >> 4, c8 = (it & 15) * 8; *(LAS u32x4_t*)(PL + ((row & 7) * 16 + (row >> 3)) * RP + c8 * 2) = *(const u32x4_t*)(RET + (size_t)unit * 16384 + row * 128 + c8); }
        __syncthreads();
        bf16x8_t qf[4];
#pragma unroll
        for (int ks = 0; ks < 4; ++ks) qf[ks] = *(const LAS bf16x8_t*)(QL + (16 * wave + r) * RP + (32 * ks + 8 * qp) * 2);
        f32x4 sacc[8];
#pragma unroll
        for (int jt = 0; jt < 8; ++jt) {
            sacc[jt] = (f32x4){0.f, 0.f, 0.f, 0.f};
            if (jt <= wave) {
#pragma unroll
                for (int ks = 0; ks < 4; ++ks) {
                    const bf16x8_t a = *(const LAS bf16x8_t*)(KL + (16 * jt + r) * RP + (32 * ks + 8 * qp) * 2);
                    sacc[jt] = __builtin_amdgcn_mfma_f32_16x16x32_bf16(a, qf[ks], sacc[jt], 0, 0, 0);
                }
#pragma unroll
                for (int j = 0; j < 4; ++j) if (16 * jt + 4 * qp + j > 16 * wave + r) sacc[jt][j] = 0.f;
            }
        }
        if (n == 0 && wave == 0) {
            const float* zq = SDZ + (size_t)(h * 128) * 32 + b;
            const float c = wave_sum(zq[lane * 32] * zq[(512 + lane) * 32] + zq[(lane + 64) * 32] * zq[(512 + lane + 64) * 32]) * 0.08838834764831845f;
            if (lane == 0) sacc[0][0] = c;
        }
        bf16x8_t pf[4];
#pragma unroll
        for (int u = 0; u < 4; ++u) {
            u32x4_t w;
            w[0] = cvt_pk_bf16(sacc[2 * u][0], sacc[2 * u][1]); w[1] = cvt_pk_bf16(sacc[2 * u][2], sacc[2 * u][3]);
            w[2] = cvt_pk_bf16(sacc[2 * u + 1][0], sacc[2 * u + 1][1]); w[3] = cvt_pk_bf16(sacc[2 * u + 1][2], sacc[2 * u + 1][3]);
            pf[u] = __builtin_bit_cast(bf16x8_t, w);
        }
        f32x4 oacc[8];
#pragma unroll
        for (int nt = 0; nt < 8; ++nt) oacc[nt] = (f32x4){0.f, 0.f, 0.f, 0.f};
#pragma unroll
        for (int u = 0; u < 4; ++u) {
            if (2 * u <= wave) {
#pragma unroll
                for (int nt = 0; nt < 8; ++nt) {
                    const LAS unsigned char* bp = VTL + (16 * nt + r) * RP + (32 * u + 4 * qp) * 2;
                    const u32x2_t lo = *(const LAS u32x2_t*)bp, hi = *(const LAS u32x2_t*)(bp + 32);
                    u32x4_t w; w[0] = lo[0]; w[1] = lo[1]; w[2] = hi[0]; w[3] = hi[1];
                    oacc[nt] = __builtin_amdgcn_mfma_f32_16x16x32_bf16(pf[u], __builtin_bit_cast(bf16x8_t, w), oacc[nt], 0, 0, 0);
                }
            }
        }
#pragma unroll
        for (int ks = 0; ks < 4; ++ks)
#pragma unroll
            for (int nt = 0; nt < 8; ++nt) {
                const bf16x8_t bv = *(const LAS bf16x8_t*)(PL + (16 * nt + r) * RP + (32 * ks + 8 * qp) * 2);
                oacc[nt] = __builtin_amdgcn_mfma_f32_16x16x32_bf16(qf[ks], bv, oacc[nt], 0, 0, 0);
            }
#pragma unroll
        for (int j = 0; j < 4; ++j) {
            float sm = 0.f;
#pragma unroll
            for (int nt = 0; nt < 8; ++nt) sm += oacc[nt][j];
            sm += __shfl_xor(sm, 1); sm += __shfl_xor(sm, 2); sm += __shfl_xor(sm, 4); sm += __shfl_xor(sm, 8);
            const float mu = sm * (1.0f / 128.0f);
            float vr = 0.f;
#pragma unroll
            for (int nt = 0; nt < 8; ++nt) { const float d = oacc[nt][j] - mu; vr += d * d; }
            vr += __shfl_xor(vr, 1); vr += __shfl_xor(vr, 2); vr += __shfl_xor(vr, 4); vr += __shfl_xor(vr, 8);
            const float rs = rsqrtf(vr * (1.0f / 128.0f) + 1e-6f);
            const size_t tok = (size_t)(tok0 + 16 * wave + 4 * qp + j);
            const u32x4_t gg = *(const u32x4_t*)(Z1 + tok * ODD_IN + 3072 + h * 128 + 8 * r);
            u32x4_t w;
#pragma unroll
            for (int e = 0; e < 4; ++e) w[e] = cvt_pk_bf16(bflo(gg[e]) * (oacc[2 * e][j] - mu) * rs, bfhi(gg[e]) * (oacc[2 * e + 1][j] - mu) * rs);
            *(u32x4_t*)(Yo + tok * 1024 + 512 + h * 128 + 8 * r) = w;
        }
    }
    __syncthreads();
}

constexpr int DKP = 144;
constexpr int DVP = 592;
constexpr int DK_BYTES = 256 * DKP;
#define DIL_DECODE(u) const int b = (u) / 384, v = (u) - b * 384, h = v / 48, v2 = v - h * 48, g = v2 >> 4, rb = v2 & 15; \
    const int lognb = 4 - 2 * g, dil = 1 << (2 * g), nbi = rb & ((1 << lognb) - 1), res = rb >> lognb; const int tokb = b * 2048
#define DIL_ISSUE(u) do { DIL_DECODE(u); const int row_ = (wave & 3) * 64 + lane, hh_ = wave >> 2; const int j_ = 128 * nbi - 128 + row_; validr = j_ >= 0; const int pos_ = validr ? j_ * dil + res : 0; \
    const bf16_t* zr_ = Z1 + (size_t)(tokb + pos_) * ODD_IN + h * 64 + hh_ * 32; \
    _Pragma("unroll") for (int i_ = 0; i_ < 4; ++i_) { kvr[i_] = *(const u32x4_t*)(zr_ + 512 + i_ * 8); vvr[i_] = *(const u32x4_t*)(zr_ + 1024 + i_ * 8); } \
    if (hh_ == 0) { const float* tc_ = TAB + TAB_DC + pos_ * 8; const float* ts_ = TAB + TAB_DS + pos_ * 8; kc0 = *(const float4*)tc_; kc1 = *(const float4*)(tc_ + 4); ks0 = *(const float4*)ts_; ks1 = *(const float4*)(ts_ + 4); } \
    const int qpos_ = (128 * nbi + 16 * wave + r) * dil + res; const bf16_t* qrow_ = Z1 + (size_t)(tokb + qpos_) * ODD_IN + h * 64 + qp * 8; \
    qr0 = *(const u32x4_t*)qrow_; qr1 = *(const u32x4_t*)(qrow_ + 32); \
    { const float* tc_ = TAB + TAB_DC + qpos_ * 8; const float* ts_ = TAB + TAB_DS + qpos_ * 8; qc0 = *(const float4*)tc_; qc1 = *(const float4*)(tc_ + 4); qs0 = *(const float4*)ts_; qs1 = *(const float4*)(ts_ + 4); } } while (0)
__device__ __forceinline__ void dil_units(LAS unsigned char* lds, const bf16_t* Z1, const float* TAB, bf16_t* OB01, bf16_t* Yo, float* LSE) {
    const int tid = opaque_tid(), lane = tid & 63, r = lane & 15, qp = lane >> 4;
    const int wave = __builtin_amdgcn_readfirstlane(tid >> 6);
    LAS unsigned char* KL = lds; LAS unsigned char* VTL = lds + DK_BYTES;
    __syncthreads();
    for (int i = tid; i < 64 * 16; i += 512) { const int d = i >> 4, c = i & 15; *(LAS unsigned*)(VTL + d * DVP + 512 + c * 4) = 0u; }
    u32x4_t kvr[4], vvr[4], qr0, qr1; float4 kc0, kc1, ks0, ks1, qc0, qc1, qs0, qs1; bool validr;
    kc0 = kc1 = ks0 = ks1 = make_float4(0.f, 0.f, 0.f, 0.f);
    int trip = 0, unit = xcd_unit(0, 12288);
    if (unit >= 0) DIL_ISSUE(unit);
    while (unit >= 0) {
        DIL_DECODE(unit);
        __syncthreads();
        {
            const int row = (wave & 3) * 64 + lane, hh = wave >> 2;
            u32x4_t kv[4], vv[4];
#pragma unroll
            for (int i = 0; i < 4; ++i) { kv[i] = validr ? kvr[i] : (u32x4_t){0u, 0u, 0u, 0u}; vv[i] = validr ? vvr[i] : (u32x4_t){0u, 0u, 0u, 0u}; }
#pragma unroll
            for (int i = 0; i < 4; ++i)
#pragma unroll
                for (int e = 0; e < 4; ++e) {
                    *(LAS unsigned short*)(VTL + ((hh * 4 + i) * 8 + 2 * e) * DVP + row * 2) = (unsigned short)(vv[i][e] & 0xffffu);
                    *(LAS unsigned short*)(VTL + ((hh * 4 + i) * 8 + 2 * e + 1) * DVP + row * 2) = (unsigned short)(vv[i][e] >> 16);
                }
            if (hh == 0) {
                const float cs[8] = {kc0.x, kc0.y, kc0.z, kc0.w, kc1.x, kc1.y, kc1.z, kc1.w}, sn[8] = {ks0.x, ks0.y, ks0.z, ks0.w, ks1.x, ks1.y, ks1.z, ks1.w};
                const u32x4_t k1 = kv[0], k2 = kv[1];
                const float x1[8] = {bflo(k1[0]), bfhi(k1[0]), bflo(k1[1]), bfhi(k1[1]), bflo(k1[2]), bfhi(k1[2]), bflo(k1[3]), bfhi(k1[3])};
                const float x2[8] = {bflo(k2[0]), bfhi(k2[0]), bflo(k2[1]), bfhi(k2[1]), bflo(k2[2]), bfhi(k2[2]), bflo(k2[3]), bfhi(k2[3])};
#pragma unroll
                for (int e = 0; e < 4; ++e) {
                    kv[0][e] = cvt_pk_bf16(x1[2 * e] * cs[2 * e] - x2[2 * e] * sn[2 * e], x1[2 * e + 1] * cs[2 * e + 1] - x2[2 * e + 1] * sn[2 * e + 1]);
                    kv[1][e] = cvt_pk_bf16(x1[2 * e] * sn[2 * e] + x2[2 * e] * cs[2 * e], x1[2 * e + 1] * sn[2 * e + 1] + x2[2 * e + 1] * cs[2 * e + 1]);
                }
            }
#pragma unroll
            for (int i = 0; i < 4; ++i) *(LAS u32x4_t*)(KL + row * DKP + (hh * 4 + i) * 16) = kv[i];
        }
        const int qi = 128 * nbi + 16 * wave + r, qpos = qi * dil + res;
        u32x4_t q0 = qr0; const u32x4_t q1 = qr1;
        {
            u32x4_t pr;
#pragma unroll
            for (int e = 0; e < 4; ++e) pr[e] = (unsigned)__shfl_xor((int)q0[e], 16);
            const float cs[8] = {qc0.x, qc0.y, qc0.z, qc0.w, qc1.x, qc1.y, qc1.z, qc1.w}, sn[8] = {qs0.x, qs0.y, qs0.z, qs0.w, qs1.x, qs1.y, qs1.z, qs1.w};
            const float own[8] = {bflo(q0[0]), bfhi(q0[0]), bflo(q0[1]), bfhi(q0[1]), bflo(q0[2]), bfhi(q0[2]), bflo(q0[3]), bfhi(q0[3])};
            const float oth[8] = {bflo(pr[0]), bfhi(pr[0]), bflo(pr[1]), bfhi(pr[1]), bflo(pr[2]), bfhi(pr[2]), bflo(pr[3]), bfhi(pr[3])};
            float o[8];
#pragma unroll
            for (int e = 0; e < 8; ++e) o[e] = (qp == 0) ? (own[e] * cs[e] - oth[e] * sn[e]) : (oth[e] * sn[e] + own[e] * cs[e]);
            if (qp < 2) {
#pragma unroll
                for (int e = 0; e < 4; ++e) q0[e] = cvt_pk_bf16(o[2 * e], o[2 * e + 1]);
            }
        }
        const bf16x8_t qf0 = __builtin_bit_cast(bf16x8_t, q0), qf1 = __builtin_bit_cast(bf16x8_t, q1);
        const int nxt = xcd_unit(++trip, 12288);
        if (nxt >= 0) DIL_ISSUE(nxt);
        __syncthreads();
        f32x4 sacc[9];
        const LAS unsigned char* kb = KL + (16 * wave + r) * DKP + qp * 16;
#pragma unroll
        for (int st = 0; st < 9; ++st) {
            const bf16x8_t a0 = *(const LAS bf16x8_t*)(kb + st * 16 * DKP), a1 = *(const LAS bf16x8_t*)(kb + st * 16 * DKP + 64);
            f32x4 acc = (f32x4){0.f, 0.f, 0.f, 0.f};
            acc = __builtin_amdgcn_mfma_f32_16x16x32_bf16(a0, qf0, acc, 0, 0, 0);
            acc = __builtin_amdgcn_mfma_f32_16x16x32_bf16(a1, qf1, acc, 0, 0, 0);
#pragma unroll
            for (int j = 0; j < 4; ++j) {
                const int dk = 16 * st + 4 * qp + j;
                const bool ok = (dk >= r) && (dk <= r + 128) && (nbi > 0 || 16 * wave + dk >= 128);
                acc[j] = ok ? acc[j] : -INFINITY;
            }
            sacc[st] = acc;
        }
        float mx = -INFINITY;
#pragma unroll
        for (int st = 0; st < 9; ++st) mx = fmaxf(mx, fmaxf(fmaxf(sacc[st][0], sacc[st][1]), fmaxf(sacc[st][2], sacc[st][3])));
        mx = fmaxf(mx, __shfl_xor(mx, 16)); mx = fmaxf(mx, __shfl_xor(mx, 32));
        float sum = 0.f;
#pragma unroll
        for (int st = 0; st < 9; ++st) {
#pragma unroll
            for (int j = 0; j < 4; ++j) { const float e = (sacc[st][j] == -INFINITY) ? 0.f : __expf(sacc[st][j] - mx); sacc[st][j] = e; sum += e; }
        }
        sum += __shfl_xor(sum, 16); sum += __shfl_xor(sum, 32);
        const float inv = 1.0f / sum;
        if (qp == 0) LSE[((size_t)g * T + tokb + qpos) * 8 + h] = mx + __logf(sum);
        f32x4 oacc[4];
#pragma unroll
        for (int nt = 0; nt < 4; ++nt) oacc[nt] = (f32x4){0.f, 0.f, 0.f, 0.f};
        const LAS unsigned char* vb = VTL + r * DVP + (16 * wave + 4 * qp) * 2;
#pragma unroll
        for (int u = 0; u < 5; ++u) {
            u32x4_t w;
            w[0] = cvt_pk_bf16(sacc[2 * u][0], sacc[2 * u][1]); w[1] = cvt_pk_bf16(sacc[2 * u][2], sacc[2 * u][3]);
            if (u < 4) { w[2] = cvt_pk_bf16(sacc[2 * u + 1][0], sacc[2 * u + 1][1]); w[3] = cvt_pk_bf16(sacc[2 * u + 1][2], sacc[2 * u + 1][3]); } else { w[2] = 0u; w[3] = 0u; }
            const bf16x8_t pfr = __builtin_bit_cast(bf16x8_t, w);
#pragma unroll
            for (int nt = 0; nt < 4; ++nt) {
                const LAS unsigned char* bp = vb + nt * 16 * DVP + u * 64;
                const u32x2_t lo = *(const LAS u32x2_t*)bp, hi = *(const LAS u32x2_t*)(bp + 32);
                u32x4_t bw; bw[0] = lo[0]; bw[1] = lo[1]; bw[2] = hi[0]; bw[3] = hi[1];
                oacc[nt] = __builtin_amdgcn_mfma_f32_16x16x32_bf16(pfr, __builtin_bit_cast(bf16x8_t, bw), oacc[nt], 0, 0, 0);
            }
        }
        bf16_t* ob = (g == 2) ? Yo : (OB01 + (size_t)g * T * 512);
        const int opitch = (g == 2) ? 1024 : 512;
#pragma unroll
        for (int j = 0; j < 4; ++j) {
            const float is = __shfl(inv, qp * 4 + j);
            const int tq = tokb + (128 * nbi + 16 * wave + 4 * qp + j) * dil + res;
            bf16_t* op = ob + (size_t)tq * opitch + h * 64 + r;
#pragma unroll
            for (int nt = 0; nt < 4; ++nt) op[16 * nt] = f2bf(oacc[nt][j] * is);
        }
        unit = nxt;
    }
    __syncthreads();
}
#undef DIL_ISSUE
#undef DIL_DECODE
__device__ __forceinline__ void dil_combine(const bf16_t* OB01, bf16_t* Yo, const float* LSE) {
    const int tid = opaque_tid();
    for (int idx = blockIdx.x * 512 + tid; idx < T * 64; idx += gridDim.x * 512) {
        const int t = idx >> 6, c8 = (idx & 63) * 8, h = c8 >> 6;
        const float l0 = LSE[((size_t)0 * T + t) * 8 + h], l1 = LSE[((size_t)1 * T + t) * 8 + h], l2 = LSE[((size_t)2 * T + t) * 8 + h];
        const float m = fmaxf(l0, fmaxf(l1, l2));
        float w0 = __expf(l0 - m), w1 = __expf(l1 - m), w2 = __expf(l2 - m);
        const float is = 1.0f / (w0 + w1 + w2); w0 *= is; w1 *= is; w2 *= is;
        const u32x4_t a = *(const u32x4_t*)(OB01 + (size_t)t * 512 + c8), bq = *(const u32x4_t*)(OB01 + (size_t)T * 512 + (size_t)t * 512 + c8), c = *(const u32x4_t*)(Yo + (size_t)t * 1024 + c8);
        u32x4_t o;
#pragma unroll
        for (int e = 0; e < 4; ++e) o[e] = cvt_pk_bf16(w0 * bflo(a[e]) + w1 * bflo(bq[e]) + w2 * bflo(c[e]), w0 * bfhi(a[e]) + w1 * bfhi(bq[e]) + w2 * bfhi(c[e]));
        *(u32x4_t*)(Yo + (size_t)t * 1024 + c8) = o;
    }
}

constexpr size_t TABB_WSB = 1280 * 1024, TABB_PWT = TABB_WSB + 4 * 128 * 128 * 2;
constexpr int EM_AL = RTILE, EM_DL = RTILE + 144 * RP;
__device__ __forceinline__ void even_mix_units(LAS unsigned char* lds, const bf16_t* Z0, const float* ssv, const bf16_t* WSB, const bf16_t* PWT, const float* sgu_norm, const float* sgu_b, bf16_t* Yo) {
    const int tid = opaque_tid(), lane = tid & 63, r = lane & 15, qp = lane >> 4;
    const int wave = __builtin_amdgcn_readfirstlane(tid >> 6);
    LAS unsigned char* VT = lds; LAS unsigned char* AL = lds + EM_AL; LAS unsigned char* DL = lds + EM_DL;
    for (int unit = blockIdx.x; unit < 2048; unit += gridDim.x) {
        const int chunk = unit >> 2, g = unit & 3, tok0 = chunk * 128, pos0 = tok0 & 2047, win = 2 << g;
        __syncthreads();
        for (int it = tid; it < 2048; it += 512) {
            const int row = it & 127, c8 = (it >> 7) * 8;
            const float rs = row_rstd(ssv, 8, tok0 + row, 1.0f / 512.0f);
            const u32x4_t a = *(const u32x4_t*)(Z0 + (size_t)(tok0 + row) * EVEN_IN + 1024 + g * 128 + c8);
#pragma unroll
            for (int e = 0; e < 4; ++e) {
                *(LAS unsigned short*)(VT + (c8 + 2 * e) * RP + row * 2) = f2bf(bflo(a[e]) * rs);
                *(LAS unsigned short*)(VT + (c8 + 2 * e + 1) * RP + row * 2) = f2bf(bfhi(a[e]) * rs);
            }
        }
        for (int it = tid; it < 143 * 16; it += 512) {
            const int rr = it >> 4, c8 = (it & 15) * 8;
            const bool valid = pos0 - 15 + rr >= 0;
            u32x4_t a = *(const u32x4_t*)(Z0 + (size_t)(valid ? tok0 - 15 + rr : tok0) * EVEN_IN + g * 128 + c8);
            if (!valid) a = (u32x4_t){0u, 0u, 0u, 0u};
            *(LAS u32x4_t*)(AL + rr * RP + c8 * 2) = a;
        }
        __syncthreads();
        for (int it = tid; it < 2048; it += 512) {
            const int t = it >> 4, c8 = (it & 15) * 8;
            float sum[8];
#pragma unroll
            for (int e = 0; e < 8; ++e) sum[e] = 0.f;
            for (int jj = 0; jj < win; ++jj) {
                const u32x4_t a = *(const LAS u32x4_t*)(AL + (t + 15 - jj) * RP + c8 * 2);
#pragma unroll
                for (int e = 0; e < 4; ++e) { sum[2 * e] += bflo(a[e]); sum[2 * e + 1] += bfhi(a[e]); }
            }
            const u32x4_t cur = *(const LAS u32x4_t*)(AL + (t + 15) * RP + c8 * 2);
            const float ic = 1.0f / (float)min(pos0 + t + 1, win);
            u32x4_t w;
#pragma unroll
            for (int e = 0; e < 4; ++e) w[e] = cvt_pk_bf16(sum[2 * e] * ic - bflo(cur[e]), sum[2 * e + 1] * ic - bfhi(cur[e]));
            *(LAS u32x4_t*)(DL + t * RP + c8 * 2) = w;
        }
        __syncthreads();
        {
            f32x4 acc[8];
#pragma unroll
            for (int nt = 0; nt < 8; ++nt) acc[nt] = (f32x4){0.f, 0.f, 0.f, 0.f};
#pragma unroll
            for (int ks = 0; ks < 4; ++ks) {
                if (32 * ks <= 16 * wave + 15) {
                    const bf16x8_t a = *(const bf16x8_t*)(WSB + (size_t)g * 16384 + (16 * wave + r) * 128 + 32 * ks + 8 * qp);
#pragma unroll
                    for (int nt = 0; nt < 8; ++nt) {
                        const bf16x8_t bv = *(const LAS bf16x8_t*)(VT + (16 * nt + r) * RP + (32 * ks + 8 * qp) * 2);
                        acc[nt] = __builtin_amdgcn_mfma_f32_16x16x32_bf16(a, bv, acc[nt], 0, 0, 0);
                    }
                }
            }
#pragma unroll
            for (int j = 0; j < 4; ++j) {
                const int t = 16 * wave + 4 * qp + j;
                const float bb = sgu_b[g * 128 + t];
                const bf16_t* up = Z0 + (size_t)(tok0 + t) * EVEN_IN + 512 + g * 128 + r;
                bf16_t* yp = Yo + (size_t)(tok0 + t) * 1024 + 512 + g * 128 + r;
#pragma unroll
                for (int nt = 0; nt < 8; ++nt) yp[16 * nt] = f2bf(bf2f(up[16 * nt]) * (acc[nt][j] * sgu_norm[g * 128 + 16 * nt + r] + bb));
            }
        }
        {
            f32x4 acc[8];
#pragma unroll
            for (int nt = 0; nt < 8; ++nt) acc[nt] = (f32x4){0.f, 0.f, 0.f, 0.f};
#pragma unroll
            for (int ks = 0; ks < 4; ++ks) {
                const bf16x8_t a = *(const LAS bf16x8_t*)(DL + (16 * wave + r) * RP + (32 * ks + 8 * qp) * 2);
#pragma unroll
                for (int nt = 0; nt < 8; ++nt) {
                    const bf16x8_t bv = *(const bf16x8_t*)(PWT + (size_t)g * 16384 + (16 * nt + r) * 128 + 32 * ks + 8 * qp);
                    acc[nt] = __builtin_amdgcn_mfma_f32_16x16x32_bf16(a, bv, acc[nt], 0, 0, 0);
                }
            }
#pragma unroll
            for (int j = 0; j < 4; ++j) {
                bf16_t* yp = Yo + (size_t)(tok0 + 16 * wave + 4 * qp + j) * 1024 + g * 128 + r;
#pragma unroll
                for (int nt = 0; nt < 8; ++nt) yp[16 * nt] = f2bf(acc[nt][j]);
            }
        }
    }
    __syncthreads();
}
#define PHASE_IDS() const int tid = opaque_tid(), lane = tid & 63, wave = tid >> 6; const int gw = blockIdx.x * 8 + wave, nw = gridDim.x * 8; const int gt = blockIdx.x * 512 + tid, nt = gridDim.x * 512; (void)lane; (void)gw; (void)nw; (void)gt; (void)nt;
#include <vector>

#define XB_TMO      128
#define XB_XCNT(j)  (256  + 64 * (j))
#define XB_XSUB(j)  (1280 + 64 * (j))
#define XB_XGEN(j)  (2304 + 64 * (j))
#define XB_TOP      3328
#define XB_TOPGEN   3392
#define XCD_BAR_WORDS 3456
#define XB_SPIN_CAP (1u << 18)

__device__ __forceinline__ unsigned xb_ld(unsigned* p)              { return __hip_atomic_load(p, __ATOMIC_RELAXED, __HIP_MEMORY_SCOPE_AGENT); }
__device__ __forceinline__ unsigned xb_add(unsigned* p, unsigned v) { return __hip_atomic_fetch_add(p, v, __ATOMIC_RELAXED, __HIP_MEMORY_SCOPE_AGENT); }
__device__ __forceinline__ unsigned xb_xcc_id() { return (unsigned)__builtin_amdgcn_s_getreg((3 << 11) | 20) & 0xFu; }
#define XB_SPIN(cond, bar) do { unsigned _sp = 0; while (cond) { __builtin_amdgcn_s_sleep(1); \
    if ((++_sp & 255u) == 0u) { if (xb_ld(&(bar)[XB_TMO])) break; if (_sp > XB_SPIN_CAP) { atomicAdd(&(bar)[XB_TMO], 1u); break; } } } } while (0)

struct XcdBarrier {
    unsigned* bar; unsigned x;
    volatile LAS unsigned* st;
};

__device__ __forceinline__ XcdBarrier xcd_barrier_post(unsigned* bar, volatile LAS unsigned* st) {
    XcdBarrier b; b.bar = bar; b.x = xb_xcc_id(); b.st = st;
    if (threadIdx.x == 0) (void)xb_add(&bar[XB_XCNT(b.x)], 1u);
    return b;
}
__device__ __forceinline__ void xcd_barrier_complete(unsigned* bar, unsigned x, unsigned& nloc, unsigned& nx) {
    const unsigned G = gridDim.x * gridDim.y * gridDim.z;
    unsigned sum, cnt, mine, sp = 0u;
    for (;;) {
        sum = 0u; cnt = 0u; mine = 0u;
#pragma unroll
        for (unsigned j = 0; j < 16; ++j) { const unsigned c = xb_ld(&bar[XB_XCNT(j)]); sum += c; cnt += (c > 0u) ? 1u : 0u; mine = (j == x) ? c : mine; }
        if (sum == G) break;
        __builtin_amdgcn_s_sleep(1);
        if ((++sp & 255u) == 0u) { if (xb_ld(&bar[XB_TMO])) break; if (sp > XB_SPIN_CAP) { atomicAdd(&bar[XB_TMO], 1u); break; } }
    }
    nloc = mine > 0u ? mine : 1u; nx = cnt > 0u ? cnt : 1u;
}

__device__ __forceinline__ void xcd_barrier(const XcdBarrier& b) {
    asm volatile("s_waitcnt vmcnt(0)" ::: "memory");
    __syncthreads();
    if (threadIdx.x == 0) {
        unsigned* bar = b.bar;
        __builtin_amdgcn_s_waitcnt(0);
        unsigned nloc = b.st[0], nx = b.st[1];
        if (nloc == 0u) { xcd_barrier_complete(bar, b.x, nloc, nx); b.st[0] = nloc; b.st[1] = nx; }
        const unsigned old = xb_add(&bar[XB_XSUB(b.x)], 1u);
        const unsigned gen = old / nloc;
        if (old + 1u == (gen + 1u) * nloc) {
            __builtin_amdgcn_fence(__ATOMIC_RELEASE, "agent");
            asm volatile("s_waitcnt vmcnt(0)" ::: "memory");
            const unsigned og = xb_add(&bar[XB_TOP], 1u);
            const unsigned tg = og / nx;
            if (og + 1u == (tg + 1u) * nx) xb_add(&bar[XB_TOPGEN], 1u);
            else XB_SPIN(xb_ld(&bar[XB_TOPGEN]) == tg, bar);
            __builtin_amdgcn_fence(__ATOMIC_ACQUIRE, "agent");
            xb_add(&bar[XB_XGEN(b.x)], 1u);
            asm volatile("s_waitcnt vmcnt(0)" ::: "memory");
        } else {
            XB_SPIN(xb_ld(&bar[XB_XGEN(b.x)]) == gen, bar);
            __builtin_amdgcn_fence(__ATOMIC_ACQUIRE, "agent");
            asm volatile("s_waitcnt vmcnt(0)" ::: "memory");
        }
    }
    __syncthreads();
}


#ifndef REP_GEMM
#define REP_GEMM 1
#endif
#ifndef REP_EM
#define REP_EM 1
#endif
#ifndef REP_DIL
#define REP_DIL 1
#endif
#ifndef REP_R1
#define REP_R1 1
#endif
#ifndef REP_R3
#define REP_R3 1
#endif
#ifndef REP_PRO
#define REP_PRO 1
#endif
#ifndef REP_SYNC
#define REP_SYNC 1
#endif
#define GSYNC() do { for (int rep_ = 0; rep_ < REP_SYNC; ++rep_) xcd_barrier(xb); } while (0)
constexpr int LDS_BYTES = 144 * 1024;

__global__ void __launch_bounds__(512) fwd_mega(Params p) {
    __shared__ __attribute__((aligned(16))) unsigned char lds_raw[LDS_BYTES];
    LAS unsigned char* lds = (LAS unsigned char*)lds_raw;
    cg::grid_group grid = cg::this_grid();
    __shared__ uint4 xb_words;
    if (threadIdx.x == 0) xb_words = make_uint4(0u, 0u, 0u, 0u);
    __syncthreads();
    const XcdBarrier xb = xcd_barrier_post((unsigned*)(p.ws + WS_BAR), (volatile LAS unsigned*)&xb_words);
    const float* x = p.in[0]; const float* mem = p.in[1];
    const float* even_mix_norm = p.in[2]; const float* even_w_in = p.in[3]; const float* pool_w = p.in[4]; const float* pool_scale = p.in[5];
    const float* sgu_norm = p.in[6]; const float* sgu_w = p.in[7]; const float* sgu_b = p.in[8]; const float* even_w_out = p.in[9];
    const float* odd_mix_norm = p.in[10]; const float* odd_w_in = p.in[11]; const float* odd_w_out = p.in[12];
    const float* xattn_norm = p.in[13]; const float* mem_norm = p.in[14]; const float* xattn_wq = p.in[15]; const float* xattn_wkv = p.in[16]; const float* xattn_wo = p.in[17];
    const float* ffn_norm = p.in[18]; const float* ffn_w_gate_up = p.in[19]; const float* ffn_w_down = p.in[20]; const float* final_norm = p.in[21];
    float* H = p.out;
    bf16_t* HB = (bf16_t*)(p.ws + WS_HB); bf16_t* Z = (bf16_t*)(p.ws + WS_Z); bf16_t* Y = (bf16_t*)(p.ws + WS_Y); bf16_t* WB = (bf16_t*)(p.ws + WS_W);
    bf16_t* MEMN = (bf16_t*)(p.ws + WS_MEMN); bf16_t* KV = (bf16_t*)(p.ws + WS_KV); float* SS = (float*)(p.ws + WS_SS); float* TAB = (float*)(p.ws + WS_TAB); float* SD = (float*)(p.ws + WS_SIDE); bf16_t* RET = (bf16_t*)(p.ws + WS_RET); LAS float* sred = (LAS float*)lds;

    for (int rep_ = 0; rep_ < REP_PRO; ++rep_) {
        LAS float* tile = (LAS float*)lds;
        conv_weight(even_w_in, even_mix_norm, WB + W_EIN, 1024, EVEN_IN, EVEN_IN, 0, tile);
        conv_weight(even_w_out, nullptr, WB + W_EOUT, 1024, 1024, 1024, 0, tile);
        conv_weight(odd_w_in, odd_mix_norm, WB + W_OIN, 1024, ODD_IN, ODD_IN, 1, tile);
        conv_weight(odd_w_out, nullptr, WB + W_OOUT, 1024, 1024, 1024, 0, tile);
        for (int l = 0; l < 2; ++l) {
            bf16_t* wl = WB + W_L0 + (size_t)l * WL_SIZE;
            conv_weight(xattn_wq + (size_t)l * 1024 * 1024, xattn_norm + l * 1024, wl + WL_Q, 1024, 1024, 1024, 2, tile);
            conv_weight(xattn_wkv + (size_t)l * 1024 * 2048, nullptr, wl + WL_KV, 1024, 2048, 2048, 0, tile);
            conv_weight(xattn_wo + (size_t)l * 1024 * 1024, nullptr, wl + WL_O, 1024, 1024, 1024, 0, tile);
            conv_weight(ffn_w_gate_up + (size_t)l * 1024 * GU, ffn_norm + l * 1024, wl + WL_GU, 1024, GU, GU, 3, tile);
            conv_weight(ffn_w_down + (size_t)l * DFF * 1024, nullptr, wl + WL_DN, DFF, 1024, 1024, 0, tile);
        }
        PHASE_IDS();
        for (int row0 = gw * 4; row0 < T; row0 += nw * 4) {
            float4 v[4][4];
#pragma unroll
            for (int rr = 0; rr < 4; ++rr)
#pragma unroll
                for (int i = 0; i < 4; ++i) v[rr][i] = ((const float4*)(x + (size_t)(row0 + rr) * 1024))[lane + 64 * i];
#pragma unroll
            for (int rr = 0; rr < 4; ++rr) {
                float s = 0.f;
#pragma unroll
                for (int i = 0; i < 4; ++i) {
                    const float4 q = v[rr][i];
                    s += (q.x * q.x + q.y * q.y) + (q.z * q.z + q.w * q.w);
                    uint2 w; w.x = cvt_pk_bf16(q.x, q.y); w.y = cvt_pk_bf16(q.z, q.w);
                    *(uint2*)(HB + (size_t)(row0 + rr) * 1024 + 4 * (lane + 64 * i)) = w;
                }
                s = wave_sum(s);
                if (lane < 4) SS[(size_t)(row0 + rr) * 16 + lane] = (lane == 0) ? s : 0.f;
            }
        }
        for (int row = gw; row < MROWS; row += nw) {
            const float4* xr = (const float4*)(mem + (size_t)row * 1024);
            float4 v[4]; float s = 0.f;
#pragma unroll
            for (int i = 0; i < 4; ++i) { v[i] = xr[lane + 64 * i]; s += (v[i].x * v[i].x + v[i].y * v[i].y) + (v[i].z * v[i].z + v[i].w * v[i].w); }
            s = wave_sum(s);
            const float rs = rsqrtf(s * (1.0f / 1024.0f) + 1e-6f);
#pragma unroll
            for (int l = 0; l < 2; ++l)
#pragma unroll
                for (int i = 0; i < 4; ++i) {
                    const float4 g = *(const float4*)(mem_norm + l * 1024 + 4 * (lane + 64 * i));
                    uint2 w; w.x = cvt_pk_bf16(v[i].x * rs * g.x, v[i].y * rs * g.y); w.y = cvt_pk_bf16(v[i].z * rs * g.z, v[i].w * rs * g.w);
                    *(uint2*)(MEMN + (size_t)l * MROWS * 1024 + (size_t)row * 1024 + 4 * (lane + 64 * i)) = w;
                }
        }
        for (int i = gt; i < 32 * 1024; i += nt) { const int b = i >> 10, k = i & 1023; SD[SD_H + k * 32 + b] = x[(size_t)b * 2048 * 1024 + k]; }
        {
            bf16_t* WSBw = (bf16_t*)(p.ws + WS_TAB + TABB_WSB); bf16_t* PWTw = (bf16_t*)(p.ws + WS_TAB + TABB_PWT);
            for (int i = gt; i < 4 * 128 * 128; i += nt) {
                const int g = i >> 14, a = (i >> 7) & 127, c = i & 127;
                WSBw[i] = f2bf(c <= a ? sgu_w[i] : 0.f);
                PWTw[i] = f2bf(pool_w[(size_t)g * 16384 + c * 128 + a] * pool_scale[g * 128 + a]);
            }
        }
        for (int i = gt; i < 2048 * 8; i += nt) { float s, c; sincos_d((double)(i >> 3) * p.inv_dil[i & 7], s, c); TAB[TAB_DC + i] = c; TAB[TAB_DS + i] = s; }
        for (int i = gt; i < 2048 * 64; i += nt) { float s, c; sincos_d((double)(i >> 6) * p.inv_ret[i & 63], s, c); TAB[TAB_RC + i] = c; TAB[TAB_RS + i] = s; }
    }
    grid.sync();

    {
        side_rstd(SD + SD_H, 1024, 1.0f / 1024.0f, sred);
        InPlain in{SD + SD_H, even_mix_norm}; EpStore ep{SD + SD_Z, sred + SRED_RSTD, 1.0f, 1};
        side_gemv(even_w_in + 512, EVEN_IN, 1024, 1024, in, ep, sred);
    }
    for (int g4 = 0; g4 < 4; ++g4) {
        const int l = g4 >> 1, isv = g4 & 1;
        const bf16_t* mn = MEMN + (size_t)l * MROWS * 1024; const bf16_t* wk = WB + W_L0 + (size_t)l * WL_SIZE + WL_KV;
        Epi<EP_PLAIN> E{KV + (size_t)l * MROWS * 2048 + (size_t)isv * MROWS * 1024, isv ? MROWS : 1024, nullptr, 0, nullptr, nullptr, nullptr};
        for (int rep_ = 0; rep_ < REP_GEMM; ++rep_) run_gemm<EP_PLAIN>(lds, isv ? wk + (size_t)1024 * 1024 : mn, isv ? mn : wk, isv ? 1024 : MROWS, isv ? MROWS : 1024, 1024, E, isv ? (int)(gridDim.x >> 1) : 0);
    }

    for (int layer = 0; layer < 2; ++layer) {
        const bf16_t* wl = WB + W_L0 + (size_t)layer * WL_SIZE;
        float* ss_base = SS + (size_t)(layer * 3 + 2) * SS_STRIDE;
        const float* ss_prev = (layer == 0) ? SS : SS + (size_t)4 * SS_STRIDE;
        const int ns_prev = (layer == 0) ? 4 : 16;
        if (layer == 0) {
            { Epi<EP_EVEN_IN> E{Z, EVEN_IN, ss_prev, ns_prev, nullptr, nullptr, SS + SS_STRIDE};
              for (int rep_ = 0; rep_ < REP_GEMM; ++rep_) run_gemm<EP_EVEN_IN>(lds, HB, WB + W_EIN, T, EVEN_IN, 1024, E); }
            GSYNC();
            {
                side_rstd(SD + SD_Z + 512 * 32, 512, 1.0f / 512.0f, sred);
                InSgu in{SD + SD_Z, sgu_w, sgu_b, sgu_norm, sred + SRED_RSTD};
                side_gemv_ks(even_w_out + (size_t)512 * 1024, 1024, 512, 1024, in, SD + SD_H, sred);
            }
            for (int rep_ = 0; rep_ < REP_EM; ++rep_) even_mix_units(lds, Z, SS + SS_STRIDE, (const bf16_t*)(p.ws + WS_TAB + TABB_WSB), (const bf16_t*)(p.ws + WS_TAB + TABB_PWT), sgu_norm, sgu_b, Y);
            GSYNC();
        } else {
            {
                side_rstd(SD + SD_H, 1024, 1.0f / 1024.0f, sred);
                InPlain in{SD + SD_H, ffn_norm}; EpStore ep{SD + SD_Z, sred + SRED_RSTD, 1.0f, 0};
                side_gemv(ffn_w_gate_up, GU, 1024, GU, in, ep, sred);
            }
            { Epi<EP_ODD_IN> E{Z, ODD_IN, ss_prev, ns_prev, nullptr, nullptr, nullptr};
              for (int rep_ = 0; rep_ < REP_GEMM; ++rep_) run_gemm<EP_ODD_IN>(lds, HB, WB + W_OIN, T, ODD_IN, 1024, E); }
            GSYNC();
            {
                InSwiglu in{SD + SD_Z};
                side_gemv_ks(ffn_w_down, 1024, DFF, 1024, in, SD + SD_H, sred);
            }
            for (int rep_ = 0; rep_ < REP_R1; ++rep_) ret_r1(lds, Z, TAB, RET);
            for (int rep_ = 0; rep_ < REP_DIL; ++rep_) dil_units(lds, Z, TAB, (bf16_t*)H, Y, SS + (size_t)6 * SS_STRIDE);
            GSYNC();
            {
                side_rstd(SD + SD_H, 1024, 1.0f / 1024.0f, sred);
                InPlain in{SD + SD_H, odd_mix_norm}; EpStore ep{SD + SD_Z, sred + SRED_RSTD, 1.0f, 0};
                side_gemv(odd_w_in + 1536, ODD_IN, 1024, 1024, in, ep, sred);
            }
            dil_combine((const bf16_t*)H, Y, SS + (size_t)6 * SS_STRIDE);
            ret_r2(RET);
            GSYNC();
            for (int rep_ = 0; rep_ < REP_R3; ++rep_) ret_r3(lds, Z, TAB, RET, SD + SD_Z, Y);
            GSYNC();
        }

        for (int sub = 0; sub < 3; ++sub) {
            const bf16_t* A = Y; const bf16_t* Bt = (layer == 0) ? (WB + W_EOUT) : (WB + W_OOUT); int K = 1024;
            if (sub == 1) {
                if (layer == 0) {
                PHASE_IDS();
                for (int item = gw; item < 4096; item += nw) {
                    const int i = item >> 2, h = item & 3;
                    const float4 w = *(const float4*)(xattn_wkv + (size_t)i * 2048 + h * 256 + lane * 4);
                    const float* qb = SD + SD_Q + (size_t)(h * 256 + lane * 4) * 32;
                    float mine = 0.f;
#pragma unroll
                    for (int b4 = 0; b4 < 8; ++b4) {
                        const float4 q0 = *(const float4*)(qb + b4 * 4), q1 = *(const float4*)(qb + 32 + b4 * 4), q2 = *(const float4*)(qb + 64 + b4 * 4), q3 = *(const float4*)(qb + 96 + b4 * 4);
                        const float s0 = wave_sum((w.x * q0.x + w.y * q1.x) + (w.z * q2.x + w.w * q3.x)), s1 = wave_sum((w.x * q0.y + w.y * q1.y) + (w.z * q2.y + w.w * q3.y));
                        const float s2 = wave_sum((w.x * q0.z + w.y * q1.z) + (w.z * q2.z + w.w * q3.z)), s3 = wave_sum((w.x * q0.w + w.y * q1.w) + (w.z * q2.w + w.w * q3.w));
                        if (lane == b4 * 4 + 0) mine = s0; if (lane == b4 * 4 + 1) mine = s1; if (lane == b4 * 4 + 2) mine = s2; if (lane == b4 * 4 + 3) mine = s3;
                    }
                    if (lane < 32) SD[SD_R + (size_t)(lane * 4 + h) * 1024 + i] = mine;
                }
            }
                { Epi<EP_SCALE> E{Y, 1024, ss_base, 16, nullptr, nullptr, nullptr};
                  for (int rep_ = 0; rep_ < REP_GEMM; ++rep_) run_gemm<EP_SCALE>(lds, HB, wl + WL_Q, T, 1024, 1024, E); }
                GSYNC();
                if (layer == 0) {
                    PHASE_IDS();
                    for (int item = gw; item < 8192; item += nw) {
                        const int b = item >> 8;
                        const float4* mr = (const float4*)(mem + (size_t)item * 1024);
                        float ssq = 0.f, a0 = 0.f, a1 = 0.f, a2 = 0.f, a3 = 0.f;
#pragma unroll
                        for (int q = 0; q < 4; ++q) {
                            const int idx = lane + 64 * q;
                            const float4 m = mr[idx], g = ((const float4*)mem_norm)[idx];
                            ssq += (m.x * m.x + m.y * m.y) + (m.z * m.z + m.w * m.w);
                            const float4 mg = make_float4(m.x * g.x, m.y * g.y, m.z * g.z, m.w * g.w);
                            const float4 r0 = ((const float4*)(SD + SD_R + (size_t)(b * 4 + 0) * 1024))[idx], r1 = ((const float4*)(SD + SD_R + (size_t)(b * 4 + 1) * 1024))[idx];
                            const float4 r2 = ((const float4*)(SD + SD_R + (size_t)(b * 4 + 2) * 1024))[idx], r3 = ((const float4*)(SD + SD_R + (size_t)(b * 4 + 3) * 1024))[idx];
                            a0 += (mg.x * r0.x + mg.y * r0.y) + (mg.z * r0.z + mg.w * r0.w); a1 += (mg.x * r1.x + mg.y * r1.y) + (mg.z * r1.z + mg.w * r1.w);
                            a2 += (mg.x * r2.x + mg.y * r2.y) + (mg.z * r2.z + mg.w * r2.w); a3 += (mg.x * r3.x + mg.y * r3.y) + (mg.z * r3.z + mg.w * r3.w);
                        }
                        ssq = wave_sum(ssq); a0 = wave_sum(a0); a1 = wave_sum(a1); a2 = wave_sum(a2); a3 = wave_sum(a3);
                        const float rs = rsqrtf(ssq * (1.0f / 1024.0f) + 1e-6f);
                        if (lane == 0) { const int j = item & 255; float* pp = SD + SD_P + (size_t)b * 4 * 256 + j; pp[0] = a0 * rs; pp[256] = a1 * rs; pp[512] = a2 * rs; pp[768] = a3 * rs; SD[SD_M + item] = rs; }
                    }
                }
                xattn_phase(lds, Y, KV + (size_t)layer * MROWS * 2048, KV + (size_t)layer * MROWS * 2048 + (size_t)MROWS * 1024);
                GSYNC();
                Bt = wl + WL_O;
            } else if (sub == 2) {
                if (layer == 0) {
                InHead in{SD + SD_T}; EpStore ep{SD + SD_O, nullptr, 1.0f, 0};
                side_gemv(xattn_wkv + 1024, 2048, 1024, 1024, in, ep, sred);
            }
                { Epi<EP_GU> E{Z, DFF, ss_base + SS_STRIDE, 16, nullptr, nullptr, nullptr};
                  for (int rep_ = 0; rep_ < REP_GEMM; ++rep_) run_gemm<EP_GU>(lds, HB, wl + WL_GU, T, GU, 1024, E); }
                GSYNC();
                A = Z; Bt = wl + WL_DN; K = DFF;
            }
            if (layer == 0 && sub == 0) {
                side_rstd(SD + SD_H, 1024, 1.0f / 1024.0f, sred);
                InPlain in{SD + SD_H, xattn_norm}; EpStore ep{SD + SD_Q, sred + SRED_RSTD, 0.0625f, 0};
                side_gemv(xattn_wq, 1024, 1024, 1024, in, ep, sred);
            }
            if (layer == 0 && sub == 1) {
                    PHASE_IDS();
                    LAS float* pl = sred; LAS float* prt = sred + 1024;
                    for (int item = blockIdx.x; item < 256; item += gridDim.x) {
                        const int b = item >> 3, il = tid & 127, i = (item & 7) * 128 + il, jg = tid >> 7;
                        if (wave < 4) {
                            const float* sp = SD + SD_P + (size_t)(b * 4 + wave) * 256;
                            float e0 = sp[lane], e1 = sp[lane + 64], e2 = sp[lane + 128], e3 = sp[lane + 192];
                            const float mx = wave_max(fmaxf(fmaxf(e0, e1), fmaxf(e2, e3)));
                            e0 = __expf(e0 - mx); e1 = __expf(e1 - mx); e2 = __expf(e2 - mx); e3 = __expf(e3 - mx);
                            const float inv = 1.0f / wave_sum((e0 + e1) + (e2 + e3));
                            const float* rm = SD + SD_M + b * 256;
                            pl[wave * 256 + lane] = e0 * inv * rm[lane]; pl[wave * 256 + lane + 64] = e1 * inv * rm[lane + 64];
                            pl[wave * 256 + lane + 128] = e2 * inv * rm[lane + 128]; pl[wave * 256 + lane + 192] = e3 * inv * rm[lane + 192];
                        }
                        __syncthreads();
                        float t0 = 0.f, t1 = 0.f, t2 = 0.f, t3 = 0.f;
                        const float* mc = mem + (size_t)b * 256 * 1024 + (size_t)(jg * 64) * 1024 + i;
#pragma unroll 16
                        for (int j = 0; j < 64; ++j) { const float m = mc[(size_t)j * 1024]; const int jj = jg * 64 + j; t0 += pl[jj] * m; t1 += pl[256 + jj] * m; t2 += pl[512 + jj] * m; t3 += pl[768 + jj] * m; }
                        prt[(jg * 4 + 0) * 128 + il] = t0; prt[(jg * 4 + 1) * 128 + il] = t1; prt[(jg * 4 + 2) * 128 + il] = t2; prt[(jg * 4 + 3) * 128 + il] = t3;
                        __syncthreads();
                        {
                            const int hh = tid >> 7;
                            const float tsum = (prt[(0 * 4 + hh) * 128 + il] + prt[(1 * 4 + hh) * 128 + il]) + (prt[(2 * 4 + hh) * 128 + il] + prt[(3 * 4 + hh) * 128 + il]);
                            SD[SD_T + ((size_t)hh * 1024 + i) * 32 + b] = tsum * mem_norm[i];
                        }
                        __syncthreads();
                    }
                }
            if (layer == 0 && sub == 2) {
                    InPlain in{SD + SD_O, nullptr};
                    side_gemv_ks(xattn_wo, 1024, 1024, 1024, in, SD + SD_H, sred);
                }
            { Epi<EP_RES> E{HB, 1024, nullptr, 0, HB, nullptr, ss_base + (size_t)sub * SS_STRIDE};
              run_gemm<EP_RES>(lds, A, Bt, T, 1024, K, E); }
            GSYNC();
        }
    }

    {
        const float* ssf = SS + (size_t)7 * SS_STRIDE;
        PHASE_IDS();
        for (int row = gw; row < T; row += nw) {
            const float sp = (lane < 16) ? ssf[(size_t)row * 16 + lane] : 0.f;
            const float rs = rsqrtf(wave_sum(sp) * (1.0f / 1024.0f) + 1e-6f);
            float4* hr = (float4*)(H + (size_t)row * 1024);
            const uint2* hb = (const uint2*)(HB + (size_t)row * 1024);
#pragma unroll
            for (int i = 0; i < 4; ++i) {
                const uint2 q = hb[lane + 64 * i];
                const float4 g = ((const float4*)final_norm)[lane + 64 * i];
                float4 v; v.x = bflo(q.x) * rs * g.x; v.y = bfhi(q.x) * rs * g.y; v.z = bflo(q.y) * rs * g.z; v.w = bfhi(q.y) * rs * g.w;
                hr[lane + 64 * i] = v;
            }
        }
    }
}

extern "C" void kernel_launch(void* const* d_in, const int* in_sizes, int n_in, void* d_out, int out_size, void* d_ws, size_t ws_size, hipStream_t stream) {
    static int grid_blocks = 0;
    if (grid_blocks == 0) {
        if (n_in != 22 || out_size != T * DM || ws_size < WS_END) { fprintf(stderr, "kernel_launch: unexpected shapes (n_in %d, out %d, ws %zu)\n", n_in, out_size, ws_size); grid_blocks = -1; return; }
        int dev = 0, cus = 0, per_cu = 0;
        hipGetDevice(&dev);
        hipDeviceGetAttribute(&cus, hipDeviceAttributeMultiprocessorCount, dev);
        hipOccupancyMaxActiveBlocksPerMultiprocessor(&per_cu, fwd_mega, 512, 0);
        if (per_cu < 1) per_cu = 1;
        if (per_cu > 1) per_cu = 1;
        grid_blocks = cus * per_cu;
    }
    if (grid_blocks < 0) return;
    Params p;
    memset(&p, 0, sizeof(p));
    for (int i = 0; i < 22; ++i) p.in[i] = (const float*)d_in[i];
    p.out = (float*)d_out; p.ws = (unsigned char*)d_ws;
    for (int i = 0; i < 8; ++i) p.inv_dil[i] = std::exp(-((double)i / 8.0) * std::log(500000.0));
    for (int i = 0; i < 64; ++i) p.inv_ret[i] = std::exp(-((double)i / 64.0) * std::log(10000.0));
    (void)hipMemsetAsync((char*)d_ws + WS_BAR, 0, XCD_BAR_WORDS * 4, stream);
    void* args[] = {&p};
    hipError_t e = hipLaunchCooperativeKernel((void*)fwd_mega, dim3(grid_blocks), dim3(512), args, 0, stream);
    if (e != hipSuccess) fprintf(stderr, "cooperative launch failed: %s (grid %d)\n", hipGetErrorString(e), grid_blocks);
}
```

```cpp
#include <hip/hip_runtime.h>
#include <hip/hip_cooperative_groups.h>
#include <cstdio>
#include <cmath>
namespace cg = cooperative_groups;
#include <cstring>
namespace pg8 {
#define PG8_LAS __attribute__((address_space(3)))
typedef unsigned short bf16_t;
typedef short bf16x8 __attribute__((ext_vector_type(8)));
typedef float f32x4 __attribute__((ext_vector_type(4)));
typedef unsigned u32x4 __attribute__((ext_vector_type(4)));
constexpr int BM = 256, BK = 64, HALF = 128, HTB = HALF * BK * 2  , STAGE_BYTES = 8 * HTB, NXCD = 8, WGM = 4;

__host__ __device__ __forceinline__ int lds_byte(int r, int c) { const int st = (r >> 4) * 2 + (c >> 5), rr = r & 15, cc = c & 31, ob = rr * 64 + cc * 2; return st * 1024 + (ob ^ (((ob >> 9) & 1) << 5)); }
__host__ __device__ __forceinline__ void stage_rc(int b, int& R, int& C) { const int st = b / 1024, sb = b % 1024, swz = sb ^ (((sb >> 9) & 1) << 5); R = (st >> 1) * 16 + swz / 64; C = (st & 1) * 32 + (swz % 64) / 2; }
__host__ __device__ __forceinline__ int perm32(int rho) { const int n = rho >> 4, i = rho & 15; return 8 * (i >> 2) + 4 * n + (i & 3); }

struct Unit { int pm, pn; };
struct Gemm { const bf16_t* A; const bf16_t* Bt; int M, N, K; };

struct StaticOrder {
    int nM, nN, nwg, G, c;
    __host__ __device__ void init(int M, int N, int G_, int c_) { nM = M / BM; nN = N / BM; nwg = nM * nN; G = G_; c = c_; }
    __host__ __device__ bool next(int i, Unit& u) const {
        const long L = (long)i * G + c; if (L >= nwg) return false;
        int wgid = (int)L; { const int q = nwg / NXCD, r = nwg % NXCD, xcd = wgid % NXCD, off = wgid / NXCD; wgid = (xcd < r ? xcd * (q + 1) : r * (q + 1) + (xcd - r) * q) + off; }
        const int nig = WGM * nN, gid = wgid / nig, fm = gid * WGM, gsz = (nM - fm) < WGM ? (nM - fm) : WGM;
        u.pm = fm + ((wgid % nig) % gsz); u.pn = (wgid % nig) / gsz; return true;
    }
    __device__ __forceinline__ void a_ready(const Unit&) const {}
    __device__ __forceinline__ void done(const Unit&) const {}
};
__device__ __forceinline__ unsigned cvt_pk_bf16(float lo, float hi) { unsigned r; asm volatile("v_cvt_pk_bf16_f32 %0, %1, %2" : "=v"(r) : "v"(lo), "v"(hi)); return r; }
typedef float f32x2 __attribute__((ext_vector_type(2)));
template <class Epi, class Sched, bool ALIGN_EPI = false, bool SP2 = false>
__device__ __forceinline__ void gemm_phase(PG8_LAS unsigned char* lds, const Gemm g, const Sched& S, const Epi& E) {
    int tid_o = threadIdx.x; asm volatile("" : "+v"(tid_o));
    const int tid = tid_o, wid = __builtin_amdgcn_readfirstlane(tid >> 6), lane = tid & 63, wr = wid >> 2, wc = wid & 3, fr = lane & 15, fq = lane >> 4;
    const int K = g.K, nt = K / BK;
    unsigned voffA[2], voffB[2];
#pragma unroll
    for (int i = 0; i < 2; ++i) { int R, C; stage_rc(tid * 16 + i * 8192, R, C); const int Rb = Epi::PERM ? ((R & ~31) + perm32(R & 31)) : R;
        voffA[i] = (unsigned)(R * K + C) * 2u; voffB[i] = (unsigned)(Rb * K + C) * 2u; }
    const size_t kstep = (size_t)(BK * 2);
    const size_t hstep = (size_t)HALF * K * 2;
    const size_t tstep = 2 * hstep;
    const unsigned ldsw = (unsigned)wid * 1024u;
    const int aoff = lds_byte(wr * 64 + fr, fq * 8), boff = lds_byte(wc * 32 + fr, fq * 8);
#define PG8_SA(b, h) (((b) * 2 + (h)) * HTB)
#define PG8_SB(b, h) ((4 + (b) * 2 + (h)) * HTB)
#define PG8_STAGE(bufoff, gbase, voff) do { const char* _gb = (const char*)(gbase); asm volatile("" : "+s"(_gb)); _Pragma("unroll") for (int _i = 0; _i < 2; ++_i) \
        __builtin_amdgcn_global_load_lds((const unsigned*)(_gb + (voff)[_i]), (PG8_LAS unsigned*)(lds + (bufoff) + ldsw + _i * 8192), 16, 0, 0); } while (0)
#define PG8_LDA(dst, b, h) do { _Pragma("unroll") for (int m = 0; m < 4; ++m) _Pragma("unroll") for (int k = 0; k < 2; ++k) dst[m][k] = *(const PG8_LAS bf16x8*)(lds + PG8_SA(b, h) + aoff + m * 2048 + k * 1024); } while (0)
#define PG8_LDB(dst, b, h) do { _Pragma("unroll") for (int n = 0; n < 2; ++n) _Pragma("unroll") for (int k = 0; k < 2; ++k) dst[n][k] = *(const PG8_LAS bf16x8*)(lds + PG8_SB(b, h) + boff + n * 2048 + k * 1024); } while (0)
#define PG8_MMA(ai, bj, At, Bt) do { __builtin_amdgcn_s_setprio(1); _Pragma("unroll") for (int m = 0; m < 4; ++m) _Pragma("unroll") for (int n = 0; n < 2; ++n) _Pragma("unroll") for (int k = 0; k < 2; ++k) \
        acc[ai][bj][m][n] = __builtin_amdgcn_mfma_f32_16x16x32_bf16(Bt[n][k], At[m][k], acc[ai][bj][m][n], 0, 0, 0); __builtin_amdgcn_s_setprio(0); } while (0)
#define PG8_WAIT_V(n) asm volatile("s_waitcnt vmcnt(" #n ")" ::: "memory")
#define PG8_WAIT_L(n) asm volatile("s_waitcnt lgkmcnt(" #n ")" ::: "memory")
#define PG8_BAR __builtin_amdgcn_s_barrier()
#define PG8_SCHED __builtin_amdgcn_sched_barrier(0)
    Unit cur, nxt; int ui = 0;
    if (!S.next(0, cur)) return;
    f32x4 acc[2][2][4][2];
#pragma unroll
    for (int a = 0; a < 2; ++a)
#pragma unroll
        for (int b = 0; b < 2; ++b)
#pragma unroll
            for (int m = 0; m < 4; ++m)
#pragma unroll
                for (int n = 0; n < 2; ++n) acc[a][b][m][n] = (f32x4){0.f, 0.f, 0.f, 0.f};
    bf16x8 At[4][2], B0[2][2], B1[2][2];
    const char* cA = (const char*)g.A + (size_t)cur.pm * tstep; const char* cB = (const char*)g.Bt + (size_t)cur.pn * tstep;
    S.a_ready(cur);
    if constexpr (SP2) {
        PG8_STAGE(PG8_SB(0, 0), cB, voffB); PG8_STAGE(PG8_SB(0, 1), cB + hstep, voffB); PG8_STAGE(PG8_SA(0, 0), cA, voffA); PG8_STAGE(PG8_SA(0, 1), cA + hstep, voffA);
        if (wr == 1) PG8_BAR;
        PG8_WAIT_V(2); PG8_BAR;
        PG8_STAGE(PG8_SB(1, 0), cB + kstep, voffB); PG8_STAGE(PG8_SA(1, 0), cA + kstep, voffA); PG8_STAGE(PG8_SB(1, 1), cB + hstep + kstep, voffB);
        PG8_WAIT_V(6); PG8_BAR;
    } else {
        PG8_STAGE(PG8_SB(0, 0), cB, voffB); PG8_STAGE(PG8_SA(0, 0), cA, voffA); PG8_STAGE(PG8_SB(0, 1), cB + hstep, voffB); PG8_STAGE(PG8_SA(0, 1), cA + hstep, voffA);
        if (wr == 1) PG8_BAR;
        PG8_WAIT_V(4); PG8_BAR;
        PG8_STAGE(PG8_SB(1, 0), cB + kstep, voffB); PG8_STAGE(PG8_SA(1, 0), cA + kstep, voffA); PG8_STAGE(PG8_SB(1, 1), cB + hstep + kstep, voffB);
        PG8_WAIT_V(6); PG8_BAR;
    }
    for (;;) {
        const bool has_next = S.next(ui + 1, nxt);
        const char* nA = has_next ? (const char*)g.A + (size_t)nxt.pm * tstep : cA; const char* nB = has_next ? (const char*)g.Bt + (size_t)nxt.pn * tstep : cB;
        for (int t = 0; t < nt; t += 2) {
            const bool last = (t == nt - 2);
            const char* a1 = cA + (size_t)(t + 1) * kstep;
            const char* a2 = last ? nA : cA + (size_t)(t + 2) * kstep; const char* b2 = last ? nB : cB + (size_t)(t + 2) * kstep;
            const char* a3 = a2 + kstep; const char* b3 = b2 + kstep;
            if (last && has_next) S.a_ready(nxt);
            if constexpr (SP2) {
            PG8_LDB(B0, 0, 0); PG8_LDB(B1, 0, 1); PG8_SCHED; PG8_LDA(At, 0, 0); PG8_STAGE(PG8_SA(1, 1), a1 + hstep, voffA);
            PG8_WAIT_V(8); PG8_WAIT_L(0); PG8_BAR; PG8_MMA(0, 0, At, B0); PG8_MMA(0, 1, At, B1); PG8_BAR; PG8_SCHED;
            PG8_LDA(At, 0, 1); PG8_STAGE(PG8_SB(0, 0), b2, voffB); PG8_STAGE(PG8_SB(0, 1), b2 + hstep, voffB); PG8_STAGE(PG8_SA(0, 0), a2, voffA);
            PG8_WAIT_V(8); PG8_WAIT_L(0); PG8_BAR; PG8_MMA(1, 0, At, B0); PG8_MMA(1, 1, At, B1); PG8_BAR; PG8_SCHED;
            PG8_LDB(B0, 1, 0); PG8_LDB(B1, 1, 1); PG8_SCHED; PG8_LDA(At, 1, 0); PG8_STAGE(PG8_SA(0, 1), a2 + hstep, voffA);
            PG8_WAIT_V(8); PG8_WAIT_L(0); PG8_BAR; PG8_MMA(0, 0, At, B0); PG8_MMA(0, 1, At, B1); PG8_BAR; PG8_SCHED;
            PG8_LDA(At, 1, 1); PG8_STAGE(PG8_SB(1, 0), b3, voffB); PG8_STAGE(PG8_SB(1, 1), b3 + hstep, voffB); PG8_STAGE(PG8_SA(1, 0), a3, voffA);
            PG8_WAIT_V(8); PG8_WAIT_L(0); PG8_BAR; PG8_MMA(1, 0, At, B0); PG8_MMA(1, 1, At, B1); PG8_BAR; PG8_SCHED;
            } else {
            PG8_LDB(B0, 0, 0); PG8_SCHED; PG8_LDA(At, 0, 0); PG8_STAGE(PG8_SA(1, 1), a1 + hstep, voffA);
            PG8_WAIT_L(8); PG8_BAR; PG8_WAIT_L(0); PG8_MMA(0, 0, At, B0); PG8_BAR; PG8_SCHED;
            PG8_LDB(B1, 0, 1); PG8_STAGE(PG8_SB(0, 0), b2, voffB);
            PG8_BAR; PG8_WAIT_L(0); PG8_MMA(0, 1, At, B1); PG8_BAR;
            PG8_LDA(At, 0, 1); PG8_STAGE(PG8_SA(0, 0), a2, voffA);
            PG8_BAR; PG8_WAIT_L(0); PG8_MMA(1, 0, At, B0); PG8_BAR; PG8_SCHED;
            PG8_STAGE(PG8_SB(0, 1), b2 + hstep, voffB);
            PG8_WAIT_V(6); PG8_BAR; PG8_MMA(1, 1, At, B1); PG8_BAR;
            PG8_LDB(B0, 1, 0); PG8_SCHED; PG8_LDA(At, 1, 0); PG8_STAGE(PG8_SA(0, 1), a2 + hstep, voffA);
            PG8_WAIT_L(8); PG8_BAR; PG8_WAIT_L(0); PG8_MMA(0, 0, At, B0); PG8_BAR; PG8_SCHED;
            PG8_LDB(B1, 1, 1); PG8_STAGE(PG8_SB(1, 0), b3, voffB);
            PG8_BAR; PG8_WAIT_L(0); PG8_MMA(0, 1, At, B1); PG8_BAR;
            PG8_LDA(At, 1, 1); PG8_STAGE(PG8_SA(1, 0), a3, voffA);
            PG8_BAR; PG8_WAIT_L(0); PG8_MMA(1, 0, At, B0); PG8_BAR; PG8_SCHED;
            PG8_STAGE(PG8_SB(1, 1), b3 + hstep, voffB);
            PG8_WAIT_V(6); PG8_BAR; PG8_MMA(1, 1, At, B1); PG8_BAR;
            }
        }
        if constexpr (ALIGN_EPI) { if (wr == 0) PG8_BAR; }
        if constexpr (!Epi::AFTER_DRAIN) { E(acc, cur, wr, wc, fr, fq); S.done(cur); }
        if (!has_next) break;
#pragma unroll
        for (int a = 0; a < 2; ++a)
#pragma unroll
            for (int b = 0; b < 2; ++b)
#pragma unroll
                for (int m = 0; m < 4; ++m)
#pragma unroll
                    for (int n = 0; n < 2; ++n) acc[a][b][m][n] = (f32x4){0.f, 0.f, 0.f, 0.f};
        cur = nxt; cA = nA; cB = nB; ++ui;
        if constexpr (ALIGN_EPI) { if (wr == 1) PG8_BAR; }
    }
    PG8_WAIT_V(0);
    if constexpr (!ALIGN_EPI) { if (wr == 0) PG8_BAR; }
    PG8_BAR;
    if constexpr (Epi::AFTER_DRAIN) { E.fused(acc, cur, wr, wc, fr, fq, lds, wid, lane); S.done(cur); }
#undef PG8_SA
#undef PG8_SB
#undef PG8_STAGE
#undef PG8_LDA
#undef PG8_LDB
#undef PG8_MMA
#undef PG8_WAIT_V
#undef PG8_WAIT_L
#undef PG8_BAR
#undef PG8_SCHED
}
}

using pg8::bf16_t; using pg8::f32x4; using pg8::Unit; using pg8::cvt_pk_bf16;
#define LAS __attribute__((address_space(3)))
constexpr int T = 65536, DM = 1024, SEQ = 2048, MROWS = 8192;
constexpr int EVEN_IN = 1536, ODD_IN = 3584, DFF = 2816, GU = 5632;
constexpr size_t MiB = 1024ull * 1024ull;
constexpr size_t WS_HB = 0, WS_Z = 128 * MiB, WS_Y = 576 * MiB, WS_W = 704 * MiB, WS_MEMN = 768 * MiB, WS_KV = 800 * MiB, WS_SS = 864 * MiB, WS_TAB = 896 * MiB, WS_SIDE = 898 * MiB, WS_RET = 906 * MiB, WS_BAR = 970 * MiB, WS_END = 971 * MiB;
constexpr size_t W_EIN = 0, W_EOUT = W_EIN + 1536ull * 1024, W_OIN = W_EOUT + 1024ull * 1024, W_OOUT = W_OIN + 3584ull * 1024, W_L0 = W_OOUT + 1024ull * 1024;
constexpr size_t WL_Q = 0, WL_KV = 1024ull * 1024, WL_O = WL_KV + 2048ull * 1024, WL_GU = WL_O + 1024ull * 1024, WL_DN = WL_GU + 5632ull * 1024, WL_SIZE = WL_DN + 1024ull * 2816;
static_assert((W_L0 + 2 * WL_SIZE) * 2 <= 64 * MiB, "weights region");
constexpr size_t SS_STRIDE = (size_t)T * 16;
constexpr size_t TAB_DC = 0, TAB_DS = 2048 * 8, TAB_RC = 2 * 2048 * 8, TAB_RS = TAB_RC + 2048 * 64;
constexpr size_t SD_H = 0, SD_Z = SD_H + 1024 * 32, SD_Q = SD_Z + 5632 * 32, SD_R = SD_Q + 1024 * 32, SD_P = SD_R + 32 * 4 * 1024, SD_M = SD_P + 32 * 4 * 256, SD_T = SD_M + 32 * 256, SD_O = SD_T + 4 * 1024 * 32, SD_END = SD_O + 1024 * 32;
static_assert(SD_END * 4 <= 8 * MiB, "side region");

typedef short bf16x8_t __attribute__((ext_vector_type(8)));
typedef unsigned u32x4_t __attribute__((ext_vector_type(4)));
typedef unsigned u32x2_t __attribute__((ext_vector_type(2)));
struct Params {
    const float* in[22];
    float* out;
    unsigned char* ws;
    double inv_dil[8];
    double inv_ret[64];
};

__device__ __forceinline__ int opaque_tid() { int t = threadIdx.x; asm volatile("" : "+v"(t)); return t; }
__device__ __forceinline__ int xcd_unit(int it, int total) {
    const int G = (int)gridDim.x, bx = (int)blockIdx.x;
    if ((G & 7) || (total & 7)) { const int u = it * G + bx; return u < total ? u : -1; }
    const int per = total >> 3, ny = G >> 3, idx = it * ny + (bx >> 3);
    return idx < per ? (bx & 7) * per + idx : -1;
}
#define LDS_BARRIER() do { asm volatile("s_waitcnt lgkmcnt(0)" ::: "memory"); __builtin_amdgcn_s_barrier(); asm volatile("" ::: "memory"); } while (0)
__device__ __forceinline__ float bf2f(unsigned short v) { return __uint_as_float((unsigned)v << 16); }
__device__ __forceinline__ float bflo(unsigned v) { return __uint_as_float(v << 16); }
__device__ __forceinline__ float bfhi(unsigned v) { return __uint_as_float(v & 0xffff0000u); }
__device__ __forceinline__ unsigned short f2bf(float f) { return (unsigned short)(cvt_pk_bf16(f, 0.f) & 0xffffu); }
__device__ __forceinline__ float dot8(const uint4 a, const uint4 b) {
    float s = bflo(a.x) * bflo(b.x); s += bfhi(a.x) * bfhi(b.x);
    s += bflo(a.y) * bflo(b.y); s += bfhi(a.y) * bfhi(b.y);
    s += bflo(a.z) * bflo(b.z); s += bfhi(a.z) * bfhi(b.z);
    s += bflo(a.w) * bflo(b.w); s += bfhi(a.w) * bfhi(b.w);
    return s;
}
__device__ __forceinline__ float wave_sum(float v) {
#pragma unroll
    for (int o = 32; o >= 1; o >>= 1) v += __shfl_xor(v, o);
    return v;
}
__device__ __forceinline__ float wave_max(float v) {
#pragma unroll
    for (int o = 32; o >= 1; o >>= 1) v = fmaxf(v, __shfl_xor(v, o));
    return v;
}
__device__ __forceinline__ float silu_f(float x) { return x * __builtin_amdgcn_rcpf(1.0f + __builtin_amdgcn_exp2f(-1.4426950408889634f * x)); }
__device__ __forceinline__ float gelu_tanh_f(float x) {
    const float y = 1.5957691216057308f * (x + 0.044715f * x * x * x);
    return x * __builtin_amdgcn_rcpf(1.0f + __builtin_amdgcn_exp2f(-1.4426950408889634f * y));
}
__device__ __forceinline__ float row_rstd(const float* ss, int nslot, int row, float inv_dim) {
    float s = 0.f;
    for (int i = 0; i < nslot; i += 4) { const float4 v = *(const float4*)(ss + (size_t)row * 16 + i); s += (v.x + v.y) + (v.z + v.w); }
    return rsqrtf(s * inv_dim + 1e-6f);
}
__device__ __forceinline__ float coop_rstd(const float* ss, int nslot, int row, int fq, float inv_dim) {
    float s = 0.f;
    if (4 * fq < nslot) { const float4 v = *(const float4*)(ss + (size_t)row * 16 + 4 * fq); s = (v.x + v.y) + (v.z + v.w); }
    s += __shfl_xor(s, 16); s += __shfl_xor(s, 32);
    return rsqrtf(s * inv_dim + 1e-6f);
}

enum { EP_EVEN_IN = 0, EP_RES = 1, EP_SCALE = 2, EP_GU = 3, EP_ODD_IN = 4, EP_PLAIN = 5 };
template <int MODE> struct Epi {
    static constexpr bool PERM = true, AFTER_DRAIN = false;
    bf16_t* O; int ldo;
    const float* ss_in; int ns_in;
    const bf16_t* res; float* hout;
    float* ss_out;
    __device__ __forceinline__ void operator()(const f32x4 (&acc)[2][2][4][2], const Unit& u, int wr, int wc, int fr_in, int fq_in) const {
        int fr = fr_in, fq = fq_in;
        asm volatile("" : "+v"(fr), "+v"(fq));
        const int row00 = u.pm * 256 + wr * 64 + fr;
        float rsv[2][4];
        if (MODE == EP_EVEN_IN || MODE == EP_SCALE || MODE == EP_GU || MODE == EP_ODD_IN) {
            float part[2][4];
#pragma unroll
            for (int ai = 0; ai < 2; ++ai)
#pragma unroll
                for (int m = 0; m < 4; ++m) {
                    float sp = 0.f;
                    if (4 * fq < ns_in) { const float4 v = *(const float4*)(ss_in + (size_t)(row00 + ai * 128 + m * 16) * 16 + 4 * fq); sp = (v.x + v.y) + (v.z + v.w); }
                    part[ai][m] = sp;
                }
#pragma unroll
            for (int ai = 0; ai < 2; ++ai)
#pragma unroll
                for (int m = 0; m < 4; ++m) { float sp = part[ai][m]; sp += __shfl_xor(sp, 16); sp += __shfl_xor(sp, 32); rsv[ai][m] = rsqrtf(sp * (1.0f / 1024.0f) + 1e-6f); }
        } else {
#pragma unroll
            for (int ai = 0; ai < 2; ++ai)
#pragma unroll
                for (int m = 0; m < 4; ++m) rsv[ai][m] = 1.0f;
        }
#pragma unroll
        for (int ai = 0; ai < 2; ++ai) {
            u32x4_t rres[4][2];
            if (MODE == EP_RES) {
#pragma unroll
                for (int m = 0; m < 4; ++m)
#pragma unroll
                    for (int bj = 0; bj < 2; ++bj) rres[m][bj] = *(const u32x4_t*)(res + (size_t)(row00 + ai * 128 + m * 16) * 1024 + u.pn * 256 + bj * 128 + wc * 32 + fq * 8);
            }
#pragma unroll
            for (int m = 0; m < 4; ++m) {
                const int row = row00 + ai * 128 + m * 16;
                const float rs = rsv[ai][m];
                if (MODE == EP_GU) {
                    const f32x4 g0 = acc[ai][0][m][0] * rs, g1 = acc[ai][0][m][1] * rs, u0 = acc[ai][1][m][0] * rs, u1 = acc[ai][1][m][1] * rs;
                    uint4 w;
                    w.x = cvt_pk_bf16(silu_f(g0[0]) * u0[0], silu_f(g0[1]) * u0[1]); w.y = cvt_pk_bf16(silu_f(g0[2]) * u0[2], silu_f(g0[3]) * u0[3]);
                    w.z = cvt_pk_bf16(silu_f(g1[0]) * u1[0], silu_f(g1[1]) * u1[1]); w.w = cvt_pk_bf16(silu_f(g1[2]) * u1[2], silu_f(g1[3]) * u1[3]);
                    *(uint4*)(O + (size_t)row * ldo + u.pn * 128 + wc * 32 + fq * 8) = w;
                } else {
                    float sq = 0.f;
#pragma unroll
                    for (int bj = 0; bj < 2; ++bj) {
                        const int col0 = u.pn * 256 + bj * 128 + wc * 32 + fq * 8;
                        f32x4 v0 = acc[ai][bj][m][0] * rs, v1 = acc[ai][bj][m][1] * rs;
                        if (MODE == EP_EVEN_IN) {
                            if (u.pn >= 2) {
#pragma unroll
                                for (int j = 0; j < 4; ++j) { v0[j] = gelu_tanh_f(v0[j]); v1[j] = gelu_tanh_f(v1[j]); }
                            }
                            if (u.pn >= 4) sq += (v0[0] * v0[0] + v0[1] * v0[1]) + (v0[2] * v0[2] + v0[3] * v0[3]) + (v1[0] * v1[0] + v1[1] * v1[1]) + (v1[2] * v1[2] + v1[3] * v1[3]);
                        }
                        if (MODE == EP_ODD_IN) {
                            if (u.pn >= 12) {
#pragma unroll
                                for (int j = 0; j < 4; ++j) { v0[j] = silu_f(v0[j]); v1[j] = silu_f(v1[j]); }
                            }
                        }
                        if (MODE == EP_RES) {
                            { const u32x4_t rr = rres[m][bj];
                              v0[0] += bflo(rr[0]); v0[1] += bfhi(rr[0]); v0[2] += bflo(rr[1]); v0[3] += bfhi(rr[1]); v1[0] += bflo(rr[2]); v1[1] += bfhi(rr[2]); v1[2] += bflo(rr[3]); v1[3] += bfhi(rr[3]); }
                            sq += (v0[0] * v0[0] + v0[1] * v0[1]) + (v0[2] * v0[2] + v0[3] * v0[3]) + (v1[0] * v1[0] + v1[1] * v1[1]) + (v1[2] * v1[2] + v1[3] * v1[3]);
                        }
                        uint4 w;
                        w.x = cvt_pk_bf16(v0[0], v0[1]); w.y = cvt_pk_bf16(v0[2], v0[3]); w.z = cvt_pk_bf16(v1[0], v1[1]); w.w = cvt_pk_bf16(v1[2], v1[3]);
                        *(uint4*)(O + (size_t)row * ldo + col0) = w;
                    }
                    if (MODE == EP_RES) {
                        sq += __shfl_xor(sq, 16); sq += __shfl_xor(sq, 32);
                        if (fq == 0) ss_out[(size_t)row * 16 + u.pn * 4 + wc] = sq;
                    }
                    if (MODE == EP_EVEN_IN) {
                        if (u.pn >= 4) {
                            sq += __shfl_xor(sq, 16); sq += __shfl_xor(sq, 32);
                            if (fq == 0) ss_out[(size_t)row * 16 + (u.pn - 4) * 4 + wc] = sq;
                        }
                    }
                }
            }
            asm volatile("" ::: "memory");
        }
    }
};

#ifndef GEMM_ALIGN
#define GEMM_ALIGN true
#endif
#ifndef GEMM_SP2
#define GEMM_SP2 true
#endif
template <int MODE>
__device__ __forceinline__ void run_gemm(LAS unsigned char* lds, const bf16_t* A, const bf16_t* Bt, int M, int N, int K, const Epi<MODE>& E, int rot = 0) {
#if defined(T_ONLYMODE)
    if (MODE != T_ONLYMODE) return;
#endif
    pg8::Gemm g{A, Bt, M, N, K};
    pg8::StaticOrder S; S.init(M, N, (int)gridDim.x, (int)((blockIdx.x + rot) % gridDim.x));
    pg8::gemm_phase<Epi<MODE>, pg8::StaticOrder, GEMM_ALIGN, GEMM_SP2>(lds, g, S, E);
}

__device__ __forceinline__ void conv_weight(const float* W, const float* gain, bf16_t* Bt, int K, int Nsrc, int N, int mode, LAS float*) {
    const int tid = opaque_tid(), nkt = K / 64, nnt = N / 64;
    const int tx = tid & 63, kq = tid >> 6;
    for (int tix = blockIdx.x; tix < nkt * nnt; tix += gridDim.x) {
        const int kt = tix % nkt, ntl = tix / nkt, k0 = kt * 64 + kq * 8, np = ntl * 64 + tx;
        int src = np; float cs = 1.0f;
        if (mode == 1) { if (np < 512) cs = 0.125f; else if (np >= 2048 && np < 2560) cs = 0.08838834764831845f; }
        else if (mode == 2) cs = 0.0625f;
        else if (mode == 3) { const int pn = np >> 8, r = np & 255; src = (r < 128) ? (pn * 128 + r) : (DFF + pn * 128 + (r - 128)); }
        float v[8];
#pragma unroll
        for (int j = 0; j < 8; ++j) v[j] = W[(size_t)(k0 + j) * Nsrc + src];
        if (gain) {
            const float4 g0 = *(const float4*)(gain + k0), g1 = *(const float4*)(gain + k0 + 4);
            v[0] *= g0.x; v[1] *= g0.y; v[2] *= g0.z; v[3] *= g0.w; v[4] *= g1.x; v[5] *= g1.y; v[6] *= g1.z; v[7] *= g1.w;
        }
        uint4 w;
        w.x = cvt_pk_bf16(v[0] * cs, v[1] * cs); w.y = cvt_pk_bf16(v[2] * cs, v[3] * cs); w.z = cvt_pk_bf16(v[4] * cs, v[5] * cs); w.w = cvt_pk_bf16(v[6] * cs, v[7] * cs);
        *(uint4*)(Bt + (size_t)np * K + k0) = w;
    }
}

__device__ __forceinline__ void sincos_d(double a, float& s_out, float& c_out) {
    const double k = rint(a * 0.63661977236758134308);
    const double r = (a - k * 1.57079632679489655800) - k * 6.12323399573676603587e-17;
    const double r2 = r * r;
    double sp = -1.0 / 1307674368000.0;
    sp = sp * r2 + 1.0 / 6227020800.0; sp = sp * r2 - 1.0 / 39916800.0; sp = sp * r2 + 1.0 / 362880.0; sp = sp * r2 - 1.0 / 5040.0; sp = sp * r2 + 1.0 / 120.0; sp = sp * r2 - 1.0 / 6.0; sp = sp * r2 + 1.0;
    const double sn = sp * r;
    double cp = 1.0 / 20922789888000.0;
    cp = cp * r2 - 1.0 / 87178291200.0; cp = cp * r2 + 1.0 / 479001600.0; cp = cp * r2 - 1.0 / 3628800.0; cp = cp * r2 + 1.0 / 40320.0; cp = cp * r2 - 1.0 / 720.0; cp = cp * r2 + 1.0 / 24.0; cp = cp * r2 - 0.5; cp = cp * r2 + 1.0;
    const int q = ((int)k) & 3;
    double s, c;
    if (q == 0) { s = sn; c = cp; } else if (q == 1) { s = cp; c = -sn; } else if (q == 2) { s = -sn; c = -cp; } else { s = -cp; c = sn; }
    s_out = (float)s; c_out = (float)c;
}


constexpr int SRED_RSTD = 512;
constexpr int SRED_GEMV = 1024;
__device__ __forceinline__ void side_rstd(const float* v_t, int K, float inv_dim, LAS float* red) {
    const int tid = opaque_tid(), b = tid & 31, part = tid >> 5;
    float s = 0.f;
    float s1 = 0.f, s2 = 0.f, s3 = 0.f;
    for (int k = part; k < K; k += 128) {
        const float x0 = v_t[k * 32 + b], x1 = v_t[(k + 16) * 32 + b], x2 = v_t[(k + 32) * 32 + b], x3 = v_t[(k + 48) * 32 + b];
        const float x4 = v_t[(k + 64) * 32 + b], x5 = v_t[(k + 80) * 32 + b], x6 = v_t[(k + 96) * 32 + b], x7 = v_t[(k + 112) * 32 + b];
        s += x0 * x0 + x4 * x4; s1 += x1 * x1 + x5 * x5; s2 += x2 * x2 + x6 * x6; s3 += x3 * x3 + x7 * x7;
    }
    s = (s + s1) + (s2 + s3);
    red[tid] = s;
    __syncthreads();
    if (tid < 32) { float t = 0.f; for (int q = 0; q < 16; ++q) t += red[q * 32 + tid]; red[SRED_RSTD + tid] = rsqrtf(t * inv_dim + 1e-6f); }
    __syncthreads();
}
constexpr int SRED_IN = SRED_GEMV + 8 * 32 * 64;
template <class InF, class EpiF>
__device__ __forceinline__ void side_gemv(const float* W, int ldw, int K, int N, const InF& in, const EpiF& epi, LAS float* red) {
    const int tid = opaque_tid(), lane = tid & 63;
    const int kg = __builtin_amdgcn_readfirstlane(tid >> 6);
    const int ns = K >> 8;
    for (int c = blockIdx.x; c < (N >> 6); c += gridDim.x) {
        float acc[32];
#pragma unroll
        for (int b = 0; b < 32; ++b) acc[b] = 0.f;
        float xs[16];
        int t0 = tid; asm volatile("" : "+v"(t0));
#pragma unroll
        for (int i = 0; i < 16; ++i) { const int idx = t0 + 512 * i, k = idx >> 5; xs[i] = in.v(k, idx & 31, c) * in.ws(k); }
        __syncthreads();
#pragma unroll
        for (int i = 0; i < 16; ++i) red[SRED_IN + t0 + 512 * i] = xs[i];
        __syncthreads();
        for (int sl = 0; sl < ns; ++sl) {
            const int ks = sl << 8;
            LAS float* xin = red + SRED_IN + (sl & 1) * 8192;
            const float* wp = W + (size_t)(ks + 32 * kg) * ldw + c * 64 + lane;
            float w[32];
#pragma unroll
            for (int i = 0; i < 32; ++i) w[i] = wp[(size_t)i * ldw];
            LAS float* wl = red + SRED_GEMV + (kg * 32) * 64 + lane;
#pragma unroll
            for (int i = 0; i < 32; ++i) wl[i * 64] = w[i];
            asm volatile("" ::: "memory");
            int t1 = tid; asm volatile("" : "+v"(t1));
            if (sl + 1 < ns) {
#pragma unroll
                for (int i = 0; i < 16; ++i) { const int idx = t1 + 512 * i, k = ks + 256 + (idx >> 5); xs[i] = in.v(k, idx & 31, c) * in.ws(k); }
            }
#pragma unroll 1
            for (int k4 = 0; k4 < 8; ++k4) {
                const LAS f32x4* xv = (const LAS f32x4*)(xin + (32 * kg + k4 * 4) * 32);
                const float w0 = wl[(k4 * 4) * 64], w1 = wl[(k4 * 4 + 1) * 64], w2 = wl[(k4 * 4 + 2) * 64], w3 = wl[(k4 * 4 + 3) * 64];
#pragma unroll
                for (int q = 0; q < 8; ++q) {
                    const f32x4 x0 = xv[q], x1 = xv[8 + q], x2 = xv[16 + q], x3 = xv[24 + q];
                    acc[4 * q] += x0[0] * w0 + x1[0] * w1 + x2[0] * w2 + x3[0] * w3; acc[4 * q + 1] += x0[1] * w0 + x1[1] * w1 + x2[1] * w2 + x3[1] * w3;
                    acc[4 * q + 2] += x0[2] * w0 + x1[2] * w1 + x2[2] * w2 + x3[2] * w3; acc[4 * q + 3] += x0[3] * w0 + x1[3] * w1 + x2[3] * w2 + x3[3] * w3;
                }
            }
            if (sl + 1 < ns) {
                LAS float* xnx = red + SRED_IN + ((sl + 1) & 1) * 8192;
#pragma unroll
                for (int i = 0; i < 16; ++i) xnx[t1 + 512 * i] = xs[i];
            }
            __syncthreads();
        }
#pragma unroll
        for (int b = 0; b < 32; ++b) red[SRED_GEMV + (kg * 32 + b) * 64 + lane] = acc[b];
        __syncthreads();
#pragma unroll
        for (int i = 0; i < 4; ++i) {
            const int idx = tid + 512 * i, col = idx & 63, b = idx >> 6;
            float sum = 0.f;
#pragma unroll
            for (int g = 0; g < 8; ++g) sum += red[SRED_GEMV + (g * 32 + b) * 64 + col];
            epi(c * 64 + col, b, sum);
        }
        __syncthreads();
    }
}
template <class InF>
__device__ __forceinline__ void side_gemv_ks(const float* W, int ldw, int K, int N, const InF& in, float* h_t, LAS float* red) {
    const int tid = opaque_tid(), lane = tid & 63;
    const int kg = __builtin_amdgcn_readfirstlane(tid >> 6);
    const int ns = K >> 8, items = (N >> 6) * ns;
    for (int item = blockIdx.x; item < items; item += gridDim.x) {
        const int c = item / ns, ks = (item - c * ns) << 8;
        float xs[16];
        int t0 = tid; asm volatile("" : "+v"(t0));
#pragma unroll
        for (int i = 0; i < 16; ++i) { const int idx = t0 + 512 * i, k = ks + (idx >> 5); xs[i] = in.v(k, idx & 31, c) * in.ws(k); }
        float w[32];
        {
            const float* wp = W + (size_t)(ks + 32 * kg) * ldw + c * 64 + lane;
#pragma unroll
            for (int i = 0; i < 32; ++i) w[i] = wp[(size_t)i * ldw];
        }
        __syncthreads();
#pragma unroll
        for (int i = 0; i < 16; ++i) red[SRED_IN + t0 + 512 * i] = xs[i];
        LAS float* wl = red + SRED_GEMV + (kg * 32) * 64 + lane;
#pragma unroll
        for (int i = 0; i < 32; ++i) wl[i * 64] = w[i];
        __syncthreads();
        float acc[32];
#pragma unroll
        for (int b = 0; b < 32; ++b) acc[b] = 0.f;
        LAS float* xin = red + SRED_IN;
#pragma unroll 1
        for (int k4 = 0; k4 < 8; ++k4) {
            const LAS f32x4* xv = (const LAS f32x4*)(xin + (32 * kg + k4 * 4) * 32);
            const float w0 = wl[(k4 * 4) * 64], w1 = wl[(k4 * 4 + 1) * 64], w2 = wl[(k4 * 4 + 2) * 64], w3 = wl[(k4 * 4 + 3) * 64];
#pragma unroll
            for (int q = 0; q < 8; ++q) {
                const f32x4 x0 = xv[q], x1 = xv[8 + q], x2 = xv[16 + q], x3 = xv[24 + q];
                acc[4 * q] += x0[0] * w0 + x1[0] * w1 + x2[0] * w2 + x3[0] * w3; acc[4 * q + 1] += x0[1] * w0 + x1[1] * w1 + x2[1] * w2 + x3[1] * w3;
                acc[4 * q + 2] += x0[2] * w0 + x1[2] * w1 + x2[2] * w2 + x3[2] * w3; acc[4 * q + 3] += x0[3] * w0 + x1[3] * w1 + x2[3] * w2 + x3[3] * w3;
            }
        }
        __syncthreads();
#pragma unroll
        for (int b = 0; b < 32; ++b) red[SRED_GEMV + (kg * 32 + b) * 64 + lane] = acc[b];
        __syncthreads();
#pragma unroll
        for (int i = 0; i < 4; ++i) {
            const int idx = tid + 512 * i, col = idx & 63, b = idx >> 6;
            float sum = 0.f;
#pragma unroll
            for (int g = 0; g < 8; ++g) sum += red[SRED_GEMV + (g * 32 + b) * 64 + col];
            atomicAdd(h_t + (c * 64 + col) * 32 + b, sum);
        }
        __syncthreads();
    }
}
struct InPlain { const float* v_t; const float* gain; __device__ __forceinline__ float ws(int k) const { return gain ? gain[k] : 1.0f; } __device__ __forceinline__ float v(int k, int b, int) const { return v_t[k * 32 + b]; } };
struct InSgu { const float* z_t; const float* sgu_w; const float* sgu_b; const float* sgu_norm; const LAS float* rstdv;
    __device__ __forceinline__ float ws(int) const { return 1.0f; }
    __device__ __forceinline__ float v(int k, int b, int) const { const int g = k >> 7; return z_t[k * 32 + b] * (sgu_w[(size_t)g * 16384] * z_t[(512 + k) * 32 + b] * rstdv[b] * sgu_norm[k] + sgu_b[g * 128]); } };
struct InHead { const float* t_t; __device__ __forceinline__ float ws(int) const { return 1.0f; } __device__ __forceinline__ float v(int k, int b, int c) const { return t_t[((size_t)(c >> 2) * 1024 + k) * 32 + b]; } };
struct InSwiglu { const float* z_t; __device__ __forceinline__ float ws(int) const { return 1.0f; } __device__ __forceinline__ float v(int k, int b, int) const { return silu_f(z_t[k * 32 + b]) * z_t[(DFF + k) * 32 + b]; } };
struct EpStore { float* o_t; const LAS float* rstd; float scale; int act;
    __device__ __forceinline__ void operator()(int n, int b, float s) const { float v = s * scale * (rstd ? rstd[b] : 1.0f); if (act == 1) v = gelu_tanh_f(v); o_t[n * 32 + b] = v; } };
struct EpAdd { float* h_t; __device__ __forceinline__ void operator()(int n, int b, float s) const { h_t[n * 32 + b] += s; } };


__device__ __forceinline__ void xattn_phase(LAS unsigned char* lds, bf16_t* Yq, const bf16_t* Kmat, const bf16_t* VT) {
    const int tid = opaque_tid(), lane = tid & 63, r = lane & 15, qp = lane >> 4;
    const int wave = __builtin_amdgcn_readfirstlane(tid >> 6);
    constexpr int KS = 528;
    for (int trip = 0;; ++trip) {
        const int unit = xcd_unit(trip, 1024);
        if (unit < 0) break;
        const int b = unit >> 5, h = (unit >> 3) & 3, qb = unit & 7;
        __syncthreads();
        int tk = tid; asm volatile("" : "+v"(tk));
#pragma unroll
        for (int half = 0; half < 2; ++half) {
            u32x4_t tv[8];
#pragma unroll
            for (int i = 0; i < 8; ++i) { const int c = tk + 512 * (half * 8 + i), row = c >> 5, ch = c & 31; tv[i] = *(const u32x4_t*)(Kmat + (size_t)(b * 256 + row) * 1024 + h * 256 + ch * 8); }
#pragma unroll
            for (int i = 0; i < 8; ++i) { const int c = tk + 512 * (half * 8 + i), row = c >> 5, ch = c & 31; *(LAS u32x4_t*)(lds + row * KS + ch * 16) = tv[i]; }
        }
        __syncthreads();
        const int q0 = b * 2048 + qb * 256 + wave * 32;
        bf16x8_t pf[2][8];
        float inv[2];
        {
            f32x4 sacc[2][16];
#pragma unroll
            for (int kt = 0; kt < 16; ++kt) { sacc[0][kt] = (f32x4){0.f, 0.f, 0.f, 0.f}; sacc[1][kt] = (f32x4){0.f, 0.f, 0.f, 0.f}; }
            const bf16_t* qrow = Yq + (size_t)(q0 + r) * 1024 + h * 256 + qp * 8;
            const LAS unsigned char* kb = lds + r * KS + qp * 16; const LAS unsigned char* kb2 = kb + 8 * 16 * KS; asm volatile("" : "+v"(kb2));
            bf16x8_t qa = *(const bf16x8_t*)qrow, qb = *(const bf16x8_t*)(qrow + 16 * 1024);
#pragma unroll
            for (int ks = 0; ks < 8; ++ks) {
                const bf16x8_t qf0 = qa, qf1 = qb;
                if (ks < 7) { qa = *(const bf16x8_t*)(qrow + (ks + 1) * 32); qb = *(const bf16x8_t*)(qrow + 16 * 1024 + (ks + 1) * 32); }
#pragma unroll
                for (int kt = 0; kt < 16; ++kt) {
                    const bf16x8_t a = *(const LAS bf16x8_t*)((kt < 8 ? kb : kb2) + (kt & 7) * 16 * KS + ks * 64);
                    sacc[0][kt] = __builtin_amdgcn_mfma_f32_16x16x32_bf16(a, qf0, sacc[0][kt], 0, 0, 0);
                    sacc[1][kt] = __builtin_amdgcn_mfma_f32_16x16x32_bf16(a, qf1, sacc[1][kt], 0, 0, 0);
                }
            }
#pragma unroll
            for (int qt = 0; qt < 2; ++qt) {
                float mx = -INFINITY;
#pragma unroll
                for (int kt = 0; kt < 16; ++kt) mx = fmaxf(mx, fmaxf(fmaxf(sacc[qt][kt][0], sacc[qt][kt][1]), fmaxf(sacc[qt][kt][2], sacc[qt][kt][3])));
                mx = fmaxf(mx, __shfl_xor(mx, 16)); mx = fmaxf(mx, __shfl_xor(mx, 32));
                float sum = 0.f;
#pragma unroll
                for (int kt = 0; kt < 16; ++kt) {
#pragma unroll
                    for (int j = 0; j < 4; ++j) { const float e = __builtin_amdgcn_exp2f((sacc[qt][kt][j] - mx) * 1.4426950408889634f); sacc[qt][kt][j] = e; sum += e; }
                }
                sum += __shfl_xor(sum, 16); sum += __shfl_xor(sum, 32);
                inv[qt] = 1.0f / sum;
#pragma unroll
                for (int u = 0; u < 8; ++u) {
                    u32x4_t w;
                    w[0] = cvt_pk_bf16(sacc[qt][2 * u][0], sacc[qt][2 * u][1]); w[1] = cvt_pk_bf16(sacc[qt][2 * u][2], sacc[qt][2 * u][3]);
                    w[2] = cvt_pk_bf16(sacc[qt][2 * u + 1][0], sacc[qt][2 * u + 1][1]); w[3] = cvt_pk_bf16(sacc[qt][2 * u + 1][2], sacc[qt][2 * u + 1][3]);
                    pf[qt][u] = __builtin_bit_cast(bf16x8_t, w);
                }
            }
        }
        __syncthreads();
        int tv2 = tid; asm volatile("" : "+v"(tv2));
#pragma unroll 1
        for (int qd = 0; qd < 4; ++qd) {
            u32x4_t tv[4];
#pragma unroll
            for (int i = 0; i < 4; ++i) { const int c = tv2 + 512 * (qd * 4 + i), row = c >> 5, ch = c & 31; tv[i] = *(const u32x4_t*)(VT + (size_t)(h * 256 + row) * MROWS + b * 256 + ch * 8); }
#pragma unroll
            for (int i = 0; i < 4; ++i) { const int c = tv2 + 512 * (qd * 4 + i), row = c >> 5, ch = c & 31; *(LAS u32x4_t*)(lds + (((row & 15) << 4) | (row >> 4)) * KS + ch * 16) = tv[i]; }
        }
        __syncthreads();
        {
            f32x4 oacc[2][16];
#pragma unroll
            for (int nt = 0; nt < 16; ++nt) { oacc[0][nt] = (f32x4){0.f, 0.f, 0.f, 0.f}; oacc[1][nt] = (f32x4){0.f, 0.f, 0.f, 0.f}; }
            const LAS unsigned char* vb = lds + r * KS + qp * 8; const LAS unsigned char* vb2 = vb + 8 * 16 * KS; asm volatile("" : "+v"(vb2));
#pragma unroll
            for (int u = 0; u < 8; ++u)
#pragma unroll
                for (int nt = 0; nt < 16; ++nt) {
                    const LAS unsigned char* bp = (nt < 8 ? vb : vb2) + (nt & 7) * 16 * KS + u * 64;
                    const u32x2_t lo = *(const LAS u32x2_t*)bp, hi = *(const LAS u32x2_t*)(bp + 32);
                    u32x4_t w; w[0] = lo[0]; w[1] = lo[1]; w[2] = hi[0]; w[3] = hi[1];
                    const bf16x8_t bv = __builtin_bit_cast(bf16x8_t, w);
                    oacc[0][nt] = __builtin_amdgcn_mfma_f32_16x16x32_bf16(pf[0][u], bv, oacc[0][nt], 0, 0, 0);
                    oacc[1][nt] = __builtin_amdgcn_mfma_f32_16x16x32_bf16(pf[1][u], bv, oacc[1][nt], 0, 0, 0);
                }
            int r2 = r, qp2 = qp; asm volatile("" : "+v"(r2), "+v"(qp2));
#pragma unroll
            for (int qt = 0; qt < 2; ++qt)
#pragma unroll
                for (int j = 0; j < 4; ++j) {
                    const float is = __shfl(inv[qt], qp2 * 4 + j);
                    bf16_t* op = Yq + (size_t)(q0 + qt * 16 + qp2 * 4 + j) * 1024 + h * 256 + r2 * 16;
                    u32x4_t w0, w1;
#pragma unroll
                    for (int e = 0; e < 4; ++e) { w0[e] = cvt_pk_bf16(oacc[qt][2 * e][j] * is, oacc[qt][2 * e + 1][j] * is); w1[e] = cvt_pk_bf16(oacc[qt][8 + 2 * e][j] * is, oacc[qt][9 + 2 * e][j] * is); }
                    *(u32x4_t*)op = w0; *(u32x4_t*)(op + 8) = w1;
                }
        }
    }
    __syncthreads();
}

constexpr int RP = 272;
constexpr int RTILE = 128 * RP;
__device__ __forceinline__ float ret_lg2(int h) { return log2f(1.0f - exp2f(-5.0f - (float)h)); }
template <int TR>
__device__ __forceinline__ void ret_stage_rot(LAS unsigned char* dst, const bf16_t* Z1, int tok0, int col0, const float* TAB, float lg2, float sgn, int tid) {
    for (int it = tid; it < 1024; it += 512) {
        const int row = TR ? (it & 127) : (it >> 3), c8 = TR ? ((it >> 7) * 8) : ((it & 7) * 8);
        const bf16_t* zp = Z1 + (size_t)(tok0 + row) * ODD_IN + col0 + c8;
        const u32x4_t a = *(const u32x4_t*)zp, bq = *(const u32x4_t*)(zp + 64);
        const int pos = (tok0 + row) & 2047;
        const float4 c0 = *(const float4*)(TAB + TAB_RC + pos * 64 + c8), c1 = *(const float4*)(TAB + TAB_RC + pos * 64 + c8 + 4);
        const float4 s0 = *(const float4*)(TAB + TAB_RS + pos * 64 + c8), s1 = *(const float4*)(TAB + TAB_RS + pos * 64 + c8 + 4);
        const float sc = exp2f(sgn * (float)(row + 1) * lg2);
        const float x1[8] = {bflo(a[0]), bfhi(a[0]), bflo(a[1]), bfhi(a[1]), bflo(a[2]), bfhi(a[2]), bflo(a[3]), bfhi(a[3])};
        const float x2[8] = {bflo(bq[0]), bfhi(bq[0]), bflo(bq[1]), bfhi(bq[1]), bflo(bq[2]), bfhi(bq[2]), bflo(bq[3]), bfhi(bq[3])};
        const float cs[8] = {c0.x, c0.y, c0.z, c0.w, c1.x, c1.y, c1.z, c1.w};
        const float sn[8] = {s0.x, s0.y, s0.z, s0.w, s1.x, s1.y, s1.z, s1.w};
        float o1[8], o2[8];
#pragma unroll
        for (int e = 0; e < 8; ++e) { o1[e] = (x1[e] * cs[e] - x2[e] * sn[e]) * sc; o2[e] = (x1[e] * sn[e] + x2[e] * cs[e]) * sc; }
        if (TR == 0) {
            u32x4_t w1, w2;
#pragma unroll
            for (int e = 0; e < 4; ++e) { w1[e] = cvt_pk_bf16(o1[2 * e], o1[2 * e + 1]); w2[e] = cvt_pk_bf16(o2[2 * e], o2[2 * e + 1]); }
            *(LAS u32x4_t*)(dst + row * RP + c8 * 2) = w1; *(LAS u32x4_t*)(dst + row * RP + (64 + c8) * 2) = w2;
        } else {
#pragma unroll
            for (int e = 0; e < 8; ++e) {
                const int d1 = c8 + e, d2 = 64 + c8 + e;
                *(LAS unsigned short*)(dst + ((d1 & 7) * 16 + (d1 >> 3)) * RP + row * 2) = f2bf(o1[e]); *(LAS unsigned short*)(dst + ((d2 & 7) * 16 + (d2 >> 3)) * RP + row * 2) = f2bf(o2[e]);
            }
        }
    }
}
template <int PERM8>
__device__ __forceinline__ void stage_tr128(LAS unsigned char* dst, const bf16_t* src, int ld, int tok0, int col0, int tid) {
    for (int it = tid; it < 2048; it += 512) {
        const int row = it & 127, c8 = (it >> 7) * 8;
        const u32x4_t a = *(const u32x4_t*)(src + (size_t)(tok0 + row) * ld + col0 + c8);
#pragma unroll
        for (int e = 0; e < 4; ++e) {
            const int e0 = c8 + 2 * e, e1 = e0 + 1;
            *(LAS unsigned short*)(dst + (PERM8 ? ((e0 & 7) * 16 + (e0 >> 3)) : e0) * RP + row * 2) = (unsigned short)(a[e] & 0xffffu);
            *(LAS unsigned short*)(dst + (PERM8 ? ((e1 & 7) * 16 + (e1 >> 3)) : e1) * RP + row * 2) = (unsigned short)(a[e] >> 16);
        }
    }
}
__device__ __forceinline__ void ret_r1(LAS unsigned char* lds, const bf16_t* Z1, const float* TAB, bf16_t* RET) {
    const int tid = opaque_tid(), lane = tid & 63, r = lane & 15, qp = lane >> 4;
    const int wave = __builtin_amdgcn_readfirstlane(tid >> 6);
    LAS unsigned char* KT = lds; LAS unsigned char* VTL = lds + RTILE;
    for (int unit = blockIdx.x; unit < 2048; unit += gridDim.x) {
        const int b = unit >> 6, h = (unit >> 4) & 3, n = unit & 15, tok0 = b * 2048 + n * 128;
        const float lg2 = ret_lg2(h);
        __syncthreads();
        ret_stage_rot<1>(KT, Z1, tok0, 2048 + h * 128, TAB, lg2, -1.0f, tid);
        stage_tr128<0>(VTL, Z1, ODD_IN, tok0, 2560 + h * 128, tid);
        __syncthreads();
        f32x4 acc[8];
#pragma unroll
        for (int nt = 0; nt < 8; ++nt) acc[nt] = (f32x4){0.f, 0.f, 0.f, 0.f};
#pragma unroll
        for (int ks = 0; ks < 4; ++ks) {
            const bf16x8_t a = *(const LAS bf16x8_t*)(VTL + (16 * wave + r) * RP + (32 * ks + 8 * qp) * 2);
#pragma unroll
            for (int nt = 0; nt < 8; ++nt) {
                const bf16x8_t bv = *(const LAS bf16x8_t*)(KT + (16 * nt + r) * RP + (32 * ks + 8 * qp) * 2);
                acc[nt] = __builtin_amdgcn_mfma_f32_16x16x32_bf16(a, bv, acc[nt], 0, 0, 0);
            }
        }
        const float g128 = exp2f(128.0f * lg2);
        bf16_t* op = RET + (size_t)unit * 16384;
#pragma unroll
        for (int j = 0; j < 4; ++j) {
            u32x4_t w;
#pragma unroll
            for (int e = 0; e < 4; ++e) w[e] = cvt_pk_bf16(acc[2 * e][j] * g128, acc[2 * e + 1][j] * g128);
            *(u32x4_t*)(op + (16 * wave + 4 * qp + j) * 128 + 8 * r) = w;
        }
    }
    __syncthreads();
}
__device__ __forceinline__ void ret_r2(bf16_t* RET) {
    const int tid = opaque_tid();
    for (int idx = blockIdx.x * 512 + tid; idx < 128 * 8192; idx += gridDim.x * 512) {
        const int bh = idx >> 13, pr = idx & 8191;
        const float g128 = exp2f(128.0f * ret_lg2(bh & 3));
        unsigned* p = (unsigned*)(RET + (size_t)bh * 16 * 16384) + pr;
        unsigned v[16];
#pragma unroll
        for (int n = 0; n < 16; ++n) v[n] = p[(size_t)n * 8192];
        float s0 = 0.f, s1 = 0.f;
#pragma unroll
        for (int n = 0; n < 16; ++n) {
            p[(size_t)n * 8192] = cvt_pk_bf16(s0, s1);
            s0 = s0 * g128 + bflo(v[n]); s1 = s1 * g128 + bfhi(v[n]);
        }
    }
}
__device__ __forceinline__ void ret_r3(LAS unsigned char* lds, const bf16_t* Z1, const float* TAB, const bf16_t* RET, const float* SDZ, bf16_t* Yo) {
    const int tid = opaque_tid(), lane = tid & 63, r = lane & 15, qp = lane >> 4;
    const int wave = __builtin_amdgcn_readfirstlane(tid >> 6);
    LAS unsigned char* QL = lds; LAS unsigned char* KL = lds + RTILE; LAS unsigned char* VTL = lds + 2 * RTILE; LAS unsigned char* PL = lds + 3 * RTILE;
    for (int unit = blockIdx.x; unit < 2048; unit += gridDim.x) {
        const int b = unit >> 6, h = (unit >> 4) & 3, n = unit & 15, tok0 = b * 2048 + n * 128;
        const float lg2 = ret_lg2(h);
        __syncthreads();
        ret_stage_rot<0>(QL, Z1, tok0, 1536 + h * 128, TAB, lg2, 1.0f, tid);
        ret_stage_rot<0>(KL, Z1, tok0, 2048 + h * 128, TAB, lg2, -1.0f, tid);
        stage_tr128<1>(VTL, Z1, ODD_IN, tok0, 2560 + h * 128, tid);
        for (int it = tid; it < 2048; it += 512) { const int row = it >> 4, c8 = (it & 15) * 8; *(LAS u32x4_t*)(PL + ((row & 7) * 16 + (row >> 3)) * RP + c8 * 2) = *(const u32x4_t*)(RET + (size_t)unit * 16384 + row * 128 + c8); }
        __syncthreads();
        bf16x8_t qf[4];
#pragma unroll
        for (int ks = 0; ks < 4; ++ks) qf[ks] = *(const LAS bf16x8_t*)(QL + (16 * wave + r) * RP + (32 * ks + 8 * qp) * 2);
        f32x4 sacc[8];
#pragma unroll
        for (int jt = 0; jt < 8; ++jt) {
            sacc[jt] = (f32x4){0.f, 0.f, 0.f, 0.f};
            if (jt <= wave) {
#pragma unroll
                for (int ks = 0; ks < 4; ++ks) {
                    const bf16x8_t a = *(const LAS bf16x8_t*)(KL + (16 * jt + r) * RP + (32 * ks + 8 * qp) * 2);
                    sacc[jt] = __builtin_amdgcn_mfma_f32_16x16x32_bf16(a, qf[ks], sacc[jt], 0, 0, 0);
                }
#pragma unroll
                for (int j = 0; j < 4; ++j) if (16 * jt + 4 * qp + j > 16 * wave + r) sacc[jt][j] = 0.f;
            }
        }
        if (n == 0 && wave == 0) {
            const float* zq = SDZ + (size_t)(h * 128) * 32 + b;
            const float c = wave_sum(zq[lane * 32] * zq[(512 + lane) * 32] + zq[(lane + 64) * 32] * zq[(512 + lane + 64) * 32]) * 0.08838834764831845f;
            if (lane == 0) sacc[0][0] = c;
        }
        bf16x8_t pf[4];
#pragma unroll
        for (int u = 0; u < 4; ++u) {
            u32x4_t w;
            w[0] = cvt_pk_bf16(sacc[2 * u][0], sacc[2 * u][1]); w[1] = cvt_pk_bf16(sacc[2 * u][2], sacc[2 * u][3]);
            w[2] = cvt_pk_bf16(sacc[2 * u + 1][0], sacc[2 * u + 1][1]); w[3] = cvt_pk_bf16(sacc[2 * u + 1][2], sacc[2 * u + 1][3]);
            pf[u] = __builtin_bit_cast(bf16x8_t, w);
        }
        f32x4 oacc[8];
#pragma unroll
        for (int nt = 0; nt < 8; ++nt) oacc[nt] = (f32x4){0.f, 0.f, 0.f, 0.f};
#pragma unroll
        for (int u = 0; u < 4; ++u) {
            if (2 * u <= wave) {
#pragma unroll
                for (int nt = 0; nt < 8; ++nt) {
                    const LAS unsigned char* bp = VTL + (16 * nt + r) * RP + (32 * u + 4 * qp) * 2;
                    const u32x2_t lo = *(const LAS u32x2_t*)bp, hi = *(const LAS u32x2_t*)(bp + 32);
                    u32x4_t w; w[0] = lo[0]; w[1] = lo[1]; w[2] = hi[0]; w[3] = hi[1];
                    oacc[nt] = __builtin_amdgcn_mfma_f32_16x16x32_bf16(pf[u], __builtin_bit_cast(bf16x8_t, w), oacc[nt], 0, 0, 0);
                }
            }
        }
#pragma unroll
        for (int ks = 0; ks < 4; ++ks)
#pragma unroll
            for (int nt = 0; nt < 8; ++nt) {
                const bf16x8_t bv = *(const LAS bf16x8_t*)(PL + (16 * nt + r) * RP + (32 * ks + 8 * qp) * 2);
                oacc[nt] = __builtin_amdgcn_mfma_f32_16x16x32_bf16(qf[ks], bv, oacc[nt], 0, 0, 0);
            }
#pragma unroll
        for (int j = 0; j < 4; ++j) {
            float sm = 0.f;
#pragma unroll
            for (int nt = 0; nt < 8; ++nt) sm += oacc[nt][j];
            sm += __shfl_xor(sm, 1); sm += __shfl_xor(sm, 2); sm += __shfl_xor(sm, 4); sm += __shfl_xor(sm, 8);
            const float mu = sm * (1.0f / 128.0f);
            float vr = 0.f;
#pragma unroll
            for (int nt = 0; nt < 8; ++nt) { const float d = oacc[nt][j] - mu; vr += d * d; }
            vr += __shfl_xor(vr, 1); vr += __shfl_xor(vr, 2); vr += __shfl_xor(vr, 4); vr += __shfl_xor(vr, 8);
            const float rs = rsqrtf(vr * (1.0f / 128.0f) + 1e-6f);
            const size_t tok = (size_t)(tok0 + 16 * wave + 4 * qp + j);
            const u32x4_t gg = *(const u32x4_t*)(Z1 + tok * ODD_IN + 3072 + h * 128 + 8 * r);
            u32x4_t w;
#pragma unroll
            for (int e = 0; e < 4; ++e) w[e] = cvt_pk_bf16(bflo(gg[e]) * (oacc[2 * e][j] - mu) * rs, bfhi(gg[e]) * (oacc[2 * e + 1][j] - mu) * rs);
            *(u32x4_t*)(Yo + tok * 1024 + 512 + h * 128 + 8 * r) = w;
        }
    }
    __syncthreads();
}

constexpr int DKP = 144;
constexpr int DVP = 592;
constexpr int DK_BYTES = 256 * DKP;
#define DIL_DECODE(u) const int b = (u) / 384, v = (u) - b * 384, h = v / 48, v2 = v - h * 48, g = v2 >> 4, rb = v2 & 15; \
    const int lognb = 4 - 2 * g, dil = 1 << (2 * g), nbi = rb & ((1 << lognb) - 1), res = rb >> lognb; const int tokb = b * 2048
#define DIL_ISSUE(u) do { DIL_DECODE(u); const int row_ = (wave & 3) * 64 + lane, hh_ = wave >> 2; const int j_ = 128 * nbi - 128 + row_; validr = j_ >= 0; const int pos_ = validr ? j_ * dil + res : 0; \
    const bf16_t* zr_ = Z1 + (size_t)(tokb + pos_) * ODD_IN + h * 64 + hh_ * 32; \
    _Pragma("unroll") for (int i_ = 0; i_ < 4; ++i_) { kvr[i_] = *(const u32x4_t*)(zr_ + 512 + i_ * 8); vvr[i_] = *(const u32x4_t*)(zr_ + 1024 + i_ * 8); } \
    if (hh_ == 0) { const float* tc_ = TAB + TAB_DC + pos_ * 8; const float* ts_ = TAB + TAB_DS + pos_ * 8; kc0 = *(const float4*)tc_; kc1 = *(const float4*)(tc_ + 4); ks0 = *(const float4*)ts_; ks1 = *(const float4*)(ts_ + 4); } \
    const int qpos_ = (128 * nbi + 16 * wave + r) * dil + res; const bf16_t* qrow_ = Z1 + (size_t)(tokb + qpos_) * ODD_IN + h * 64 + qp * 8; \
    qr0 = *(const u32x4_t*)qrow_; qr1 = *(const u32x4_t*)(qrow_ + 32); \
    { const float* tc_ = TAB + TAB_DC + qpos_ * 8; const float* ts_ = TAB + TAB_DS + qpos_ * 8; qc0 = *(const float4*)tc_; qc1 = *(const float4*)(tc_ + 4); qs0 = *(const float4*)ts_; qs1 = *(const float4*)(ts_ + 4); } } while (0)
__device__ __forceinline__ void dil_units(LAS unsigned char* lds, const bf16_t* Z1, const float* TAB, bf16_t* OB01, bf16_t* Yo, float* LSE) {
    const int tid = opaque_tid(), lane = tid & 63, r = lane & 15, qp = lane >> 4;
    const int wave = __builtin_amdgcn_readfirstlane(tid >> 6);
    LAS unsigned char* KL = lds; LAS unsigned char* VTL = lds + DK_BYTES;
    __syncthreads();
    for (int i = tid; i < 64 * 16; i += 512) { const int d = i >> 4, c = i & 15; *(LAS unsigned*)(VTL + d * DVP + 512 + c * 4) = 0u; }
    u32x4_t kvr[4], vvr[4], qr0, qr1; float4 kc0, kc1, ks0, ks1, qc0, qc1, qs0, qs1; bool validr;
    kc0 = kc1 = ks0 = ks1 = make_float4(0.f, 0.f, 0.f, 0.f);
    int trip = 0, unit = xcd_unit(0, 12288);
    if (unit >= 0) DIL_ISSUE(unit);
    while (unit >= 0) {
        DIL_DECODE(unit);
        __syncthreads();
        {
            const int row = (wave & 3) * 64 + lane, hh = wave >> 2;
            u32x4_t kv[4], vv[4];
#pragma unroll
            for (int i = 0; i < 4; ++i) { kv[i] = validr ? kvr[i] : (u32x4_t){0u, 0u, 0u, 0u}; vv[i] = validr ? vvr[i] : (u32x4_t){0u, 0u, 0u, 0u}; }
#pragma unroll
            for (int i = 0; i < 4; ++i)
#pragma unroll
                for (int e = 0; e < 4; ++e) {
                    *(LAS unsigned short*)(VTL + ((hh * 4 + i) * 8 + 2 * e) * DVP + row * 2) = (unsigned short)(vv[i][e] & 0xffffu);
                    *(LAS unsigned short*)(VTL + ((hh * 4 + i) * 8 + 2 * e + 1) * DVP + row * 2) = (unsigned short)(vv[i][e] >> 16);
                }
            if (hh == 0) {
                const float cs[8] = {kc0.x, kc0.y, kc0.z, kc0.w, kc1.x, kc1.y, kc1.z, kc1.w}, sn[8] = {ks0.x, ks0.y, ks0.z, ks0.w, ks1.x, ks1.y, ks1.z, ks1.w};
                const u32x4_t k1 = kv[0], k2 = kv[1];
                const float x1[8] = {bflo(k1[0]), bfhi(k1[0]), bflo(k1[1]), bfhi(k1[1]), bflo(k1[2]), bfhi(k1[2]), bflo(k1[3]), bfhi(k1[3])};
                const float x2[8] = {bflo(k2[0]), bfhi(k2[0]), bflo(k2[1]), bfhi(k2[1]), bflo(k2[2]), bfhi(k2[2]), bflo(k2[3]), bfhi(k2[3])};
#pragma unroll
                for (int e = 0; e < 4; ++e) {
                    kv[0][e] = cvt_pk_bf16(x1[2 * e] * cs[2 * e] - x2[2 * e] * sn[2 * e], x1[2 * e + 1] * cs[2 * e + 1] - x2[2 * e + 1] * sn[2 * e + 1]);
                    kv[1][e] = cvt_pk_bf16(x1[2 * e] * sn[2 * e] + x2[2 * e] * cs[2 * e], x1[2 * e + 1] * sn[2 * e + 1] + x2[2 * e + 1] * cs[2 * e + 1]);
                }
            }
#pragma unroll
            for (int i = 0; i < 4; ++i) *(LAS u32x4_t*)(KL + row * DKP + (hh * 4 + i) * 16) = kv[i];
        }
        const int qi = 128 * nbi + 16 * wave + r, qpos = qi * dil + res;
        u32x4_t q0 = qr0; const u32x4_t q1 = qr1;
        {
            u32x4_t pr;
#pragma unroll
            for (int e = 0; e < 4; ++e) pr[e] = (unsigned)__shfl_xor((int)q0[e], 16);
            const float cs[8] = {qc0.x, qc0.y, qc0.z, qc0.w, qc1.x, qc1.y, qc1.z, qc1.w}, sn[8] = {qs0.x, qs0.y, qs0.z, qs0.w, qs1.x, qs1.y, qs1.z, qs1.w};
            const float own[8] = {bflo(q0[0]), bfhi(q0[0]), bflo(q0[1]), bfhi(q0[1]), bflo(q0[2]), bfhi(q0[2]), bflo(q0[3]), bfhi(q0[3])};
            const float oth[8] = {bflo(pr[0]), bfhi(pr[0]), bflo(pr[1]), bfhi(pr[1]), bflo(pr[2]), bfhi(pr[2]), bflo(pr[3]), bfhi(pr[3])};
            float o[8];
#pragma unroll
            for (int e = 0; e < 8; ++e) o[e] = (qp == 0) ? (own[e] * cs[e] - oth[e] * sn[e]) : (oth[e] * sn[e] + own[e] * cs[e]);
            if (qp < 2) {
#pragma unroll
                for (int e = 0; e < 4; ++e) q0[e] = cvt_pk_bf16(o[2 * e], o[2 * e + 1]);
            }
        }
        const bf16x8_t qf0 = __builtin_bit_cast(bf16x8_t, q0), qf1 = __builtin_bit_cast(bf16x8_t, q1);
        const int nxt = xcd_unit(++trip, 12288);
        if (nxt >= 0) DIL_ISSUE(nxt);
        __syncthreads();
        f32x4 sacc[9];
        const LAS unsigned char* kb = KL + (16 * wave + r) * DKP + qp * 16;
#pragma unroll
        for (int st = 0; st < 9; ++st) {
            const bf16x8_t a0 = *(const LAS bf16x8_t*)(kb + st * 16 * DKP), a1 = *(const LAS bf16x8_t*)(kb + st * 16 * DKP + 64);
            f32x4 acc = (f32x4){0.f, 0.f, 0.f, 0.f};
            acc = __builtin_amdgcn_mfma_f32_16x16x32_bf16(a0, qf0, acc, 0, 0, 0);
            acc = __builtin_amdgcn_mfma_f32_16x16x32_bf16(a1, qf1, acc, 0, 0, 0);
#pragma unroll
            for (int j = 0; j < 4; ++j) {
                const int dk = 16 * st + 4 * qp + j;
                const bool ok = (dk >= r) && (dk <= r + 128) && (nbi > 0 || 16 * wave + dk >= 128);
                acc[j] = ok ? acc[j] : -INFINITY;
            }
            sacc[st] = acc;
        }
        float mx = -INFINITY;
#pragma unroll
        for (int st = 0; st < 9; ++st) mx = fmaxf(mx, fmaxf(fmaxf(sacc[st][0], sacc[st][1]), fmaxf(sacc[st][2], sacc[st][3])));
        mx = fmaxf(mx, __shfl_xor(mx, 16)); mx = fmaxf(mx, __shfl_xor(mx, 32));
        float sum = 0.f;
#pragma unroll
        for (int st = 0; st < 9; ++st) {
#pragma unroll
            for (int j = 0; j < 4; ++j) { const float e = (sacc[st][j] == -INFINITY) ? 0.f : __expf(sacc[st][j] - mx); sacc[st][j] = e; sum += e; }
        }
        sum += __shfl_xor(sum, 16); sum += __shfl_xor(sum, 32);
        const float inv = 1.0f / sum;
        if (qp == 0) LSE[((size_t)g * T + tokb + qpos) * 8 + h] = mx + __logf(sum);
        f32x4 oacc[4];
#pragma unroll
        for (int nt = 0; nt < 4; ++nt) oacc[nt] = (f32x4){0.f, 0.f, 0.f, 0.f};
        const LAS unsigned char* vb = VTL + r * DVP + (16 * wave + 4 * qp) * 2;
#pragma unroll
        for (int u = 0; u < 5; ++u) {
            u32x4_t w;
            w[0] = cvt_pk_bf16(sacc[2 * u][0], sacc[2 * u][1]); w[1] = cvt_pk_bf16(sacc[2 * u][2], sacc[2 * u][3]);
            if (u < 4) { w[2] = cvt_pk_bf16(sacc[2 * u + 1][0], sacc[2 * u + 1][1]); w[3] = cvt_pk_bf16(sacc[2 * u + 1][2], sacc[2 * u + 1][3]); } else { w[2] = 0u; w[3] = 0u; }
            const bf16x8_t pfr = __builtin_bit_cast(bf16x8_t, w);
#pragma unroll
            for (int nt = 0; nt < 4; ++nt) {
                const LAS unsigned char* bp = vb + nt * 16 * DVP + u * 64;
                const u32x2_t lo = *(const LAS u32x2_t*)bp, hi = *(const LAS u32x2_t*)(bp + 32);
                u32x4_t bw; bw[0] = lo[0]; bw[1] = lo[1]; bw[2] = hi[0]; bw[3] = hi[1];
                oacc[nt] = __builtin_amdgcn_mfma_f32_16x16x32_bf16(pfr, __builtin_bit_cast(bf16x8_t, bw), oacc[nt], 0, 0, 0);
            }
        }
        bf16_t* ob = (g == 2) ? Yo : (OB01 + (size_t)g * T * 512);
        const int opitch = (g == 2) ? 1024 : 512;
#pragma unroll
        for (int j = 0; j < 4; ++j) {
            const float is = __shfl(inv, qp * 4 + j);
            const int tq = tokb + (128 * nbi + 16 * wave + 4 * qp + j) * dil + res;
            bf16_t* op = ob + (size_t)tq * opitch + h * 64 + r;
#pragma unroll
            for (int nt = 0; nt < 4; ++nt) op[16 * nt] = f2bf(oacc[nt][j] * is);
        }
        unit = nxt;
    }
    __syncthreads();
}
#undef DIL_ISSUE
#undef DIL_DECODE
__device__ __forceinline__ void dil_combine(const bf16_t* OB01, bf16_t* Yo, const float* LSE) {
    const int tid = opaque_tid();
    for (int idx = blockIdx.x * 512 + tid; idx < T * 64; idx += gridDim.x * 512) {
        const int t = idx >> 6, c8 = (idx & 63) * 8, h = c8 >> 6;
        const float l0 = LSE[((size_t)0 * T + t) * 8 + h], l1 = LSE[((size_t)1 * T + t) * 8 + h], l2 = LSE[((size_t)2 * T + t) * 8 + h];
        const float m = fmaxf(l0, fmaxf(l1, l2));
        float w0 = __expf(l0 - m), w1 = __expf(l1 - m), w2 = __expf(l2 - m);
        const float is = 1.0f / (w0 + w1 + w2); w0 *= is; w1 *= is; w2 *= is;
        const u32x4_t a = *(const u32x4_t*)(OB01 + (size_t)t * 512 + c8), bq = *(const u32x4_t*)(OB01 + (size_t)T * 512 + (size_t)t * 512 + c8), c = *(const u32x4_t*)(Yo + (size_t)t * 1024 + c8);
        u32x4_t o;
#pragma unroll
        for (int e = 0; e < 4; ++e) o[e] = cvt_pk_bf16(w0 * bflo(a[e]) + w1 * bflo(bq[e]) + w2 * bflo(c[e]), w0 * bfhi(a[e]) + w1 * bfhi(bq[e]) + w2 * bfhi(c[e]));
        *(u32x4_t*)(Yo + (size_t)t * 1024 + c8) = o;
    }
}

constexpr size_t TABB_WSB = 1280 * 1024, TABB_PWT = TABB_WSB + 4 * 128 * 128 * 2;
constexpr int EM_AL = RTILE, EM_DL = RTILE + 144 * RP;
__device__ __forceinline__ void even_mix_units(LAS unsigned char* lds, const bf16_t* Z0, const float* ssv, const bf16_t* WSB, const bf16_t* PWT, const float* sgu_norm, const float* sgu_b, bf16_t* Yo) {
    const int tid = opaque_tid(), lane = tid & 63, r = lane & 15, qp = lane >> 4;
    const int wave = __builtin_amdgcn_readfirstlane(tid >> 6);
    LAS unsigned char* VT = lds; LAS unsigned char* AL = lds + EM_AL; LAS unsigned char* DL = lds + EM_DL;
    for (int unit = blockIdx.x; unit < 2048; unit += gridDim.x) {
        const int chunk = unit >> 2, g = unit & 3, tok0 = chunk * 128, pos0 = tok0 & 2047, win = 2 << g;
        __syncthreads();
        for (int it = tid; it < 2048; it += 512) {
            const int row = it & 127, c8 = (it >> 7) * 8;
            const float rs = row_rstd(ssv, 8, tok0 + row, 1.0f / 512.0f);
            const u32x4_t a = *(const u32x4_t*)(Z0 + (size_t)(tok0 + row) * EVEN_IN + 1024 + g * 128 + c8);
#pragma unroll
            for (int e = 0; e < 4; ++e) {
                *(LAS unsigned short*)(VT + (c8 + 2 * e) * RP + row * 2) = f2bf(bflo(a[e]) * rs);
                *(LAS unsigned short*)(VT + (c8 + 2 * e + 1) * RP + row * 2) = f2bf(bfhi(a[e]) * rs);
            }
        }
        for (int it = tid; it < 143 * 16; it += 512) {
            const int rr = it >> 4, c8 = (it & 15) * 8;
            const bool valid = pos0 - 15 + rr >= 0;
            u32x4_t a = *(const u32x4_t*)(Z0 + (size_t)(valid ? tok0 - 15 + rr : tok0) * EVEN_IN + g * 128 + c8);
            if (!valid) a = (u32x4_t){0u, 0u, 0u, 0u};
            *(LAS u32x4_t*)(AL + rr * RP + c8 * 2) = a;
        }
        __syncthreads();
        for (int it = tid; it < 2048; it += 512) {
            const int t = it >> 4, c8 = (it & 15) * 8;
            float sum[8];
#pragma unroll
            for (int e = 0; e < 8; ++e) sum[e] = 0.f;
            for (int jj = 0; jj < win; ++jj) {
                const u32x4_t a = *(const LAS u32x4_t*)(AL + (t + 15 - jj) * RP + c8 * 2);
#pragma unroll
                for (int e = 0; e < 4; ++e) { sum[2 * e] += bflo(a[e]); sum[2 * e + 1] += bfhi(a[e]); }
            }
            const u32x4_t cur = *(const LAS u32x4_t*)(AL + (t + 15) * RP + c8 * 2);
            const float ic = 1.0f / (float)min(pos0 + t + 1, win);
            u32x4_t w;
#pragma unroll
            for (int e = 0; e < 4; ++e) w[e] = cvt_pk_bf16(sum[2 * e] * ic - bflo(cur[e]), sum[2 * e + 1] * ic - bfhi(cur[e]));
            *(LAS u32x4_t*)(DL + t * RP + c8 * 2) = w;
        }
        __syncthreads();
        {
            f32x4 acc[8];
#pragma unroll
            for (int nt = 0; nt < 8; ++nt) acc[nt] = (f32x4){0.f, 0.f, 0.f, 0.f};
#pragma unroll
            for (int ks = 0; ks < 4; ++ks) {
                if (32 * ks <= 16 * wave + 15) {
                    const bf16x8_t a = *(const bf16x8_t*)(WSB + (size_t)g * 16384 + (16 * wave + r) * 128 + 32 * ks + 8 * qp);
#pragma unroll
                    for (int nt = 0; nt < 8; ++nt) {
                        const bf16x8_t bv = *(const LAS bf16x8_t*)(VT + (16 * nt + r) * RP + (32 * ks + 8 * qp) * 2);
                        acc[nt] = __builtin_amdgcn_mfma_f32_16x16x32_bf16(a, bv, acc[nt], 0, 0, 0);
                    }
                }
            }
#pragma unroll
            for (int j = 0; j < 4; ++j) {
                const int t = 16 * wave + 4 * qp + j;
                const float bb = sgu_b[g * 128 + t];
                const bf16_t* up = Z0 + (size_t)(tok0 + t) * EVEN_IN + 512 + g * 128 + r;
                bf16_t* yp = Yo + (size_t)(tok0 + t) * 1024 + 512 + g * 128 + r;
#pragma unroll
                for (int nt = 0; nt < 8; ++nt) yp[16 * nt] = f2bf(bf2f(up[16 * nt]) * (acc[nt][j] * sgu_norm[g * 128 + 16 * nt + r] + bb));
            }
        }
        {
            f32x4 acc[8];
#pragma unroll
            for (int nt = 0; nt < 8; ++nt) acc[nt] = (f32x4){0.f, 0.f, 0.f, 0.f};
#pragma unroll
            for (int ks = 0; ks < 4; ++ks) {
                const bf16x8_t a = *(const LAS bf16x8_t*)(DL + (16 * wave + r) * RP + (32 * ks + 8 * qp) * 2);
#pragma unroll
                for (int nt = 0; nt < 8; ++nt) {
                    const bf16x8_t bv = *(const bf16x8_t*)(PWT + (size_t)g * 16384 + (16 * nt + r) * 128 + 32 * ks + 8 * qp);
                    acc[nt] = __builtin_amdgcn_mfma_f32_16x16x32_bf16(a, bv, acc[nt], 0, 0, 0);
                }
            }
#pragma unroll
            for (int j = 0; j < 4; ++j) {
                bf16_t* yp = Yo + (size_t)(tok0 + 16 * wave + 4 * qp + j) * 1024 + g * 128 + r;
#pragma unroll
                for (int nt = 0; nt < 8; ++nt) yp[16 * nt] = f2bf(acc[nt][j]);
            }
        }
    }
    __syncthreads();
}
#define PHASE_IDS() const int tid = opaque_tid(), lane = tid & 63, wave = tid >> 6; const int gw = blockIdx.x * 8 + wave, nw = gridDim.x * 8; const int gt = blockIdx.x * 512 + tid, nt = gridDim.x * 512; (void)lane; (void)gw; (void)nw; (void)gt; (void)nt;
#include <vector>

#define XB_TMO      128
#define XB_XCNT(j)  (256  + 64 * (j))
#define XB_XSUB(j)  (1280 + 64 * (j))
#define XB_XGEN(j)  (2304 + 64 * (j))
#define XB_TOP      3328
#define XB_TOPGEN   3392
#define XCD_BAR_WORDS 3456
#define XB_SPIN_CAP (1u << 18)

__device__ __forceinline__ unsigned xb_ld(unsigned* p)              { return __hip_atomic_load(p, __ATOMIC_RELAXED, __HIP_MEMORY_SCOPE_AGENT); }
__device__ __forceinline__ unsigned xb_add(unsigned* p, unsigned v) { return __hip_atomic_fetch_add(p, v, __ATOMIC_RELAXED, __HIP_MEMORY_SCOPE_AGENT); }
__device__ __forceinline__ unsigned xb_xcc_id() { return (unsigned)__builtin_amdgcn_s_getreg((3 << 11) | 20) & 0xFu; }
#define XB_SPIN(cond, bar) do { unsigned _sp = 0; while (cond) { __builtin_amdgcn_s_sleep(1); \
    if ((++_sp & 255u) == 0u) { if (xb_ld(&(bar)[XB_TMO])) break; if (_sp > XB_SPIN_CAP) { atomicAdd(&(bar)[XB_TMO], 1u); break; } } } } while (0)

struct XcdBarrier {
    unsigned* bar; unsigned x;
    volatile LAS unsigned* st;
};

__device__ __forceinline__ XcdBarrier xcd_barrier_post(unsigned* bar, volatile LAS unsigned* st) {
    XcdBarrier b; b.bar = bar; b.x = xb_xcc_id(); b.st = st;
    if (threadIdx.x == 0) (void)xb_add(&bar[XB_XCNT(b.x)], 1u);
    return b;
}
__device__ __forceinline__ void xcd_barrier_complete(unsigned* bar, unsigned x, unsigned& nloc, unsigned& nx) {
    const unsigned G = gridDim.x * gridDim.y * gridDim.z;
    unsigned sum, cnt, mine, sp = 0u;
    for (;;) {
        sum = 0u; cnt = 0u; mine = 0u;
#pragma unroll
        for (unsigned j = 0; j < 16; ++j) { const unsigned c = xb_ld(&bar[XB_XCNT(j)]); sum += c; cnt += (c > 0u) ? 1u : 0u; mine = (j == x) ? c : mine; }
        if (sum == G) break;
        __builtin_amdgcn_s_sleep(1);
        if ((++sp & 255u) == 0u) { if (xb_ld(&bar[XB_TMO])) break; if (sp > XB_SPIN_CAP) { atomicAdd(&bar[XB_TMO], 1u); break; } }
    }
    nloc = mine > 0u ? mine : 1u; nx = cnt > 0u ? cnt : 1u;
}

__device__ __forceinline__ void xcd_barrier(const XcdBarrier& b) {
    asm volatile("s_waitcnt vmcnt(0)" ::: "memory");
    __syncthreads();
    if (threadIdx.x == 0) {
        unsigned* bar = b.bar;
        __builtin_amdgcn_s_waitcnt(0);
        unsigned nloc = b.st[0], nx = b.st[1];
        if (nloc == 0u) { xcd_barrier_complete(bar, b.x, nloc, nx); b.st[0] = nloc; b.st[1] = nx; }
        const unsigned old = xb_add(&bar[XB_XSUB(b.x)], 1u);
        const unsigned gen = old / nloc;
        if (old + 1u == (gen + 1u) * nloc) {
            __builtin_amdgcn_fence(__ATOMIC_RELEASE, "agent");
            asm volatile("s_waitcnt vmcnt(0)" ::: "memory");
            const unsigned og = xb_add(&bar[XB_TOP], 1u);
            const unsigned tg = og / nx;
            if (og + 1u == (tg + 1u) * nx) xb_add(&bar[XB_TOPGEN], 1u);
            else XB_SPIN(xb_ld(&bar[XB_TOPGEN]) == tg, bar);
            __builtin_amdgcn_fence(__ATOMIC_ACQUIRE, "agent");
            xb_add(&bar[XB_XGEN(b.x)], 1u);
            asm volatile("s_waitcnt vmcnt(0)" ::: "memory");
        } else {
            XB_SPIN(xb_ld(&bar[XB_XGEN(b.x)]) == gen, bar);
            __builtin_amdgcn_fence(__ATOMIC_ACQUIRE, "agent");
            asm volatile("s_waitcnt vmcnt(0)" ::: "memory");
        }
    }
    __syncthreads();
}


#ifndef REP_GEMM
#define REP_GEMM 1
#endif
#ifndef REP_EM
#define REP_EM 1
#endif
#ifndef REP_DIL
#define REP_DIL 1
#endif
#ifndef REP_R1
#define REP_R1 1
#endif
#ifndef REP_R3
#define REP_R3 1
#endif
#ifndef REP_PRO
#define REP_PRO 1
#endif
#ifndef REP_SYNC
#define REP_SYNC 1
#endif
#define GSYNC() do { for (int rep_ = 0; rep_ < REP_SYNC; ++rep_) xcd_barrier(xb); } while (0)
constexpr int LDS_BYTES = 144 * 1024;

__global__ void __launch_bounds__(512) fwd_mega(Params p) {
    __shared__ __attribute__((aligned(16))) unsigned char lds_raw[LDS_BYTES];
    LAS unsigned char* lds = (LAS unsigned char*)lds_raw;
    cg::grid_group grid = cg::this_grid();
    __shared__ uint4 xb_words;
    if (threadIdx.x == 0) xb_words = make_uint4(0u, 0u, 0u, 0u);
    __syncthreads();
    const XcdBarrier xb = xcd_barrier_post((unsigned*)(p.ws + WS_BAR), (volatile LAS unsigned*)&xb_words);
    const float* x = p.in[0]; const float* mem = p.in[1];
    const float* even_mix_norm = p.in[2]; const float* even_w_in = p.in[3]; const float* pool_w = p.in[4]; const float* pool_scale = p.in[5];
    const float* sgu_norm = p.in[6]; const float* sgu_w = p.in[7]; const float* sgu_b = p.in[8]; const float* even_w_out = p.in[9];
    const float* odd_mix_norm = p.in[10]; const float* odd_w_in = p.in[11]; const float* odd_w_out = p.in[12];
    const float* xattn_norm = p.in[13]; const float* mem_norm = p.in[14]; const float* xattn_wq = p.in[15]; const float* xattn_wkv = p.in[16]; const float* xattn_wo = p.in[17];
    const float* ffn_norm = p.in[18]; const float* ffn_w_gate_up = p.in[19]; const float* ffn_w_down = p.in[20]; const float* final_norm = p.in[21];
    float* H = p.out;
    bf16_t* HB = (bf16_t*)(p.ws + WS_HB); bf16_t* Z = (bf16_t*)(p.ws + WS_Z); bf16_t* Y = (bf16_t*)(p.ws + WS_Y); bf16_t* WB = (bf16_t*)(p.ws + WS_W);
    bf16_t* MEMN = (bf16_t*)(p.ws + WS_MEMN); bf16_t* KV = (bf16_t*)(p.ws + WS_KV); float* SS = (float*)(p.ws + WS_SS); float* TAB = (float*)(p.ws + WS_TAB); float* SD = (float*)(p.ws + WS_SIDE); bf16_t* RET = (bf16_t*)(p.ws + WS_RET); LAS float* sred = (LAS float*)lds;

    for (int rep_ = 0; rep_ < REP_PRO; ++rep_) {
        LAS float* tile = (LAS float*)lds;
        conv_weight(even_w_in, even_mix_norm, WB + W_EIN, 1024, EVEN_IN, EVEN_IN, 0, tile);
        conv_weight(even_w_out, nullptr, WB + W_EOUT, 1024, 1024, 1024, 0, tile);
        conv_weight(odd_w_in, odd_mix_norm, WB + W_OIN, 1024, ODD_IN, ODD_IN, 1, tile);
        conv_weight(odd_w_out, nullptr, WB + W_OOUT, 1024, 1024, 1024, 0, tile);
        for (int l = 0; l < 2; ++l) {
            bf16_t* wl = WB + W_L0 + (size_t)l * WL_SIZE;
            conv_weight(xattn_wq + (size_t)l * 1024 * 1024, xattn_norm + l * 1024, wl + WL_Q, 1024, 1024, 1024, 2, tile);
            conv_weight(xattn_wkv + (size_t)l * 1024 * 2048, nullptr, wl + WL_KV, 1024, 2048, 2048, 0, tile);
            conv_weight(xattn_wo + (size_t)l * 1024 * 1024, nullptr, wl + WL_O, 1024, 1024, 1024, 0, tile);
            conv_weight(ffn_w_gate_up + (size_t)l * 1024 * GU, ffn_norm + l * 1024, wl + WL_GU, 1024, GU, GU, 3, tile);
            conv_weight(ffn_w_down + (size_t)l * DFF * 1024, nullptr, wl + WL_DN, DFF, 1024, 1024, 0, tile);
        }
        PHASE_IDS();
        for (int row0 = gw * 4; row0 < T; row0 += nw * 4) {
            float4 v[4][4];
#pragma unroll
            for (int rr = 0; rr < 4; ++rr)
#pragma unroll
                for (int i = 0; i < 4; ++i) v[rr][i] = ((const float4*)(x + (size_t)(row0 + rr) * 1024))[lane + 64 * i];
#pragma unroll
            for (int rr = 0; rr < 4; ++rr) {
                float s = 0.f;
#pragma unroll
                for (int i = 0; i < 4; ++i) {
                    const float4 q = v[rr][i];
                    s += (q.x * q.x + q.y * q.y) + (q.z * q.z + q.w * q.w);
                    uint2 w; w.x = cvt_pk_bf16(q.x, q.y); w.y = cvt_pk_bf16(q.z, q.w);
                    *(uint2*)(HB + (size_t)(row0 + rr) * 1024 + 4 * (lane + 64 * i)) = w;
                }
                s = wave_sum(s);
                if (lane < 4) SS[(size_t)(row0 + rr) * 16 + lane] = (lane == 0) ? s : 0.f;
            }
        }
        for (int row = gw; row < MROWS; row += nw) {
            const float4* xr = (const float4*)(mem + (size_t)row * 1024);
            float4 v[4]; float s = 0.f;
#pragma unroll
            for (int i = 0; i < 4; ++i) { v[i] = xr[lane + 64 * i]; s += (v[i].x * v[i].x + v[i].y * v[i].y) + (v[i].z * v[i].z + v[i].w * v[i].w); }
            s = wave_sum(s);
            const float rs = rsqrtf(s * (1.0f / 1024.0f) + 1e-6f);
#pragma unroll
            for (int l = 0; l < 2; ++l)
#pragma unroll
                for (int i = 0; i < 4; ++i) {
                    const float4 g = *(const float4*)(mem_norm + l * 1024 + 4 * (lane + 64 * i));
                    uint2 w; w.x = cvt_pk_bf16(v[i].x * rs * g.x, v[i].y * rs * g.y); w.y = cvt_pk_bf16(v[i].z * rs * g.z, v[i].w * rs * g.w);
                    *(uint2*)(MEMN + (size_t)l * MROWS * 1024 + (size_t)row * 1024 + 4 * (lane + 64 * i)) = w;
                }
        }
        for (int i = gt; i < 32 * 1024; i += nt) { const int b = i >> 10, k = i & 1023; SD[SD_H + k * 32 + b] = x[(size_t)b * 2048 * 1024 + k]; }
        {
            bf16_t* WSBw = (bf16_t*)(p.ws + WS_TAB + TABB_WSB); bf16_t* PWTw = (bf16_t*)(p.ws + WS_TAB + TABB_PWT);
            for (int i = gt; i < 4 * 128 * 128; i += nt) {
                const int g = i >> 14, a = (i >> 7) & 127, c = i & 127;
                WSBw[i] = f2bf(c <= a ? sgu_w[i] : 0.f);
                PWTw[i] = f2bf(pool_w[(size_t)g * 16384 + c * 128 + a] * pool_scale[g * 128 + a]);
            }
        }
        for (int i = gt; i < 2048 * 8; i += nt) { float s, c; sincos_d((double)(i >> 3) * p.inv_dil[i & 7], s, c); TAB[TAB_DC + i] = c; TAB[TAB_DS + i] = s; }
        for (int i = gt; i < 2048 * 64; i += nt) { float s, c; sincos_d((double)(i >> 6) * p.inv_ret[i & 63], s, c); TAB[TAB_RC + i] = c; TAB[TAB_RS + i] = s; }
    }
    grid.sync();

    {
        side_rstd(SD + SD_H, 1024, 1.0f / 1024.0f, sred);
        InPlain in{SD + SD_H, even_mix_norm}; EpStore ep{SD + SD_Z, sred + SRED_RSTD, 1.0f, 1};
        side_gemv(even_w_in + 512, EVEN_IN, 1024, 1024, in, ep, sred);
    }
    for (int g4 = 0; g4 < 4; ++g4) {
        const int l = g4 >> 1, isv = g4 & 1;
        const bf16_t* mn = MEMN + (size_t)l * MROWS * 1024; const bf16_t* wk = WB + W_L0 + (size_t)l * WL_SIZE + WL_KV;
        Epi<EP_PLAIN> E{KV + (size_t)l * MROWS * 2048 + (size_t)isv * MROWS * 1024, isv ? MROWS : 1024, nullptr, 0, nullptr, nullptr, nullptr};
        for (int rep_ = 0; rep_ < REP_GEMM; ++rep_) run_gemm<EP_PLAIN>(lds, isv ? wk + (size_t)1024 * 1024 : mn, isv ? mn : wk, isv ? 1024 : MROWS, isv ? MROWS : 1024, 1024, E, isv ? (int)(gridDim.x >> 1) : 0);
    }

    for (int layer = 0; layer < 2; ++layer) {
        const bf16_t* wl = WB + W_L0 + (size_t)layer * WL_SIZE;
        float* ss_base = SS + (size_t)(layer * 3 + 2) * SS_STRIDE;
        const float* ss_prev = (layer == 0) ? SS : SS + (size_t)4 * SS_STRIDE;
        const int ns_prev = (layer == 0) ? 4 : 16;
        if (layer == 0) {
            { Epi<EP_EVEN_IN> E{Z, EVEN_IN, ss_prev, ns_prev, nullptr, nullptr, SS + SS_STRIDE};
              for (int rep_ = 0; rep_ < REP_GEMM; ++rep_) run_gemm<EP_EVEN_IN>(lds, HB, WB + W_EIN, T, EVEN_IN, 1024, E); }
            GSYNC();
            {
                side_rstd(SD + SD_Z + 512 * 32, 512, 1.0f / 512.0f, sred);
                InSgu in{SD + SD_Z, sgu_w, sgu_b, sgu_norm, sred + SRED_RSTD};
                side_gemv_ks(even_w_out + (size_t)512 * 1024, 1024, 512, 1024, in, SD + SD_H, sred);
            }
            for (int rep_ = 0; rep_ < REP_EM; ++rep_) even_mix_units(lds, Z, SS + SS_STRIDE, (const bf16_t*)(p.ws + WS_TAB + TABB_WSB), (const bf16_t*)(p.ws + WS_TAB + TABB_PWT), sgu_norm, sgu_b, Y);
            GSYNC();
        } else {
            {
                side_rstd(SD + SD_H, 1024, 1.0f / 1024.0f, sred);
                InPlain in{SD + SD_H, ffn_norm}; EpStore ep{SD + SD_Z, sred + SRED_RSTD, 1.0f, 0};
                side_gemv(ffn_w_gate_up, GU, 1024, GU, in, ep, sred);
            }
            { Epi<EP_ODD_IN> E{Z, ODD_IN, ss_prev, ns_prev, nullptr, nullptr, nullptr};
              for (int rep_ = 0; rep_ < REP_GEMM; ++rep_) run_gemm<EP_ODD_IN>(lds, HB, WB + W_OIN, T, ODD_IN, 1024, E); }
            GSYNC();
            {
                InSwiglu in{SD + SD_Z};
                side_gemv_ks(ffn_w_down, 1024, DFF, 1024, in, SD + SD_H, sred);
            }
            for (int rep_ = 0; rep_ < REP_R1; ++rep_) ret_r1(lds, Z, TAB, RET);
            for (int rep_ = 0; rep_ < REP_DIL; ++rep_) dil_units(lds, Z, TAB, (bf16_t*)H, Y, SS + (size_t)6 * SS_STRIDE);
            GSYNC();
            {
                side_rstd(SD + SD_H, 1024, 1.0f / 1024.0f, sred);
                InPlain in{SD + SD_H, odd_mix_norm}; EpStore ep{SD + SD_Z, sred + SRED_RSTD, 1.0f, 0};
                side_gemv(odd_w_in + 1536, ODD_IN, 1024, 1024, in, ep, sred);
            }
            dil_combine((const bf16_t*)H, Y, SS + (size_t)6 * SS_STRIDE);
            ret_r2(RET);
            GSYNC();
            for (int rep_ = 0; rep_ < REP_R3; ++rep_) ret_r3(lds, Z, TAB, RET, SD + SD_Z, Y);
            GSYNC();
        }

        for (int sub = 0; sub < 3; ++sub) {
            const bf16_t* A = Y; const bf16_t* Bt = (layer == 0) ? (WB + W_EOUT) : (WB + W_OOUT); int K = 1024;
            if (sub == 1) {
                if (layer == 0) {
                PHASE_IDS();
                for (int item = gw; item < 4096; item += nw) {
                    const int i = item >> 2, h = item & 3;
                    const float4 w = *(const float4*)(xattn_wkv + (size_t)i * 2048 + h * 256 + lane * 4);
                    const float* qb = SD + SD_Q + (size_t)(h * 256 + lane * 4) * 32;
                    float mine = 0.f;
#pragma unroll
                    for (int b4 = 0; b4 < 8; ++b4) {
                        const float4 q0 = *(const float4*)(qb + b4 * 4), q1 = *(const float4*)(qb + 32 + b4 * 4), q2 = *(const float4*)(qb + 64 + b4 * 4), q3 = *(const float4*)(qb + 96 + b4 * 4);
                        const float s0 = wave_sum((w.x * q0.x + w.y * q1.x) + (w.z * q2.x + w.w * q3.x)), s1 = wave_sum((w.x * q0.y + w.y * q1.y) + (w.z * q2.y + w.w * q3.y));
                        const float s2 = wave_sum((w.x * q0.z + w.y * q1.z) + (w.z * q2.z + w.w * q3.z)), s3 = wave_sum((w.x * q0.w + w.y * q1.w) + (w.z * q2.w + w.w * q3.w));
                        if (lane == b4 * 4 + 0) mine = s0; if (lane == b4 * 4 + 1) mine = s1; if (lane == b4 * 4 + 2) mine = s2; if (lane == b4 * 4 + 3) mine = s3;
                    }
                    if (lane < 32) SD[SD_R + (size_t)(lane * 4 + h) * 1024 + i] = mine;
                }
            }
                { Epi<EP_SCALE> E{Y, 1024, ss_base, 16, nullptr, nullptr, nullptr};
                  for (int rep_ = 0; rep_ < REP_GEMM; ++rep_) run_gemm<EP_SCALE>(lds, HB, wl + WL_Q, T, 1024, 1024, E); }
                GSYNC();
                if (layer == 0) {
                    PHASE_IDS();
                    for (int item = gw; item < 8192; item += nw) {
                        const int b = item >> 8;
                        const float4* mr = (const float4*)(mem + (size_t)item * 1024);
                        float ssq = 0.f, a0 = 0.f, a1 = 0.f, a2 = 0.f, a3 = 0.f;
#pragma unroll
                        for (int q = 0; q < 4; ++q) {
                            const int idx = lane + 64 * q;
                            const float4 m = mr[idx], g = ((const float4*)mem_norm)[idx];
                            ssq += (m.x * m.x + m.y * m.y) + (m.z * m.z + m.w * m.w);
                            const float4 mg = make_float4(m.x * g.x, m.y * g.y, m.z * g.z, m.w * g.w);
                            const float4 r0 = ((const float4*)(SD + SD_R + (size_t)(b * 4 + 0) * 1024))[idx], r1 = ((const float4*)(SD + SD_R + (size_t)(b * 4 + 1) * 1024))[idx];
                            const float4 r2 = ((const float4*)(SD + SD_R + (size_t)(b * 4 + 2) * 1024))[idx], r3 = ((const float4*)(SD + SD_R + (size_t)(b * 4 + 3) * 1024))[idx];
                            a0 += (mg.x * r0.x + mg.y * r0.y) + (mg.z * r0.z + mg.w * r0.w); a1 += (mg.x * r1.x + mg.y * r1.y) + (mg.z * r1.z + mg.w * r1.w);
                            a2 += (mg.x * r2.x + mg.y * r2.y) + (mg.z * r2.z + mg.w * r2.w); a3 += (mg.x * r3.x + mg.y * r3.y) + (mg.z * r3.z + mg.w * r3.w);
                        }
                        ssq = wave_sum(ssq); a0 = wave_sum(a0); a1 = wave_sum(a1); a2 = wave_sum(a2); a3 = wave_sum(a3);
                        const float rs = rsqrtf(ssq * (1.0f / 1024.0f) + 1e-6f);
                        if (lane == 0) { const int j = item & 255; float* pp = SD + SD_P + (size_t)b * 4 * 256 + j; pp[0] = a0 * rs; pp[256] = a1 * rs; pp[512] = a2 * rs; pp[768] = a3 * rs; SD[SD_M + item] = rs; }
                    }
                }
                xattn_phase(lds, Y, KV + (size_t)layer * MROWS * 2048, KV + (size_t)layer * MROWS * 2048 + (size_t)MROWS * 1024);
                GSYNC();
                Bt = wl + WL_O;
            } else if (sub == 2) {
                if (layer == 0) {
                InHead in{SD + SD_T}; EpStore ep{SD + SD_O, nullptr, 1.0f, 0};
                side_gemv(xattn_wkv + 1024, 2048, 1024, 1024, in, ep, sred);
            }
                { Epi<EP_GU> E{Z, DFF, ss_base + SS_STRIDE, 16, nullptr, nullptr, nullptr};
                  for (int rep_ = 0; rep_ < REP_GEMM; ++rep_) run_gemm<EP_GU>(lds, HB, wl + WL_GU, T, GU, 1024, E); }
                GSYNC();
                A = Z; Bt = wl + WL_DN; K = DFF;
            }
            if (layer == 0 && sub == 0) {
                side_rstd(SD + SD_H, 1024, 1.0f / 1024.0f, sred);
                InPlain in{SD + SD_H, xattn_norm}; EpStore ep{SD + SD_Q, sred + SRED_RSTD, 0.0625f, 0};
                side_gemv(xattn_wq, 1024, 1024, 1024, in, ep, sred);
            }
            if (layer == 0 && sub == 1) {
                    PHASE_IDS();
                    LAS float* pl = sred; LAS float* prt = sred + 1024;
                    for (int item = blockIdx.x; item < 256; item += gridDim.x) {
                        const int b = item >> 3, il = tid & 127, i = (item & 7) * 128 + il, jg = tid >> 7;
                        if (wave < 4) {
                            const float* sp = SD + SD_P + (size_t)(b * 4 + wave) * 256;
                            float e0 = sp[lane], e1 = sp[lane + 64], e2 = sp[lane + 128], e3 = sp[lane + 192];
                            const float mx = wave_max(fmaxf(fmaxf(e0, e1), fmaxf(e2, e3)));
                            e0 = __expf(e0 - mx); e1 = __expf(e1 - mx); e2 = __expf(e2 - mx); e3 = __expf(e3 - mx);
                            const float inv = 1.0f / wave_sum((e0 + e1) + (e2 + e3));
                            const float* rm = SD + SD_M + b * 256;
                            pl[wave * 256 + lane] = e0 * inv * rm[lane]; pl[wave * 256 + lane + 64] = e1 * inv * rm[lane + 64];
                            pl[wave * 256 + lane + 128] = e2 * inv * rm[lane + 128]; pl[wave * 256 + lane + 192] = e3 * inv * rm[lane + 192];
                        }
                        __syncthreads();
                        float t0 = 0.f, t1 = 0.f, t2 = 0.f, t3 = 0.f;
                        const float* mc = mem + (size_t)b * 256 * 1024 + (size_t)(jg * 64) * 1024 + i;
#pragma unroll 16
                        for (int j = 0; j < 64; ++j) { const float m = mc[(size_t)j * 1024]; const int jj = jg * 64 + j; t0 += pl[jj] * m; t1 += pl[256 + jj] * m; t2 += pl[512 + jj] * m; t3 += pl[768 + jj] * m; }
                        prt[(jg * 4 + 0) * 128 + il] = t0; prt[(jg * 4 + 1) * 128 + il] = t1; prt[(jg * 4 + 2) * 128 + il] = t2; prt[(jg * 4 + 3) * 128 + il] = t3;
                        __syncthreads();
                        {
                            const int hh = tid >> 7;
                            const float tsum = (prt[(0 * 4 + hh) * 128 + il] + prt[(1 * 4 + hh) * 128 + il]) + (prt[(2 * 4 + hh) * 128 + il] + prt[(3 * 4 + hh) * 128 + il]);
                            SD[SD_T + ((size_t)hh * 1024 + i) * 32 + b] = tsum * mem_norm[i];
                        }
                        __syncthreads();
                    }
                }
            if (layer == 0 && sub == 2) {
                    InPlain in{SD + SD_O, nullptr};
                    side_gemv_ks(xattn_wo, 1024, 1024, 1024, in, SD + SD_H, sred);
                }
            { Epi<EP_RES> E{HB, 1024, nullptr, 0, HB, nullptr, ss_base + (size_t)sub * SS_STRIDE};
              run_gemm<EP_RES>(lds, A, Bt, T, 1024, K, E); }
            GSYNC();
        }
    }

    {
        const float* ssf = SS + (size_t)7 * SS_STRIDE;
        PHASE_IDS();
        for (int row = gw; row < T; row += nw) {
            const float sp = (lane < 16) ? ssf[(size_t)row * 16 + lane] : 0.f;
            const float rs = rsqrtf(wave_sum(sp) * (1.0f / 1024.0f) + 1e-6f);
            float4* hr = (float4*)(H + (size_t)row * 1024);
            const uint2* hb = (const uint2*)(HB + (size_t)row * 1024);
#pragma unroll
            for (int i = 0; i < 4; ++i) {
                const uint2 q = hb[lane + 64 * i];
                const float4 g = ((const float4*)final_norm)[lane + 64 * i];
                float4 v; v.x = bflo(q.x) * rs * g.x; v.y = bfhi(q.x) * rs * g.y; v.z = bflo(q.y) * rs * g.z; v.w = bfhi(q.y) * rs * g.w;
                hr[lane + 64 * i] = v;
            }
        }
    }
}

extern "C" void kernel_launch(void* const* d_in, const int* in_sizes, int n_in, void* d_out, int out_size, void* d_ws, size_t ws_size, hipStream_t stream) {
    static int grid_blocks = 0;
    if (grid_blocks == 0) {
        if (n_in != 22 || out_size != T * DM || ws_size < WS_END) { fprintf(stderr, "kernel_launch: unexpected shapes (n_in %d, out %d, ws %zu)\n", n_in, out_size, ws_size); grid_blocks = -1; return; }
        int dev = 0, cus = 0, per_cu = 0;
        hipGetDevice(&dev);
        hipDeviceGetAttribute(&cus, hipDeviceAttributeMultiprocessorCount, dev);
        hipOccupancyMaxActiveBlocksPerMultiprocessor(&per_cu, fwd_mega, 512, 0);
        if (per_cu < 1) per_cu = 1;
        if (per_cu > 1) per_cu = 1;
        grid_blocks = cus * per_cu;
    }
    if (grid_blocks < 0) return;
    Params p;
    memset(&p, 0, sizeof(p));
    for (int i = 0; i < 22; ++i) p.in[i] = (const float*)d_in[i];
    p.out = (float*)d_out; p.ws = (unsigned char*)d_ws;
    for (int i = 0; i < 8; ++i) p.inv_dil[i] = std::exp(-((double)i / 8.0) * std::log(500000.0));
    for (int i = 0; i < 64; ++i) p.inv_ret[i] = std::exp(-((double)i / 64.0) * std::log(10000.0));
    (void)hipMemsetAsync((char*)d_ws + WS_BAR, 0, XCD_BAR_WORDS * 4, stream);
    void* args[] = {&p};
    hipError_t e = hipLaunchCooperativeKernel((void*)fwd_mega, dim3(grid_blocks), dim3(512), args, 0, stream);
    if (e != hipSuccess) fprintf(stderr, "cooperative launch failed: %s (grid %d)\n", hipGetErrorString(e), grid_blocks);
}
```

```cpp
#include <hip/hip_runtime.h>
#include <hip/hip_cooperative_groups.h>
#include <cstdio>
#include <cmath>
namespace cg = cooperative_groups;
#include <cstring>
namespace pg8 {
#define PG8_LAS __attribute__((address_space(3)))
typedef unsigned short bf16_t;
typedef short bf16x8 __attribute__((ext_vector_type(8)));
typedef float f32x4 __attribute__((ext_vector_type(4)));
typedef unsigned u32x4 __attribute__((ext_vector_type(4)));
constexpr int BM = 256, BK = 64, HALF = 128, HTB = HALF * BK * 2  , STAGE_BYTES = 8 * HTB, NXCD = 8, WGM = 4;

__host__ __device__ __forceinline__ int lds_byte(int r, int c) { const int st = (r >> 4) * 2 + (c >> 5), rr = r & 15, cc = c & 31, ob = rr * 64 + cc * 2; return st * 1024 + (ob ^ (((ob >> 9) & 1) << 5)); }
__host__ __device__ __forceinline__ void stage_rc(int b, int& R, int& C) { const int st = b / 1024, sb = b % 1024, swz = sb ^ (((sb >> 9) & 1) << 5); R = (st >> 1) * 16 + swz / 64; C = (st & 1) * 32 + (swz % 64) / 2; }
__host__ __device__ __forceinline__ int perm32(int rho) { const int n = rho >> 4, i = rho & 15; return 8 * (i >> 2) + 4 * n + (i & 3); }

struct Unit { int pm, pn; };
struct Gemm { const bf16_t* A; const bf16_t* Bt; int M, N, K; };

struct StaticOrder {
    int nM, nN, nwg, G, c;
    __host__ __device__ void init(int M, int N, int G_, int c_) { nM = M / BM; nN = N / BM; nwg = nM * nN; G = G_; c = c_; }
    __host__ __device__ bool next(int i, Unit& u) const {
        const long L = (long)i * G + c; if (L >= nwg) return false;
        int wgid = (int)L; { const int q = nwg / NXCD, r = nwg % NXCD, xcd = wgid % NXCD, off = wgid / NXCD; wgid = (xcd < r ? xcd * (q + 1) : r * (q + 1) + (xcd - r) * q) + off; }
        const int nig = WGM * nN, gid = wgid / nig, fm = gid * WGM, gsz = (nM - fm) < WGM ? (nM - fm) : WGM;
        u.pm = fm + ((wgid % nig) % gsz); u.pn = (wgid % nig) / gsz; return true;
    }
    __device__ __forceinline__ void a_ready(const Unit&) const {}
    __device__ __forceinline__ void done(const Unit&) const {}
};
__device__ __forceinline__ unsigned cvt_pk_bf16(float lo, float hi) { unsigned r; asm volatile("v_cvt_pk_bf16_f32 %0, %1, %2" : "=v"(r) : "v"(lo), "v"(hi)); return r; }
typedef float f32x2 __attribute__((ext_vector_type(2)));
template <class Epi, class Sched, bool ALIGN_EPI = false, bool SP2 = false>
__device__ __forceinline__ void gemm_phase(PG8_LAS unsigned char* lds, const Gemm g, const Sched& S, const Epi& E) {
    int tid_o = threadIdx.x; asm volatile("" : "+v"(tid_o));
    const int tid = tid_o, wid = __builtin_amdgcn_readfirstlane(tid >> 6), lane = tid & 63, wr = wid >> 2, wc = wid & 3, fr = lane & 15, fq = lane >> 4;
    const int K = g.K, nt = K / BK;
    unsigned voffA[2], voffB[2];
#pragma unroll
    for (int i = 0; i < 2; ++i) { int R, C; stage_rc(tid * 16 + i * 8192, R, C); const int Rb = Epi::PERM ? ((R & ~31) + perm32(R & 31)) : R;
        voffA[i] = (unsigned)(R * K + C) * 2u; voffB[i] = (unsigned)(Rb * K + C) * 2u; }
    const size_t kstep = (size_t)(BK * 2);
    const size_t hstep = (size_t)HALF * K * 2;
    const size_t tstep = 2 * hstep;
    const unsigned ldsw = (unsigned)wid * 1024u;
    const int aoff = lds_byte(wr * 64 + fr, fq * 8), boff = lds_byte(wc * 32 + fr, fq * 8);
#define PG8_SA(b, h) (((b) * 2 + (h)) * HTB)
#define PG8_SB(b, h) ((4 + (b) * 2 + (h)) * HTB)
#define PG8_STAGE(bufoff, gbase, voff) do { const char* _gb = (const char*)(gbase); asm volatile("" : "+s"(_gb)); _Pragma("unroll") for (int _i = 0; _i < 2; ++_i) \
        __builtin_amdgcn_global_load_lds((const unsigned*)(_gb + (voff)[_i]), (PG8_LAS unsigned*)(lds + (bufoff) + ldsw + _i * 8192), 16, 0, 0); } while (0)
#define PG8_LDA(dst, b, h) do { _Pragma("unroll") for (int m = 0; m < 4; ++m) _Pragma("unroll") for (int k = 0; k < 2; ++k) dst[m][k] = *(const PG8_LAS bf16x8*)(lds + PG8_SA(b, h) + aoff + m * 2048 + k * 1024); } while (0)
#define PG8_LDB(dst, b, h) do { _Pragma("unroll") for (int n = 0; n < 2; ++n) _Pragma("unroll") for (int k = 0; k < 2; ++k) dst[n][k] = *(const PG8_LAS bf16x8*)(lds + PG8_SB(b, h) + boff + n * 2048 + k * 1024); } while (0)
#define PG8_MMA(ai, bj, At, Bt) do { __builtin_amdgcn_s_setprio(1); _Pragma("unroll") for (int m = 0; m < 4; ++m) _Pragma("unroll") for (int n = 0; n < 2; ++n) _Pragma("unroll") for (int k = 0; k < 2; ++k) \
        acc[ai][bj][m][n] = __builtin_amdgcn_mfma_f32_16x16x32_bf16(Bt[n][k], At[m][k], acc[ai][bj][m][n], 0, 0, 0); __builtin_amdgcn_s_setprio(0); } while (0)
#define PG8_WAIT_V(n) asm volatile("s_waitcnt vmcnt(" #n ")" ::: "memory")
#define PG8_WAIT_L(n) asm volatile("s_waitcnt lgkmcnt(" #n ")" ::: "memory")
#define PG8_BAR __builtin_amdgcn_s_barrier()
#define PG8_SCHED __builtin_amdgcn_sched_barrier(0)
    Unit cur, nxt; int ui = 0;
    if (!S.next(0, cur)) return;
    f32x4 acc[2][2][4][2];
#pragma unroll
    for (int a = 0; a < 2; ++a)
#pragma unroll
        for (int b = 0; b < 2; ++b)
#pragma unroll
            for (int m = 0; m < 4; ++m)
#pragma unroll
                for (int n = 0; n < 2; ++n) acc[a][b][m][n] = (f32x4){0.f, 0.f, 0.f, 0.f};
    bf16x8 At[4][2], B0[2][2], B1[2][2];
    const char* cA = (const char*)g.A + (size_t)cur.pm * tstep; const char* cB = (const char*)g.Bt + (size_t)cur.pn * tstep;
    S.a_ready(cur);
    if constexpr (SP2) {
        PG8_STAGE(PG8_SB(0, 0), cB, voffB); PG8_STAGE(PG8_SB(0, 1), cB + hstep, voffB); PG8_STAGE(PG8_SA(0, 0), cA, voffA); PG8_STAGE(PG8_SA(0, 1), cA + hstep, voffA);
        if (wr == 1) PG8_BAR;
        PG8_WAIT_V(2); PG8_BAR;
        PG8_STAGE(PG8_SB(1, 0), cB + kstep, voffB); PG8_STAGE(PG8_SA(1, 0), cA + kstep, voffA); PG8_STAGE(PG8_SB(1, 1), cB + hstep + kstep, voffB);
        PG8_WAIT_V(6); PG8_BAR;
    } else {
        PG8_STAGE(PG8_SB(0, 0), cB, voffB); PG8_STAGE(PG8_SA(0, 0), cA, voffA); PG8_STAGE(PG8_SB(0, 1), cB + hstep, voffB); PG8_STAGE(PG8_SA(0, 1), cA + hstep, voffA);
        if (wr == 1) PG8_BAR;
        PG8_WAIT_V(4); PG8_BAR;
        PG8_STAGE(PG8_SB(1, 0), cB + kstep, voffB); PG8_STAGE(PG8_SA(1, 0), cA + kstep, voffA); PG8_STAGE(PG8_SB(1, 1), cB + hstep + kstep, voffB);
        PG8_WAIT_V(6); PG8_BAR;
    }
    for (;;) {
        const bool has_next = S.next(ui + 1, nxt);
        const char* nA = has_next ? (const char*)g.A + (size_t)nxt.pm * tstep : cA; const char* nB = has_next ? (const char*)g.Bt + (size_t)nxt.pn * tstep : cB;
        for (int t = 0; t < nt; t += 2) {
            const bool last = (t == nt - 2);
            const char* a1 = cA + (size_t)(t + 1) * kstep;
            const char* a2 = last ? nA : cA + (size_t)(t + 2) * kstep; const char* b2 = last ? nB : cB + (size_t)(t + 2) * kstep;
            const char* a3 = a2 + kstep; const char* b3 = b2 + kstep;
            if (last && has_next) S.a_ready(nxt);
            if constexpr (SP2) {
            PG8_LDB(B0, 0, 0); PG8_LDB(B1, 0, 1); PG8_SCHED; PG8_LDA(At, 0, 0); PG8_STAGE(PG8_SA(1, 1), a1 + hstep, voffA);
            PG8_WAIT_V(8); PG8_WAIT_L(0); PG8_BAR; PG8_MMA(0, 0, At, B0); PG8_MMA(0, 1, At, B1); PG8_BAR; PG8_SCHED;
            PG8_LDA(At, 0, 1); PG8_STAGE(PG8_SB(0, 0), b2, voffB); PG8_STAGE(PG8_SB(0, 1), b2 + hstep, voffB); PG8_STAGE(PG8_SA(0, 0), a2, voffA);
            PG8_WAIT_V(8); PG8_WAIT_L(0); PG8_BAR; PG8_MMA(1, 0, At, B0); PG8_MMA(1, 1, At, B1); PG8_BAR; PG8_SCHED;
            PG8_LDB(B0, 1, 0); PG8_LDB(B1, 1, 1); PG8_SCHED; PG8_LDA(At, 1, 0); PG8_STAGE(PG8_SA(0, 1), a2 + hstep, voffA);
            PG8_WAIT_V(8); PG8_WAIT_L(0); PG8_BAR; PG8_MMA(0, 0, At, B0); PG8_MMA(0, 1, At, B1); PG8_BAR; PG8_SCHED;
            PG8_LDA(At, 1, 1); PG8_STAGE(PG8_SB(1, 0), b3, voffB); PG8_STAGE(PG8_SB(1, 1), b3 + hstep, voffB); PG8_STAGE(PG8_SA(1, 0), a3, voffA);
            PG8_WAIT_V(8); PG8_WAIT_L(0); PG8_BAR; PG8_MMA(1, 0, At, B0); PG8_MMA(1, 1, At, B1); PG8_BAR; PG8_SCHED;
            } else {
            PG8_LDB(B0, 0, 0); PG8_SCHED; PG8_LDA(At, 0, 0); PG8_STAGE(PG8_SA(1, 1), a1 + hstep, voffA);
            PG8_WAIT_L(8); PG8_BAR; PG8_WAIT_L(0); PG8_MMA(0, 0, At, B0); PG8_BAR; PG8_SCHED;
            PG8_LDB(B1, 0, 1); PG8_STAGE(PG8_SB(0, 0), b2, voffB);
            PG8_BAR; PG8_WAIT_L(0); PG8_MMA(0, 1, At, B1); PG8_BAR;
            PG8_LDA(At, 0, 1); PG8_STAGE(PG8_SA(0, 0), a2, voffA);
            PG8_BAR; PG8_WAIT_L(0); PG8_MMA(1, 0, At, B0); PG8_BAR; PG8_SCHED;
            PG8_STAGE(PG8_SB(0, 1), b2 + hstep, voffB);
            PG8_WAIT_V(6); PG8_BAR; PG8_MMA(1, 1, At, B1); PG8_BAR;
            PG8_LDB(B0, 1, 0); PG8_SCHED; PG8_LDA(At, 1, 0); PG8_STAGE(PG8_SA(0, 1), a2 + hstep, voffA);
            PG8_WAIT_L(8); PG8_BAR; PG8_WAIT_L(0); PG8_MMA(0, 0, At, B0); PG8_BAR; PG8_SCHED;
            PG8_LDB(B1, 1, 1); PG8_STAGE(PG8_SB(1, 0), b3, voffB);
            PG8_BAR; PG8_WAIT_L(0); PG8_MMA(0, 1, At, B1); PG8_BAR;
            PG8_LDA(At, 1, 1); PG8_STAGE(PG8_SA(1, 0), a3, voffA);
            PG8_BAR; PG8_WAIT_L(0); PG8_MMA(1, 0, At, B0); PG8_BAR; PG8_SCHED;
            PG8_STAGE(PG8_SB(1, 1), b3 + hstep, voffB);
            PG8_WAIT_V(6); PG8_BAR; PG8_MMA(1, 1, At, B1); PG8_BAR;
            }
        }
        if constexpr (ALIGN_EPI) { if (wr == 0) PG8_BAR; }
        if constexpr (!Epi::AFTER_DRAIN) { E(acc, cur, wr, wc, fr, fq); S.done(cur); }
        if (!has_next) break;
#pragma unroll
        for (int a = 0; a < 2; ++a)
#pragma unroll
            for (int b = 0; b < 2; ++b)
#pragma unroll
                for (int m = 0; m < 4; ++m)
#pragma unroll
                    for (int n = 0; n < 2; ++n) acc[a][b][m][n] = (f32x4){0.f, 0.f, 0.f, 0.f};
        cur = nxt; cA = nA; cB = nB; ++ui;
        if constexpr (ALIGN_EPI) { if (wr == 1) PG8_BAR; }
    }
    PG8_WAIT_V(0);
    if constexpr (!ALIGN_EPI) { if (wr == 0) PG8_BAR; }
    PG8_BAR;
    if constexpr (Epi::AFTER_DRAIN) { E.fused(acc, cur, wr, wc, fr, fq, lds, wid, lane); S.done(cur); }
#undef PG8_SA
#undef PG8_SB
#undef PG8_STAGE
#undef PG8_LDA
#undef PG8_LDB
#undef PG8_MMA
#undef PG8_WAIT_V
#undef PG8_WAIT_L
#undef PG8_BAR
#undef PG8_SCHED
}
}

using pg8::bf16_t; using pg8::f32x4; using pg8::Unit; using pg8::cvt_pk_bf16;
#define LAS __attribute__((address_space(3)))
constexpr int T = 65536, DM = 1024, SEQ = 2048, MROWS = 8192;
constexpr int EVEN_IN = 1536, ODD_IN = 3584, DFF = 2816, GU = 5632;
constexpr size_t MiB = 1024ull * 1024ull;
constexpr size_t WS_HB = 0, WS_Z = 128 * MiB, WS_Y = 576 * MiB, WS_W = 704 * MiB, WS_MEMN = 768 * MiB, WS_KV = 800 * MiB, WS_SS = 864 * MiB, WS_TAB = 896 * MiB, WS_SIDE = 898 * MiB, WS_RET = 906 * MiB, WS_BAR = 970 * MiB, WS_END = 971 * MiB;
constexpr size_t W_EIN = 0, W_EOUT = W_EIN + 1536ull * 1024, W_OIN = W_EOUT + 1024ull * 1024, W_OOUT = W_OIN + 3584ull * 1024, W_L0 = W_OOUT + 1024ull * 1024;
constexpr size_t WL_Q = 0, WL_KV = 1024ull * 1024, WL_O = WL_KV + 2048ull * 1024, WL_GU = WL_O + 1024ull * 1024, WL_DN = WL_GU + 5632ull * 1024, WL_SIZE = WL_DN + 1024ull * 2816;
static_assert((W_L0 + 2 * WL_SIZE) * 2 <= 64 * MiB, "weights region");
constexpr size_t SS_STRIDE = (size_t)T * 16;
constexpr size_t TAB_DC = 0, TAB_DS = 2048 * 8, TAB_RC = 2 * 2048 * 8, TAB_RS = TAB_RC + 2048 * 64;
constexpr size_t SD_H = 0, SD_Z = SD_H + 1024 * 32, SD_Q = SD_Z + 5632 * 32, SD_R = SD_Q + 1024 * 32, SD_P = SD_R + 32 * 4 * 1024, SD_M = SD_P + 32 * 4 * 256, SD_T = SD_M + 32 * 256, SD_O = SD_T + 4 * 1024 * 32, SD_END = SD_O + 1024 * 32;
static_assert(SD_END * 4 <= 8 * MiB, "side region");

typedef short bf16x8_t __attribute__((ext_vector_type(8)));
typedef unsigned u32x4_t __attribute__((ext_vector_type(4)));
typedef unsigned u32x2_t __attribute__((ext_vector_type(2)));
struct Params {
    const float* in[22];
    float* out;
    unsigned char* ws;
    double inv_dil[8];
    double inv_ret[64];
};

__device__ __forceinline__ int opaque_tid() { int t = threadIdx.x; asm volatile("" : "+v"(t)); return t; }
__device__ __forceinline__ int xcd_unit(int it, int total) {
    const int G = (int)gridDim.x, bx = (int)blockIdx.x;
    if ((G & 7) || (total & 7)) { const int u = it * G + bx; return u < total ? u : -1; }
    const int per = total >> 3, ny = G >> 3, idx = it * ny + (bx >> 3);
    return idx < per ? (bx & 7) * per + idx : -1;
}
#define LDS_BARRIER() do { asm volatile("s_waitcnt lgkmcnt(0)" ::: "memory"); __builtin_amdgcn_s_barrier(); asm volatile("" ::: "memory"); } while (0)
__device__ __forceinline__ float bf2f(unsigned short v) { return __uint_as_float((unsigned)v << 16); }
__device__ __forceinline__ float bflo(unsigned v) { return __uint_as_float(v << 16); }
__device__ __forceinline__ float bfhi(unsigned v) { return __uint_as_float(v & 0xffff0000u); }
__device__ __forceinline__ unsigned short f2bf(float f) { return (unsigned short)(cvt_pk_bf16(f, 0.f) & 0xffffu); }
__device__ __forceinline__ float dot8(const uint4 a, const uint4 b) {
    float s = bflo(a.x) * bflo(b.x); s += bfhi(a.x) * bfhi(b.x);
    s += bflo(a.y) * bflo(b.y); s += bfhi(a.y) * bfhi(b.y);
    s += bflo(a.z) * bflo(b.z); s += bfhi(a.z) * bfhi(b.z);
    s += bflo(a.w) * bflo(b.w); s += bfhi(a.w) * bfhi(b.w);
    return s;
}
__device__ __forceinline__ float wave_sum(float v) {
#pragma unroll
    for (int o = 32; o >= 1; o >>= 1) v += __shfl_xor(v, o);
    return v;
}
__device__ __forceinline__ float wave_max(float v) {
#pragma unroll
    for (int o = 32; o >= 1; o >>= 1) v = fmaxf(v, __shfl_xor(v, o));
    return v;
}
__device__ __forceinline__ float silu_f(float x) { return x * __builtin_amdgcn_rcpf(1.0f + __builtin_amdgcn_exp2f(-1.4426950408889634f * x)); }
__device__ __forceinline__ float gelu_tanh_f(float x) {
    const float y = 1.5957691216057308f * (x + 0.044715f * x * x * x);
    return x * __builtin_amdgcn_rcpf(1.0f + __builtin_amdgcn_exp2f(-1.4426950408889634f * y));
}
__device__ __forceinline__ float row_rstd(const float* ss, int nslot, int row, float inv_dim) {
    float s = 0.f;
    for (int i = 0; i < nslot; i += 4) { const float4 v = *(const float4*)(ss + (size_t)row * 16 + i); s += (v.x + v.y) + (v.z + v.w); }
    return rsqrtf(s * inv_dim + 1e-6f);
}
__device__ __forceinline__ float coop_rstd(const float* ss, int nslot, int row, int fq, float inv_dim) {
    float s = 0.f;
    if (4 * fq < nslot) { const float4 v = *(const float4*)(ss + (size_t)row * 16 + 4 * fq); s = (v.x + v.y) + (v.z + v.w); }
    s += __shfl_xor(s, 16); s += __shfl_xor(s, 32);
    return rsqrtf(s * inv_dim + 1e-6f);
}

enum { EP_EVEN_IN = 0, EP_RES = 1, EP_SCALE = 2, EP_GU = 3, EP_ODD_IN = 4, EP_PLAIN = 5 };
template <int MODE> struct Epi {
    static constexpr bool PERM = true, AFTER_DRAIN = false;
    bf16_t* O; int ldo;
    const float* ss_in; int ns_in;
    const bf16_t* res; float* hout;
    float* ss_out;
    __device__ __forceinline__ void operator()(const f32x4 (&acc)[2][2][4][2], const Unit& u, int wr, int wc, int fr_in, int fq_in) const {
        int fr = fr_in, fq = fq_in;
        asm volatile("" : "+v"(fr), "+v"(fq));
        const int row00 = u.pm * 256 + wr * 64 + fr;
        float rsv[2][4];
        if (MODE == EP_EVEN_IN || MODE == EP_SCALE || MODE == EP_GU || MODE == EP_ODD_IN) {
            float part[2][4];
#pragma unroll
            for (int ai = 0; ai < 2; ++ai)
#pragma unroll
                for (int m = 0; m < 4; ++m) {
                    float sp = 0.f;
                    if (4 * fq < ns_in) { const float4 v = *(const float4*)(ss_in + (size_t)(row00 + ai * 128 + m * 16) * 16 + 4 * fq); sp = (v.x + v.y) + (v.z + v.w); }
                    part[ai][m] = sp;
                }
#pragma unroll
            for (int ai = 0; ai < 2; ++ai)
#pragma unroll
                for (int m = 0; m < 4; ++m) { float sp = part[ai][m]; sp += __shfl_xor(sp, 16); sp += __shfl_xor(sp, 32); rsv[ai][m] = rsqrtf(sp * (1.0f / 1024.0f) + 1e-6f); }
        } else {
#pragma unroll
            for (int ai = 0; ai < 2; ++ai)
#pragma unroll
                for (int m = 0; m < 4; ++m) rsv[ai][m] = 1.0f;
        }
#pragma unroll
        for (int ai = 0; ai < 2; ++ai) {
            u32x4_t rres[4][2];
            if (MODE == EP_RES) {
#pragma unroll
                for (int m = 0; m < 4; ++m)
#pragma unroll
                    for (int bj = 0; bj < 2; ++bj) rres[m][bj] = *(const u32x4_t*)(res + (size_t)(row00 + ai * 128 + m * 16) * 1024 + u.pn * 256 + bj * 128 + wc * 32 + fq * 8);
            }
#pragma unroll
            for (int m = 0; m < 4; ++m) {
                const int row = row00 + ai * 128 + m * 16;
                const float rs = rsv[ai][m];
                if (MODE == EP_GU) {
                    const f32x4 g0 = acc[ai][0][m][0] * rs, g1 = acc[ai][0][m][1] * rs, u0 = acc[ai][1][m][0] * rs, u1 = acc[ai][1][m][1] * rs;
                    uint4 w;
                    w.x = cvt_pk_bf16(silu_f(g0[0]) * u0[0], silu_f(g0[1]) * u0[1]); w.y = cvt_pk_bf16(silu_f(g0[2]) * u0[2], silu_f(g0[3]) * u0[3]);
                    w.z = cvt_pk_bf16(silu_f(g1[0]) * u1[0], silu_f(g1[1]) * u1[1]); w.w = cvt_pk_bf16(silu_f(g1[2]) * u1[2], silu_f(g1[3]) * u1[3]);
                    *(uint4*)(O + (size_t)row * ldo + u.pn * 128 + wc * 32 + fq * 8) = w;
                } else {
                    float sq = 0.f;
#pragma unroll
                    for (int bj = 0; bj < 2; ++bj) {
                        const int col0 = u.pn * 256 + bj * 128 + wc * 32 + fq * 8;
                        f32x4 v0 = acc[ai][bj][m][0] * rs, v1 = acc[ai][bj][m][1] * rs;
                        if (MODE == EP_EVEN_IN) {
                            if (u.pn >= 2) {
#pragma unroll
                                for (int j = 0; j < 4; ++j) { v0[j] = gelu_tanh_f(v0[j]); v1[j] = gelu_tanh_f(v1[j]); }
                            }
                            if (u.pn >= 4) sq += (v0[0] * v0[0] + v0[1] * v0[1]) + (v0[2] * v0[2] + v0[3] * v0[3]) + (v1[0] * v1[0] + v1[1] * v1[1]) + (v1[2] * v1[2] + v1[3] * v1[3]);
                        }
                        if (MODE == EP_ODD_IN) {
                            if (u.pn >= 12) {
#pragma unroll
                                for (int j = 0; j < 4; ++j) { v0[j] = silu_f(v0[j]); v1[j] = silu_f(v1[j]); }
                            }
                        }
                        if (MODE == EP_RES) {
                            { const u32x4_t rr = rres[m][bj];
                              v0[0] += bflo(rr[0]); v0[1] += bfhi(rr[0]); v0[2] += bflo(rr[1]); v0[3] += bfhi(rr[1]); v1[0] += bflo(rr[2]); v1[1] += bfhi(rr[2]); v1[2] += bflo(rr[3]); v1[3] += bfhi(rr[3]); }
                            sq += (v0[0] * v0[0] + v0[1] * v0[1]) + (v0[2] * v0[2] + v0[3] * v0[3]) + (v1[0] * v1[0] + v1[1] * v1[1]) + (v1[2] * v1[2] + v1[3] * v1[3]);
                        }
                        uint4 w;
                        w.x = cvt_pk_bf16(v0[0], v0[1]); w.y = cvt_pk_bf16(v0[2], v0[3]); w.z = cvt_pk_bf16(v1[0], v1[1]); w.w = cvt_pk_bf16(v1[2], v1[3]);
                        *(uint4*)(O + (size_t)row * ldo + col0) = w;
                    }
                    if (MODE == EP_RES) {
                        sq += __shfl_xor(sq, 16); sq += __shfl_xor(sq, 32);
                        if (fq == 0) ss_out[(size_t)row * 16 + u.pn * 4 + wc] = sq;
                    }
                    if (MODE == EP_EVEN_IN) {
                        if (u.pn >= 4) {
                            sq += __shfl_xor(sq, 16); sq += __shfl_xor(sq, 32);
                            if (fq == 0) ss_out[(size_t)row * 16 + (u.pn - 4) * 4 + wc] = sq;
                        }
                    }
                }
            }
            asm volatile("" ::: "memory");
        }
    }
};

#ifndef GEMM_ALIGN
#define GEMM_ALIGN true
#endif
#ifndef GEMM_SP2
#define GEMM_SP2 true
#endif
template <int MODE>
__device__ __forceinline__ void run_gemm(LAS unsigned char* lds, const bf16_t* A, const bf16_t* Bt, int M, int N, int K, const Epi<MODE>& E, int rot = 0) {
#if defined(T_ONLYMODE)
    if (MODE != T_ONLYMODE) return;
#endif
    pg8::Gemm g{A, Bt, M, N, K};
    pg8::StaticOrder S; S.init(M, N, (int)gridDim.x, (int)((blockIdx.x + rot) % gridDim.x));
    pg8::gemm_phase<Epi<MODE>, pg8::StaticOrder, GEMM_ALIGN, GEMM_SP2>(lds, g, S, E);
}

__device__ __forceinline__ void conv_weight(const float* W, const float* gain, bf16_t* Bt, int K, int Nsrc, int N, int mode, LAS float*) {
    const int tid = opaque_tid(), nkt = K / 64, nnt = N / 64;
    const int tx = tid & 63, kq = tid >> 6;
    for (int tix = blockIdx.x; tix < nkt * nnt; tix += gridDim.x) {
        const int kt = tix % nkt, ntl = tix / nkt, k0 = kt * 64 + kq * 8, np = ntl * 64 + tx;
        int src = np; float cs = 1.0f;
        if (mode == 1) { if (np < 512) cs = 0.125f; else if (np >= 2048 && np < 2560) cs = 0.08838834764831845f; }
        else if (mode == 2) cs = 0.0625f;
        else if (mode == 3) { const int pn = np >> 8, r = np & 255; src = (r < 128) ? (pn * 128 + r) : (DFF + pn * 128 + (r - 128)); }
        float v[8];
#pragma unroll
        for (int j = 0; j < 8; ++j) v[j] = W[(size_t)(k0 + j) * Nsrc + src];
        if (gain) {
            const float4 g0 = *(const float4*)(gain + k0), g1 = *(const float4*)(gain + k0 + 4);
            v[0] *= g0.x; v[1] *= g0.y; v[2] *= g0.z; v[3] *= g0.w; v[4] *= g1.x; v[5] *= g1.y; v[6] *= g1.z; v[7] *= g1.w;
        }
        uint4 w;
        w.x = cvt_pk_bf16(v[0] * cs, v[1] * cs); w.y = cvt_pk_bf16(v[2] * cs, v[3] * cs); w.z = cvt_pk_bf16(v[4] * cs, v[5] * cs); w.w = cvt_pk_bf16(v[6] * cs, v[7] * cs);
        *(uint4*)(Bt + (size_t)np * K + k0) = w;
    }
}

__device__ __forceinline__ void sincos_d(double a, float& s_out, float& c_out) {
    const double k = rint(a * 0.63661977236758134308);
    const double r = (a - k * 1.57079632679489655800) - k * 6.12323399573676603587e-17;
    const double r2 = r * r;
    double sp = -1.0 / 1307674368000.0;
    sp = sp * r2 + 1.0 / 6227020800.0; sp = sp * r2 - 1.0 / 39916800.0; sp = sp * r2 + 1.0 / 362880.0; sp = sp * r2 - 1.0 / 5040.0; sp = sp * r2 + 1.0 / 120.0; sp = sp * r2 - 1.0 / 6.0; sp = sp * r2 + 1.0;
    const double sn = sp * r;
    double cp = 1.0 / 20922789888000.0;
    cp = cp * r2 - 1.0 / 87178291200.0; cp = cp * r2 + 1.0 / 479001600.0; cp = cp * r2 - 1.0 / 3628800.0; cp = cp * r2 + 1.0 / 40320.0; cp = cp * r2 - 1.0 / 720.0; cp = cp * r2 + 1.0 / 24.0; cp = cp * r2 - 0.5; cp = cp * r2 + 1.0;
    const int q = ((int)k) & 3;
    double s, c;
    if (q == 0) { s = sn; c = cp; } else if (q == 1) { s = cp; c = -sn; } else if (q == 2) { s = -sn; c = -cp; } else { s = -cp; c = sn; }
    s_out = (float)s; c_out = (float)c;
}


constexpr int SRED_RSTD = 512;
constexpr int SRED_GEMV = 1024;
__device__ __forceinline__ void side_rstd(const float* v_t, int K, float inv_dim, LAS float* red) {
    const int tid = opaque_tid(), b = tid & 31, part = tid >> 5;
    float s = 0.f;
    float s1 = 0.f, s2 = 0.f, s3 = 0.f;
    for (int k = part; k < K; k += 128) {
        const float x0 = v_t[k * 32 + b], x1 = v_t[(k + 16) * 32 + b], x2 = v_t[(k + 32) * 32 + b], x3 = v_t[(k + 48) * 32 + b];
        const float x4 = v_t[(k + 64) * 32 + b], x5 = v_t[(k + 80) * 32 + b], x6 = v_t[(k + 96) * 32 + b], x7 = v_t[(k + 112) * 32 + b];
        s += x0 * x0 + x4 * x4; s1 += x1 * x1 + x5 * x5; s2 += x2 * x2 + x6 * x6; s3 += x3 * x3 + x7 * x7;
    }
    s = (s + s1) + (s2 + s3);
    red[tid] = s;
    __syncthreads();
    if (tid < 32) { float t = 0.f; for (int q = 0; q < 16; ++q) t += red[q * 32 + tid]; red[SRED_RSTD + tid] = rsqrtf(t * inv_dim + 1e-6f); }
    __syncthreads();
}
constexpr int SRED_IN = SRED_GEMV + 8 * 32 * 64;
template <class InF, class EpiF>
__device__ __forceinline__ void side_gemv(const float* W, int ldw, int K, int N, const InF& in, const EpiF& epi, LAS float* red) {
    const int tid = opaque_tid(), lane = tid & 63;
    const int kg = __builtin_amdgcn_readfirstlane(tid >> 6);
    const int ns = K >> 8;
    for (int c = blockIdx.x; c < (N >> 6); c += gridDim.x) {
        float acc[32];
#pragma unroll
        for (int b = 0; b < 32; ++b) acc[b] = 0.f;
        float xs[16];
        int t0 = tid; asm volatile("" : "+v"(t0));
#pragma unroll
        for (int i = 0; i < 16; ++i) { const int idx = t0 + 512 * i, k = idx >> 5; xs[i] = in.v(k, idx & 31, c) * in.ws(k); }
        __syncthreads();
#pragma unroll
        for (int i = 0; i < 16; ++i) red[SRED_IN + t0 + 512 * i] = xs[i];
        __syncthreads();
        for (int sl = 0; sl < ns; ++sl) {
            const int ks = sl << 8;
            LAS float* xin = red + SRED_IN + (sl & 1) * 8192;
            const float* wp = W + (size_t)(ks + 32 * kg) * ldw + c * 64 + lane;
            float w[32];
#pragma unroll
            for (int i = 0; i < 32; ++i) w[i] = wp[(size_t)i * ldw];
            LAS float* wl = red + SRED_GEMV + (kg * 32) * 64 + lane;
#pragma unroll
            for (int i = 0; i < 32; ++i) wl[i * 64] = w[i];
            asm volatile("" ::: "memory");
            int t1 = tid; asm volatile("" : "+v"(t1));
            if (sl + 1 < ns) {
#pragma unroll
                for (int i = 0; i < 16; ++i) { const int idx = t1 + 512 * i, k = ks + 256 + (idx >> 5); xs[i] = in.v(k, idx & 31, c) * in.ws(k); }
            }
#pragma unroll 1
            for (int k4 = 0; k4 < 8; ++k4) {
                const LAS f32x4* xv = (const LAS f32x4*)(xin + (32 * kg + k4 * 4) * 32);
                const float w0 = wl[(k4 * 4) * 64], w1 = wl[(k4 * 4 + 1) * 64], w2 = wl[(k4 * 4 + 2) * 64], w3 = wl[(k4 * 4 + 3) * 64];
#pragma unroll
                for (int q = 0; q < 8; ++q) {
                    const f32x4 x0 = xv[q], x1 = xv[8 + q], x2 = xv[16 + q], x3 = xv[24 + q];
                    acc[4 * q] += x0[0] * w0 + x1[0] * w1 + x2[0] * w2 + x3[0] * w3; acc[4 * q + 1] += x0[1] * w0 + x1[1] * w1 + x2[1] * w2 + x3[1] * w3;
                    acc[4 * q + 2] += x0[2] * w0 + x1[2] * w1 + x2[2] * w2 + x3[2] * w3; acc[4 * q + 3] += x0[3] * w0 + x1[3] * w1 + x2[3] * w2 + x3[3] * w3;
                }
            }
            if (sl + 1 < ns) {
                LAS float* xnx = red + SRED_IN + ((sl + 1) & 1) * 8192;
#pragma unroll
                for (int i = 0; i < 16; ++i) xnx[t1 + 512 * i] = xs[i];
            }
            __syncthreads();
        }
#pragma unroll
        for (int b = 0; b < 32; ++b) red[SRED_GEMV + (kg * 32 + b) * 64 + lane] = acc[b];
        __syncthreads();
#pragma unroll
        for (int i = 0; i < 4; ++i) {
            const int idx = tid + 512 * i, col = idx & 63, b = idx >> 6;
            float sum = 0.f;
#pragma unroll
            for (int g = 0; g < 8; ++g) sum += red[SRED_GEMV + (g * 32 + b) * 64 + col];
            epi(c * 64 + col, b, sum);
        }
        __syncthreads();
    }
}
template <class InF>
__device__ __forceinline__ void side_gemv_ks(const float* W, int ldw, int K, int N, const InF& in, float* h_t, LAS float* red) {
    const int tid = opaque_tid(), lane = tid & 63;
    const int kg = __builtin_amdgcn_readfirstlane(tid >> 6);
    const int ns = K >> 8, items = (N >> 6) * ns;
    for (int item = blockIdx.x; item < items; item += gridDim.x) {
        const int c = item / ns, ks = (item - c * ns) << 8;
        float xs[16];
        int t0 = tid; asm volatile("" : "+v"(t0));
#pragma unroll
        for (int i = 0; i < 16; ++i) { const int idx = t0 + 512 * i, k = ks + (idx >> 5); xs[i] = in.v(k, idx & 31, c) * in.ws(k); }
        float w[32];
        {
            const float* wp = W + (size_t)(ks + 32 * kg) * ldw + c * 64 + lane;
#pragma unroll
            for (int i = 0; i < 32; ++i) w[i] = wp[(size_t)i * ldw];
        }
        __syncthreads();
#pragma unroll
        for (int i = 0; i < 16; ++i) red[SRED_IN + t0 + 512 * i] = xs[i];
        LAS float* wl = red + SRED_GEMV + (kg * 32) * 64 + lane;
#pragma unroll
        for (int i = 0; i < 32; ++i) wl[i * 64] = w[i];
        __syncthreads();
        float acc[32];
#pragma unroll
        for (int b = 0; b < 32; ++b) acc[b] = 0.f;
        LAS float* xin = red + SRED_IN;
#pragma unroll 1
        for (int k4 = 0; k4 < 8; ++k4) {
            const LAS f32x4* xv = (const LAS f32x4*)(xin + (32 * kg + k4 * 4) * 32);
            const float w0 = wl[(k4 * 4) * 64], w1 = wl[(k4 * 4 + 1) * 64], w2 = wl[(k4 * 4 + 2) * 64], w3 = wl[(k4 * 4 + 3) * 64];
#pragma unroll
            for (int q = 0; q < 8; ++q) {
                const f32x4 x0 = xv[q], x1 = xv[8 + q], x2 = xv[16 + q], x3 = xv[24 + q];
                acc[4 * q] += x0[0] * w0 + x1[0] * w1 + x2[0] * w2 + x3[0] * w3; acc[4 * q + 1] += x0[1] * w0 + x1[1] * w1 + x2[1] * w2 + x3[1] * w3;
                acc[4 * q + 2] += x0[2] * w0 + x1[2] * w1 + x2[2] * w2 + x3[2] * w3; acc[4 * q + 3] += x0[3] * w0 + x1[3] * w1 + x2[3] * w2 + x3[3] * w3;
            }
        }
        __syncthreads();
#pragma unroll
        for (int b = 0; b < 32; ++b) red[SRED_GEMV + (kg * 32 + b) * 64 + lane] = acc[b];
        __syncthreads();
#pragma unroll
        for (int i = 0; i < 4; ++i) {
            const int idx = tid + 512 * i, col = idx & 63, b = idx >> 6;
            float sum = 0.f;
#pragma unroll
            for (int g = 0; g < 8; ++g) sum += red[SRED_GEMV + (g * 32 + b) * 64 + col];
            atomicAdd(h_t + (c * 64 + col) * 32 + b, sum);
        }
        __syncthreads();
    }
}
struct InPlain { const float* v_t; const float* gain; __device__ __forceinline__ float ws(int k) const { return gain ? gain[k] : 1.0f; } __device__ __forceinline__ float v(int k, int b, int) const { return v_t[k * 32 + b]; } };
struct InSgu { const float* z_t; const float* sgu_w; const float* sgu_b; const float* sgu_norm; const LAS float* rstdv;
    __device__ __forceinline__ float ws(int) const { return 1.0f; }
    __device__ __forceinline__ float v(int k, int b, int) const { const int g = k >> 7; return z_t[k * 32 + b] * (sgu_w[(size_t)g * 16384] * z_t[(512 + k) * 32 + b] * rstdv[b] * sgu_norm[k] + sgu_b[g * 128]); } };
struct InHead { const float* t_t; __device__ __forceinline__ float ws(int) const { return 1.0f; } __device__ __forceinline__ float v(int k, int b, int c) const { return t_t[((size_t)(c >> 2) * 1024 + k) * 32 + b]; } };
struct InSwiglu { const float* z_t; __device__ __forceinline__ float ws(int) const { return 1.0f; } __device__ __forceinline__ float v(int k, int b, int) const { return silu_f(z_t[k * 32 + b]) * z_t[(DFF + k) * 32 + b]; } };
struct EpStore { float* o_t; const LAS float* rstd; float scale; int act;
    __device__ __forceinline__ void operator()(int n, int b, float s) const { float v = s * scale * (rstd ? rstd[b] : 1.0f); if (act == 1) v = gelu_tanh_f(v); o_t[n * 32 + b] = v; } };
struct EpAdd { float* h_t; __device__ __forceinline__ void operator()(int n, int b, float s) const { h_t[n * 32 + b] += s; } };


__device__ __forceinline__ void xattn_phase(LAS unsigned char* lds, bf16_t* Yq, const bf16_t* Kmat, const bf16_t* VT) {
    const int tid = opaque_tid(), lane = tid & 63, r = lane & 15, qp = lane >> 4;
    const int wave = __builtin_amdgcn_readfirstlane(tid >> 6);
    constexpr int KS = 528;
    for (int trip = 0;; ++trip) {
        const int unit = xcd_unit(trip, 1024);
        if (unit < 0) break;
        const int b = unit >> 5, h = (unit >> 3) & 3, qb = unit & 7;
        __syncthreads();
        int tk = tid; asm volatile("" : "+v"(tk));
#pragma unroll
        for (int half = 0; half < 2; ++half) {
            u32x4_t tv[8];
#pragma unroll
            for (int i = 0; i < 8; ++i) { const int c = tk + 512 * (half * 8 + i), row = c >> 5, ch = c & 31; tv[i] = *(const u32x4_t*)(Kmat + (size_t)(b * 256 + row) * 1024 + h * 256 + ch * 8); }
#pragma unroll
            for (int i = 0; i < 8; ++i) { const int c = tk + 512 * (half * 8 + i), row = c >> 5, ch = c & 31; *(LAS u32x4_t*)(lds + row * KS + ch * 16) = tv[i]; }
        }
        __syncthreads();
        const int q0 = b * 2048 + qb * 256 + wave * 32;
        bf16x8_t pf[2][8];
        float inv[2];
        {
            f32x4 sacc[2][16];
#pragma unroll
            for (int kt = 0; kt < 16; ++kt) { sacc[0][kt] = (f32x4){0.f, 0.f, 0.f, 0.f}; sacc[1][kt] = (f32x4){0.f, 0.f, 0.f, 0.f}; }
            const bf16_t* qrow = Yq + (size_t)(q0 + r) * 1024 + h * 256 + qp * 8;
            const LAS unsigned char* kb = lds + r * KS + qp * 16; const LAS unsigned char* kb2 = kb + 8 * 16 * KS; asm volatile("" : "+v"(kb2));
            bf16x8_t qa = *(const bf16x8_t*)qrow, qb = *(const bf16x8_t*)(qrow + 16 * 1024);
#pragma unroll
            for (int ks = 0; ks < 8; ++ks) {
                const bf16x8_t qf0 = qa, qf1 = qb;
                if (ks < 7) { qa = *(const bf16x8_t*)(qrow + (ks + 1) * 32); qb = *(const bf16x8_t*)(qrow + 16 * 1024 + (ks + 1) * 32); }
#pragma unroll
                for (int kt = 0; kt < 16; ++kt) {
                    const bf16x8_t a = *(const LAS bf16x8_t*)((kt < 8 ? kb : kb2) + (kt & 7) * 16 * KS + ks * 64);
                    sacc[0][kt] = __builtin_amdgcn_mfma_f32_16x16x32_bf16(a, qf0, sacc[0][kt], 0, 0, 0);
                    sacc[1][kt] = __builtin_amdgcn_mfma_f32_16x16x32_bf16(a, qf1, sacc[1][kt], 0, 0, 0);
                }
            }
#pragma unroll
            for (int qt = 0; qt < 2; ++qt) {
                float mx = -INFINITY;
#pragma unroll
                for (int kt = 0; kt < 16; ++kt) mx = fmaxf(mx, fmaxf(fmaxf(sacc[qt][kt][0], sacc[qt][kt][1]), fmaxf(sacc[qt][kt][2], sacc[qt][kt][3])));
                mx = fmaxf(mx, __shfl_xor(mx, 16)); mx = fmaxf(mx, __shfl_xor(mx, 32));
                float sum = 0.f;
#pragma unroll
                for (int kt = 0; kt < 16; ++kt) {
#pragma unroll
                    for (int j = 0; j < 4; ++j) { const float e = __builtin_amdgcn_exp2f((sacc[qt][kt][j] - mx) * 1.4426950408889634f); sacc[qt][kt][j] = e; sum += e; }
                }
                sum += __shfl_xor(sum, 16); sum += __shfl_xor(sum, 32);
                inv[qt] = 1.0f / sum;
#pragma unroll
                for (int u = 0; u < 8; ++u) {
                    u32x4_t w;
                    w[0] = cvt_pk_bf16(sacc[qt][2 * u][0], sacc[qt][2 * u][1]); w[1] = cvt_pk_bf16(sacc[qt][2 * u][2], sacc[qt][2 * u][3]);
                    w[2] = cvt_pk_bf16(sacc[qt][2 * u + 1][0], sacc[qt][2 * u + 1][1]); w[3] = cvt_pk_bf16(sacc[qt][2 * u + 1][2], sacc[qt][2 * u + 1][3]);
                    pf[qt][u] = __builtin_bit_cast(bf16x8_t, w);
                }
            }
        }
        __syncthreads();
        int tv2 = tid; asm volatile("" : "+v"(tv2));
#pragma unroll 1
        for (int qd = 0; qd < 4; ++qd) {
            u32x4_t tv[4];
#pragma unroll
            for (int i = 0; i < 4; ++i) { const int c = tv2 + 512 * (qd * 4 + i), row = c >> 5, ch = c & 31; tv[i] = *(const u32x4_t*)(VT + (size_t)(h * 256 + row) * MROWS + b * 256 + ch * 8); }
#pragma unroll
            for (int i = 0; i < 4; ++i) { const int c = tv2 + 512 * (qd * 4 + i), row = c >> 5, ch = c & 31; *(LAS u32x4_t*)(lds + (((row & 15) << 4) | (row >> 4)) * KS + ch * 16) = tv[i]; }
        }
        __syncthreads();
        {
            f32x4 oacc[2][16];
#pragma unroll
            for (int nt = 0; nt < 16; ++nt) { oacc[0][nt] = (f32x4){0.f, 0.f, 0.f, 0.f}; oacc[1][nt] = (f32x4){0.f, 0.f, 0.f, 0.f}; }
            const LAS unsigned char* vb = lds + r * KS + qp * 8; const LAS unsigned char* vb2 = vb + 8 * 16 * KS; asm volatile("" : "+v"(vb2));
#pragma unroll
            for (int u = 0; u < 8; ++u)
#pragma unroll
                for (int nt = 0; nt < 16; ++nt) {
                    const LAS unsigned char* bp = (nt < 8 ? vb : vb2) + (nt & 7) * 16 * KS + u * 64;
                    const u32x2_t lo = *(const LAS u32x2_t*)bp, hi = *(const LAS u32x2_t*)(bp + 32);
                    u32x4_t w; w[0] = lo[0]; w[1] = lo[1]; w[2] = hi[0]; w[3] = hi[1];
                    const bf16x8_t bv = __builtin_bit_cast(bf16x8_t, w);
                    oacc[0][nt] = __builtin_amdgcn_mfma_f32_16x16x32_bf16(pf[0][u], bv, oacc[0][nt], 0, 0, 0);
                    oacc[1][nt] = __builtin_amdgcn_mfma_f32_16x16x32_bf16(pf[1][u], bv, oacc[1][nt], 0, 0, 0);
                }
            int r2 = r, qp2 = qp; asm volatile("" : "+v"(r2), "+v"(qp2));
#pragma unroll
            for (int qt = 0; qt < 2; ++qt)
#pragma unroll
                for (int j = 0; j < 4; ++j) {
                    const float is = __shfl(inv[qt], qp2 * 4 + j);
                    bf16_t* op = Yq + (size_t)(q0 + qt * 16 + qp2 * 4 + j) * 1024 + h * 256 + r2 * 16;
                    u32x4_t w0, w1;
#pragma unroll
                    for (int e = 0; e < 4; ++e) { w0[e] = cvt_pk_bf16(oacc[qt][2 * e][j] * is, oacc[qt][2 * e + 1][j] * is); w1[e] = cvt_pk_bf16(oacc[qt][8 + 2 * e][j] * is, oacc[qt][9 + 2 * e][j] * is); }
                    *(u32x4_t*)op = w0; *(u32x4_t*)(op + 8) = w1;
                }
        }
    }
    __syncthreads();
}

constexpr int RP = 272;
constexpr int RTILE = 128 * RP;
__device__ __forceinline__ float ret_lg2(int h) { return log2f(1.0f - exp2f(-5.0f - (float)h)); }
template <int TR>
__device__ __forceinline__ void ret_stage_rot(LAS unsigned char* dst, const bf16_t* Z1, int tok0, int col0, const float* TAB, float lg2, float sgn, int tid) {
    for (int it = tid; it < 1024; it += 512) {
        const int row = TR ? (it & 127) : (it >> 3), c8 = TR ? ((it >> 7) * 8) : ((it & 7) * 8);
        const bf16_t* zp = Z1 + (size_t)(tok0 + row) * ODD_IN + col0 + c8;
        const u32x4_t a = *(const u32x4_t*)zp, bq = *(const u32x4_t*)(zp + 64);
        const int pos = (tok0 + row) & 2047;
        const float4 c0 = *(const float4*)(TAB + TAB_RC + pos * 64 + c8), c1 = *(const float4*)(TAB + TAB_RC + pos * 64 + c8 + 4);
        const float4 s0 = *(const float4*)(TAB + TAB_RS + pos * 64 + c8), s1 = *(const float4*)(TAB + TAB_RS + pos * 64 + c8 + 4);
        const float sc = exp2f(sgn * (float)(row + 1) * lg2);
        const float x1[8] = {bflo(a[0]), bfhi(a[0]), bflo(a[1]), bfhi(a[1]), bflo(a[2]), bfhi(a[2]), bflo(a[3]), bfhi(a[3])};
        const float x2[8] = {bflo(bq[0]), bfhi(bq[0]), bflo(bq[1]), bfhi(bq[1]), bflo(bq[2]), bfhi(bq[2]), bflo(bq[3]), bfhi(bq[3])};
        const float cs[8] = {c0.x, c0.y, c0.z, c0.w, c1.x, c1.y, c1.z, c1.w};
        const float sn[8] = {s0.x, s0.y, s0.z, s0.w, s1.x, s1.y, s1.z, s1.w};
        float o1[8], o2[8];
#pragma unroll
        for (int e = 0; e < 8; ++e) { o1[e] = (x1[e] * cs[e] - x2[e] * sn[e]) * sc; o2[e] = (x1[e] * sn[e] + x2[e] * cs[e]) * sc; }
        if (TR == 0) {
            u32x4_t w1, w2;
#pragma unroll
            for (int e = 0; e < 4; ++e) { w1[e] = cvt_pk_bf16(o1[2 * e], o1[2 * e + 1]); w2[e] = cvt_pk_bf16(o2[2 * e], o2[2 * e + 1]); }
            *(LAS u32x4_t*)(dst + row * RP + c8 * 2) = w1; *(LAS u32x4_t*)(dst + row * RP + (64 + c8) * 2) = w2;
        } else {
#pragma unroll
            for (int e = 0; e < 8; ++e) {
                const int d1 = c8 + e, d2 = 64 + c8 + e;
                *(LAS unsigned short*)(dst + ((d1 & 7) * 16 + (d1 >> 3)) * RP + row * 2) = f2bf(o1[e]); *(LAS unsigned short*)(dst + ((d2 & 7) * 16 + (d2 >> 3)) * RP + row * 2) = f2bf(o2[e]);
            }
        }
    }
}
template <int PERM8>
__device__ __forceinline__ void stage_tr128(LAS unsigned char* dst, const bf16_t* src, int ld, int tok0, int col0, int tid) {
    for (int it = tid; it < 2048; it += 512) {
        const int row = it & 127, c8 = (it >> 7) * 8;
        const u32x4_t a = *(const u32x4_t*)(src + (size_t)(tok0 + row) * ld + col0 + c8);
#pragma unroll
        for (int e = 0; e < 4; ++e) {
            const int e0 = c8 + 2 * e, e1 = e0 + 1;
            *(LAS unsigned short*)(dst + (PERM8 ? ((e0 & 7) * 16 + (e0 >> 3)) : e0) * RP + row * 2) = (unsigned short)(a[e] & 0xffffu);
            *(LAS unsigned short*)(dst + (PERM8 ? ((e1 & 7) * 16 + (e1 >> 3)) : e1) * RP + row * 2) = (unsigned short)(a[e] >> 16);
        }
    }
}
__device__ __forceinline__ void ret_r1(LAS unsigned char* lds, const bf16_t* Z1, const float* TAB, bf16_t* RET) {
    const int tid = opaque_tid(), lane = tid & 63, r = lane & 15, qp = lane >> 4;
    const int wave = __builtin_amdgcn_readfirstlane(tid >> 6);
    LAS unsigned char* KT = lds; LAS unsigned char* VTL = lds + RTILE;
    for (int unit = blockIdx.x; unit < 2048; unit += gridDim.x) {
        const int b = unit >> 6, h = (unit >> 4) & 3, n = unit & 15, tok0 = b * 2048 + n * 128;
        const float lg2 = ret_lg2(h);
        __syncthreads();
        ret_stage_rot<1>(KT, Z1, tok0, 2048 + h * 128, TAB, lg2, -1.0f, tid);
        stage_tr128<0>(VTL, Z1, ODD_IN, tok0, 2560 + h * 128, tid);
        __syncthreads();
        f32x4 acc[8];
#pragma unroll
        for (int nt = 0; nt < 8; ++nt) acc[nt] = (f32x4){0.f, 0.f, 0.f, 0.f};
#pragma unroll
        for (int ks = 0; ks < 4; ++ks) {
            const bf16x8_t a = *(const LAS bf16x8_t*)(VTL + (16 * wave + r) * RP + (32 * ks + 8 * qp) * 2);
#pragma unroll
            for (int nt = 0; nt < 8; ++nt) {
                const bf16x8_t bv = *(const LAS bf16x8_t*)(KT + (16 * nt + r) * RP + (32 * ks + 8 * qp) * 2);
                acc[nt] = __builtin_amdgcn_mfma_f32_16x16x32_bf16(a, bv, acc[nt], 0, 0, 0);
            }
        }
        const float g128 = exp2f(128.0f * lg2);
        bf16_t* op = RET + (size_t)unit * 16384;
#pragma unroll
        for (int j = 0; j < 4; ++j) {
            u32x4_t w;
#pragma unroll
            for (int e = 0; e < 4; ++e) w[e] = cvt_pk_bf16(acc[2 * e][j] * g128, acc[2 * e + 1][j] * g128);
            *(u32x4_t*)(op + (16 * wave + 4 * qp + j) * 128 + 8 * r) = w;
        }
    }
    __syncthreads();
}
__device__ __forceinline__ void ret_r2(bf16_t* RET) {
    const int tid = opaque_tid();
    for (int idx = blockIdx.x * 512 + tid; idx < 128 * 8192; idx += gridDim.x * 512) {
        const int bh = idx >> 13, pr = idx & 8191;
        const float g128 = exp2f(128.0f * ret_lg2(bh & 3));
        unsigned* p = (unsigned*)(RET + (size_t)bh * 16 * 16384) + pr;
        unsigned v[16];
#pragma unroll
        for (int n = 0; n < 16; ++n) v[n] = p[(size_t)n * 8192];
        float s0 = 0.f, s1 = 0.f;
#pragma unroll
        for (int n = 0; n < 16; ++n) {
            p[(size_t)n * 8192] = cvt_pk_bf16(s0, s1);
            s0 = s0 * g128 + bflo(v[n]); s1 = s1 * g128 + bfhi(v[n]);
        }
    }
}
__device__ __forceinline__ void ret_r3(LAS unsigned char* lds, const bf16_t* Z1, const float* TAB, const bf16_t* RET, const float* SDZ, bf16_t* Yo) {
    const int tid = opaque_tid(), lane = tid & 63, r = lane & 15, qp = lane >> 4;
    const int wave = __builtin_amdgcn_readfirstlane(tid >> 6);
    LAS unsigned char* QL = lds; LAS unsigned char* KL = lds + RTILE; LAS unsigned char* VTL = lds + 2 * RTILE; LAS unsigned char* PL = lds + 3 * RTILE;
    for (int unit = blockIdx.x; unit < 2048; unit += gridDim.x) {
        const int b = unit >> 6, h = (unit >> 4) & 3, n = unit & 15, tok0 = b * 2048 + n * 128;
        const float lg2 = ret_lg2(h);
        __syncthreads();
        ret_stage_rot<0>(QL, Z1, tok0, 1536 + h * 128, TAB, lg2, 1.0f, tid);
        ret_stage_rot<0>(KL, Z1, tok0, 2048 + h * 128, TAB, lg2, -1.0f, tid);
        stage_tr128<1>(VTL, Z1, ODD_IN, tok0, 2560 + h * 128, tid);
        for (int it = tid; it < 2048; it += 512) { const int row = it >> 4, c8 = (it & 15) * 8; *(LAS u32x4_t*)(PL + ((row & 7) * 16 + (row >> 3)) * RP + c8 * 2) = *(const u32x4_t*)(RET + (size_t)unit * 16384 + row * 128 + c8); }
        __syncthreads();
        bf16x8_t qf[4];
#pragma unroll
        for (int ks = 0; ks < 4; ++ks) qf[ks] = *(const LAS bf16x8_t*)(QL + (16 * wave + r) * RP + (32 * ks + 8 * qp) * 2);
        f32x4 sacc[8];
#pragma unroll
        for (int jt = 0; jt < 8; ++jt) {
            sacc[jt] = (f32x4){0.f, 0.f, 0.f, 0.f};
            if (jt <= wave) {
#pragma unroll
                for (int ks = 0; ks < 4; ++ks) {
                    const bf16x8_t a = *(const LAS bf16x8_t*)(KL + (16 * jt + r) * RP + (32 * ks + 8 * qp) * 2);
                    sacc[jt] = __builtin_amdgcn_mfma_f32_16x16x32_bf16(a, qf[ks], sacc[jt], 0, 0, 0);
                }
#pragma unroll
                for (int j = 0; j < 4; ++j) if (16 * jt + 4 * qp + j > 16 * wave + r) sacc[jt][j] = 0.f;
            }
        }
        if (n == 0 && wave == 0) {
            const float* zq = SDZ + (size_t)(h * 128) * 32 + b;
            const float c = wave_sum(zq[lane * 32] * zq[(512 + lane) * 32] + zq[(lane + 64) * 32] * zq[(512 + lane + 64) * 32]) * 0.08838834764831845f;
            if (lane == 0) sacc[0][0] = c;
        }
        bf16x8_t pf[4];
#pragma unroll
        for (int u = 0; u < 4; ++u) {
            u32x4_t w;
            w[0] = cvt_pk_bf16(sacc[2 * u][0], sacc[2 * u][1]); w[1] = cvt_pk_bf16(sacc[2 * u][2], sacc[2 * u][3]);
            w[2] = cvt_pk_bf16(sacc[2 * u + 1][0], sacc[2 * u + 1][1]); w[3] = cvt_pk_bf16(sacc[2 * u + 1][2], sacc[2 * u + 1][3]);
            pf[u] = __builtin_bit_cast(bf16x8_t, w);
        }
        f32x4 oacc[8];
#pragma unroll
        for (int nt = 0; nt < 8; ++nt) oacc[nt] = (f32x4){0.f, 0.f, 0.f, 0.f};
#pragma unroll
        for (int u = 0; u < 4; ++u) {
            if (2 * u <= wave) {
#pragma unroll
                for (int nt = 0; nt < 8; ++nt) {
                    const LAS unsigned char* bp = VTL + (16 * nt + r) * RP + (32 * u + 4 * qp) * 2;
                    const u32x2_t lo = *(const LAS u32x2_t*)bp, hi = *(const LAS u32x2_t*)(bp + 32);
                    u32x4_t w; w[0] = lo[0]; w[1] = lo[1]; w[2] = hi[0]; w[3] = hi[1];
                    oacc[nt] = __builtin_amdgcn_mfma_f32_16x16x32_bf16(pf[u], __builtin_bit_cast(bf16x8_t, w), oacc[nt], 0, 0, 0);
                }
            }
        }
#pragma unroll
        for (int ks = 0; ks < 4; ++ks)
#pragma unroll
            for (int nt = 0; nt < 8; ++nt) {
                const bf16x8_t bv = *(const LAS bf16x8_t*)(PL + (16 * nt + r) * RP + (32 * ks + 8 * qp) * 2);
                oacc[nt] = __builtin_amdgcn_mfma_f32_16x16x32_bf16(qf[ks], bv, oacc[nt], 0, 0, 0);
            }
#pragma unroll
        for (int j = 0; j < 4; ++j) {
            float sm = 0.f;
#pragma unroll
            for (int nt = 0; nt < 8; ++nt) sm += oacc[nt][j];
            sm += __shfl_xor(sm, 1); sm += __shfl_xor(sm, 2); sm += __shfl_xor(sm, 4); sm += __shfl_xor(sm, 8);
            const float mu = sm * (1.0f / 128.0f);
            float vr = 0.f;
#pragma unroll
            for (int nt = 0; nt < 8; ++nt) { const float d = oacc[nt][j] - mu; vr += d * d; }
            vr += __shfl_xor(vr, 1); vr += __shfl_xor(vr, 2); vr += __shfl_xor(vr, 4); vr += __shfl_xor(vr, 8);
            const float rs = rsqrtf(vr * (1.0f / 128.0f) + 1e-6f);
            const size_t tok = (size_t)(tok0 + 16 * wave + 4 * qp + j);
            const u32x4_t gg = *(const u32x4_t*)(Z1 + tok * ODD_IN + 3072 + h * 128 + 8 * r);
            u32x4_t w;
#pragma unroll
            for (int e = 0; e < 4; ++e) w[e] = cvt_pk_bf16(bflo(gg[e]) * (oacc[2 * e][j] - mu) * rs, bfhi(gg[e]) * (oacc[2 * e + 1][j] - mu) * rs);
            *(u32x4_t*)(Yo + tok * 1024 + 512 + h * 128 + 8 * r) = w;
        }
    }
    __syncthreads();
}

constexpr int DKP = 144;
constexpr int DVP = 592;
constexpr int DK_BYTES = 256 * DKP;
#define DIL_DECODE(u) const int b = (u) / 384, v = (u) - b * 384, h = v / 48, v2 = v - h * 48, g = v2 >> 4, rb = v2 & 15; \
    const int lognb = 4 - 2 * g, dil = 1 << (2 * g), nbi = rb & ((1 << lognb) - 1), res = rb >> lognb; const int tokb = b * 2048
#define DIL_ISSUE(u) do { DIL_DECODE(u); const int row_ = (wave & 3) * 64 + lane, hh_ = wave >> 2; const int j_ = 128 * nbi - 128 + row_; validr = j_ >= 0; const int pos_ = validr ? j_ * dil + res : 0; \
    const bf16_t* zr_ = Z1 + (size_t)(tokb + pos_) * ODD_IN + h * 64 + hh_ * 32; \
    _Pragma("unroll") for (int i_ = 0; i_ < 4; ++i_) { kvr[i_] = *(const u32x4_t*)(zr_ + 512 + i_ * 8); vvr[i_] = *(const u32x4_t*)(zr_ + 1024 + i_ * 8); } \
    if (hh_ == 0) { const float* tc_ = TAB + TAB_DC + pos_ * 8; const float* ts_ = TAB + TAB_DS + pos_ * 8; kc0 = *(const float4*)tc_; kc1 = *(const float4*)(tc_ + 4); ks0 = *(const float4*)ts_; ks1 = *(const float4*)(ts_ + 4); } \
    const int qpos_ = (128 * nbi + 16 * wave + r) * dil + res; const bf16_t* qrow_ = Z1 + (size_t)(tokb + qpos_) * ODD_IN + h * 64 + qp * 8; \
    qr0 = *(const u32x4_t*)qrow_; qr1 = *(const u32x4_t*)(qrow_ + 32); \
    { const float* tc_ = TAB + TAB_DC + qpos_ * 8; const float* ts_ = TAB + TAB_DS + qpos_ * 8; qc0 = *(const float4*)tc_; qc1 = *(const float4*)(tc_ + 4); qs0 = *(const float4*)ts_; qs1 = *(const float4*)(ts_ + 4); } } while (0)
__device__ __forceinline__ void dil_units(LAS unsigned char* lds, const bf16_t* Z1, const float* TAB, bf16_t* OB01, bf16_t* Yo, float* LSE) {
    const int tid = opaque_tid(), lane = tid & 63, r = lane & 15, qp = lane >> 4;
    const int wave = __builtin_amdgcn_readfirstlane(tid >> 6);
    LAS unsigned char* KL = lds; LAS unsigned char* VTL = lds + DK_BYTES;
    __syncthreads();
    for (int i = tid; i < 64 * 16; i += 512) { const int d = i >> 4, c = i & 15; *(LAS unsigned*)(VTL + d * DVP + 512 + c * 4) = 0u; }
    u32x4_t kvr[4], vvr[4], qr0, qr1; float4 kc0, kc1, ks0, ks1, qc0, qc1, qs0, qs1; bool validr;
    kc0 = kc1 = ks0 = ks1 = make_float4(0.f, 0.f, 0.f, 0.f);
    int trip = 0, unit = xcd_unit(0, 12288);
    if (unit >= 0) DIL_ISSUE(unit);
    while (unit >= 0) {
        DIL_DECODE(unit);
        __syncthreads();
        {
            const int row = (wave & 3) * 64 + lane, hh = wave >> 2;
            u32x4_t kv[4], vv[4];
#pragma unroll
            for (int i = 0; i < 4; ++i) { kv[i] = validr ? kvr[i] : (u32x4_t){0u, 0u, 0u, 0u}; vv[i] = validr ? vvr[i] : (u32x4_t){0u, 0u, 0u, 0u}; }
#pragma unroll
            for (int i = 0; i < 4; ++i)
#pragma unroll
                for (int e = 0; e < 4; ++e) {
                    *(LAS unsigned short*)(VTL + ((hh * 4 + i) * 8 + 2 * e) * DVP + row * 2) = (unsigned short)(vv[i][e] & 0xffffu);
                    *(LAS unsigned short*)(VTL + ((hh * 4 + i) * 8 + 2 * e + 1) * DVP + row * 2) = (unsigned short)(vv[i][e] >> 16);
                }
            if (hh == 0) {
                const float cs[8] = {kc0.x, kc0.y, kc0.z, kc0.w, kc1.x, kc1.y, kc1.z, kc1.w}, sn[8] = {ks0.x, ks0.y, ks0.z, ks0.w, ks1.x, ks1.y, ks1.z, ks1.w};
                const u32x4_t k1 = kv[0], k2 = kv[1];
                const float x1[8] = {bflo(k1[0]), bfhi(k1[0]), bflo(k1[1]), bfhi(k1[1]), bflo(k1[2]), bfhi(k1[2]), bflo(k1[3]), bfhi(k1[3])};
                const float x2[8] = {bflo(k2[0]), bfhi(k2[0]), bflo(k2[1]), bfhi(k2[1]), bflo(k2[2]), bfhi(k2[2]), bflo(k2[3]), bfhi(k2[3])};
#pragma unroll
                for (int e = 0; e < 4; ++e) {
                    kv[0][e] = cvt_pk_bf16(x1[2 * e] * cs[2 * e] - x2[2 * e] * sn[2 * e], x1[2 * e + 1] * cs[2 * e + 1] - x2[2 * e + 1] * sn[2 * e + 1]);
                    kv[1][e] = cvt_pk_bf16(x1[2 * e] * sn[2 * e] + x2[2 * e] * cs[2 * e], x1[2 * e + 1] * sn[2 * e + 1] + x2[2 * e + 1] * cs[2 * e + 1]);
                }
            }
#pragma unroll
            for (int i = 0; i < 4; ++i) *(LAS u32x4_t*)(KL + row * DKP + (hh * 4 + i) * 16) = kv[i];
        }
        const int qi = 128 * nbi + 16 * wave + r, qpos = qi * dil + res;
        u32x4_t q0 = qr0; const u32x4_t q1 = qr1;
        {
            u32x4_t pr;
#pragma unroll
            for (int e = 0; e < 4; ++e) pr[e] = (unsigned)__shfl_xor((int)q0[e], 16);
            const float cs[8] = {qc0.x, qc0.y, qc0.z, qc0.w, qc1.x, qc1.y, qc1.z, qc1.w}, sn[8] = {qs0.x, qs0.y, qs0.z, qs0.w, qs1.x, qs1.y, qs1.z, qs1.w};
            const float own[8] = {bflo(q0[0]), bfhi(q0[0]), bflo(q0[1]), bfhi(q0[1]), bflo(q0[2]), bfhi(q0[2]), bflo(q0[3]), bfhi(q0[3])};
            const float oth[8] = {bflo(pr[0]), bfhi(pr[0]), bflo(pr[1]), bfhi(pr[1]), bflo(pr[2]), bfhi(pr[2]), bflo(pr[3]), bfhi(pr[3])};
            float o[8];
#pragma unroll
            for (int e = 0; e < 8; ++e) o[e] = (qp == 0) ? (own[e] * cs[e] - oth[e] * sn[e]) : (oth[e] * sn[e] + own[e] * cs[e]);
            if (qp < 2) {
#pragma unroll
                for (int e = 0; e < 4; ++e) q0[e] = cvt_pk_bf16(o[2 * e], o[2 * e + 1]);
            }
        }
        const bf16x8_t qf0 = __builtin_bit_cast(bf16x8_t, q0), qf1 = __builtin_bit_cast(bf16x8_t, q1);
        const int nxt = xcd_unit(++trip, 12288);
        if (nxt >= 0) DIL_ISSUE(nxt);
        __syncthreads();
        f32x4 sacc[9];
        const LAS unsigned char* kb = KL + (16 * wave + r) * DKP + qp * 16;
#pragma unroll
        for (int st = 0; st < 9; ++st) {
            const bf16x8_t a0 = *(const LAS bf16x8_t*)(kb + st * 16 * DKP), a1 = *(const LAS bf16x8_t*)(kb + st * 16 * DKP + 64);
            f32x4 acc = (f32x4){0.f, 0.f, 0.f, 0.f};
            acc = __builtin_amdgcn_mfma_f32_16x16x32_bf16(a0, qf0, acc, 0, 0, 0);
            acc = __builtin_amdgcn_mfma_f32_16x16x32_bf16(a1, qf1, acc, 0, 0, 0);
#pragma unroll
            for (int j = 0; j < 4; ++j) {
                const int dk = 16 * st + 4 * qp + j;
                const bool ok = (dk >= r) && (dk <= r + 128) && (nbi > 0 || 16 * wave + dk >= 128);
                acc[j] = ok ? acc[j] : -INFINITY;
            }
            sacc[st] = acc;
        }
        float mx = -INFINITY;
#pragma unroll
        for (int st = 0; st < 9; ++st) mx = fmaxf(mx, fmaxf(fmaxf(sacc[st][0], sacc[st][1]), fmaxf(sacc[st][2], sacc[st][3])));
        mx = fmaxf(mx, __shfl_xor(mx, 16)); mx = fmaxf(mx, __shfl_xor(mx, 32));
        float sum = 0.f;
#pragma unroll
        for (int st = 0; st < 9; ++st) {
#pragma unroll
            for (int j = 0; j < 4; ++j) { const float e = (sacc[st][j] == -INFINITY) ? 0.f : __expf(sacc[st][j] - mx); sacc[st][j] = e; sum += e; }
        }
        sum += __shfl_xor(sum, 16); sum += __shfl_xor(sum, 32);
        const float inv = 1.0f / sum;
        if (qp == 0) LSE[((size_t)g * T + tokb + qpos) * 8 + h] = mx + __logf(sum);
        f32x4 oacc[4];
#pragma unroll
        for (int nt = 0; nt < 4; ++nt) oacc[nt] = (f32x4){0.f, 0.f, 0.f, 0.f};
        const LAS unsigned char* vb = VTL + r * DVP + (16 * wave + 4 * qp) * 2;
#pragma unroll
        for (int u = 0; u < 5; ++u) {
            u32x4_t w;
            w[0] = cvt_pk_bf16(sacc[2 * u][0], sacc[2 * u][1]); w[1] = cvt_pk_bf16(sacc[2 * u][2], sacc[2 * u][3]);
            if (u < 4) { w[2] = cvt_pk_bf16(sacc[2 * u + 1][0], sacc[2 * u + 1][1]); w[3] = cvt_pk_bf16(sacc[2 * u + 1][2], sacc[2 * u + 1][3]); } else { w[2] = 0u; w[3] = 0u; }
            const bf16x8_t pfr = __builtin_bit_cast(bf16x8_t, w);
#pragma unroll
            for (int nt = 0; nt < 4; ++nt) {
                const LAS unsigned char* bp = vb + nt * 16 * DVP + u * 64;
                const u32x2_t lo = *(const LAS u32x2_t*)bp, hi = *(const LAS u32x2_t*)(bp + 32);
                u32x4_t bw; bw[0] = lo[0]; bw[1] = lo[1]; bw[2] = hi[0]; bw[3] = hi[1];
                oacc[nt] = __builtin_amdgcn_mfma_f32_16x16x32_bf16(pfr, __builtin_bit_cast(bf16x8_t, bw), oacc[nt], 0, 0, 0);
            }
        }
        bf16_t* ob = (g == 2) ? Yo : (OB01 + (size_t)g * T * 512);
        const int opitch = (g == 2) ? 1024 : 512;
#pragma unroll
        for (int j = 0; j < 4; ++j) {
            const float is = __shfl(inv, qp * 4 + j);
            const int tq = tokb + (128 * nbi + 16 * wave + 4 * qp + j) * dil + res;
            bf16_t* op = ob + (size_t)tq * opitch + h * 64 + r;
#pragma unroll
            for (int nt = 0; nt < 4; ++nt) op[16 * nt] = f2bf(oacc[nt][j] * is);
        }
        unit = nxt;
    }
    __syncthreads();
}
#undef DIL_ISSUE
#undef DIL_DECODE
__device__ __forceinline__ void dil_combine(const bf16_t* OB01, bf16_t* Yo, const float* LSE) {
    const int tid = opaque_tid();
    for (int idx = blockIdx.x * 512 + tid; idx < T * 64; idx += gridDim.x * 512) {
        const int t = idx >> 6, c8 = (idx & 63) * 8, h = c8 >> 6;
        const float l0 = LSE[((size_t)0 * T + t) * 8 + h], l1 = LSE[((size_t)1 * T + t) * 8 + h], l2 = LSE[((size_t)2 * T + t) * 8 + h];
        const float m = fmaxf(l0, fmaxf(l1, l2));
        float w0 = __expf(l0 - m), w1 = __expf(l1 - m), w2 = __expf(l2 - m);
        const float is = 1.0f / (w0 + w1 + w2); w0 *= is; w1 *= is; w2 *= is;
        const u32x4_t a = *(const u32x4_t*)(OB01 + (size_t)t * 512 + c8), bq = *(const u32x4_t*)(OB01 + (size_t)T * 512 + (size_t)t * 512 + c8), c = *(const u32x4_t*)(Yo + (size_t)t * 1024 + c8);
        u32x4_t o;
#pragma unroll
        for (int e = 0; e < 4; ++e) o[e] = cvt_pk_bf16(w0 * bflo(a[e]) + w1 * bflo(bq[e]) + w2 * bflo(c[e]), w0 * bfhi(a[e]) + w1 * bfhi(bq[e]) + w2 * bfhi(c[e]));
        *(u32x4_t*)(Yo + (size_t)t * 1024 + c8) = o;
    }
}

constexpr size_t TABB_WSB = 1280 * 1024, TABB_PWT = TABB_WSB + 4 * 128 * 128 * 2;
constexpr int EM_AL = RTILE, EM_DL = RTILE + 144 * RP;
__device__ __forceinline__ void even_mix_units(LAS unsigned char* lds, const bf16_t* Z0, const float* ssv, const bf16_t* WSB, const bf16_t* PWT, const float* sgu_norm, const float* sgu_b, bf16_t* Yo) {
    const int tid = opaque_tid(), lane = tid & 63, r = lane & 15, qp = lane >> 4;
    const int wave = __builtin_amdgcn_readfirstlane(tid >> 6);
    LAS unsigned char* VT = lds; LAS unsigned char* AL = lds + EM_AL; LAS unsigned char* DL = lds + EM_DL;
    for (int unit = blockIdx.x; unit < 2048; unit += gridDim.x) {
        const int chunk = unit >> 2, g = unit & 3, tok0 = chunk * 128, pos0 = tok0 & 2047, win = 2 << g;
        __syncthreads();
        for (int it = tid; it < 2048; it += 512) {
            const int row = it & 127, c8 = (it >> 7) * 8;
            const float rs = row_rstd(ssv, 8, tok0 + row, 1.0f / 512.0f);
            const u32x4_t a = *(const u32x4_t*)(Z0 + (size_t)(tok0 + row) * EVEN_IN + 1024 + g * 128 + c8);
#pragma unroll
            for (int e = 0; e < 4; ++e) {
                *(LAS unsigned short*)(VT + (c8 + 2 * e) * RP + row * 2) = f2bf(bflo(a[e]) * rs);
                *(LAS unsigned short*)(VT + (c8 + 2 * e + 1) * RP + row * 2) = f2bf(bfhi(a[e]) * rs);
            }
        }
        for (int it = tid; it < 143 * 16; it += 512) {
            const int rr = it >> 4, c8 = (it & 15) * 8;
            const bool valid = pos0 - 15 + rr >= 0;
            u32x4_t a = *(const u32x4_t*)(Z0 + (size_t)(valid ? tok0 - 15 + rr : tok0) * EVEN_IN + g * 128 + c8);
            if (!valid) a = (u32x4_t){0u, 0u, 0u, 0u};
            *(LAS u32x4_t*)(AL + rr * RP + c8 * 2) = a;
        }
        __syncthreads();
        for (int it = tid; it < 2048; it += 512) {
            const int t = it >> 4, c8 = (it & 15) * 8;
            float sum[8];
#pragma unroll
            for (int e = 0; e < 8; ++e) sum[e] = 0.f;
            for (int jj = 0; jj < win; ++jj) {
                const u32x4_t a = *(const LAS u32x4_t*)(AL + (t + 15 - jj) * RP + c8 * 2);
#pragma unroll
                for (int e = 0; e < 4; ++e) { sum[2 * e] += bflo(a[e]); sum[2 * e + 1] += bfhi(a[e]); }
            }
            const u32x4_t cur = *(const LAS u32x4_t*)(AL + (t + 15) * RP + c8 * 2);
            const float ic = 1.0f / (float)min(pos0 + t + 1, win);
            u32x4_t w;
#pragma unroll
            for (int e = 0; e < 4; ++e) w[e] = cvt_pk_bf16(sum[2 * e] * ic - bflo(cur[e]), sum[2 * e + 1] * ic - bfhi(cur[e]));
            *(LAS u32x4_t*)(DL + t * RP + c8 * 2) = w;
        }
        __syncthreads();
        {
            f32x4 acc[8];
#pragma unroll
            for (int nt = 0; nt < 8; ++nt) acc[nt] = (f32x4){0.f, 0.f, 0.f, 0.f};
#pragma unroll
            for (int ks = 0; ks < 4; ++ks) {
                if (32 * ks <= 16 * wave + 15) {
                    const bf16x8_t a = *(const bf16x8_t*)(WSB + (size_t)g * 16384 + (16 * wave + r) * 128 + 32 * ks + 8 * qp);
#pragma unroll
                    for (int nt = 0; nt < 8; ++nt) {
                        const bf16x8_t bv = *(const LAS bf16x8_t*)(VT + (16 * nt + r) * RP + (32 * ks + 8 * qp) * 2);
                        acc[nt] = __builtin_amdgcn_mfma_f32_16x16x32_bf16(a, bv, acc[nt], 0, 0, 0);
                    }
                }
            }
#pragma unroll
            for (int j = 0; j < 4; ++j) {
                const int t = 16 * wave + 4 * qp + j;
                const float bb = sgu_b[g * 128 + t];
                const bf16_t* up = Z0 + (size_t)(tok0 + t) * EVEN_IN + 512 + g * 128 + r;
                bf16_t* yp = Yo + (size_t)(tok0 + t) * 1024 + 512 + g * 128 + r;
#pragma unroll
                for (int nt = 0; nt < 8; ++nt) yp[16 * nt] = f2bf(bf2f(up[16 * nt]) * (acc[nt][j] * sgu_norm[g * 128 + 16 * nt + r] + bb));
            }
        }
        {
            f32x4 acc[8];
#pragma unroll
            for (int nt = 0; nt < 8; ++nt) acc[nt] = (f32x4){0.f, 0.f, 0.f, 0.f};
#pragma unroll
            for (int ks = 0; ks < 4; ++ks) {
                const bf16x8_t a = *(const LAS bf16x8_t*)(DL + (16 * wave + r) * RP + (32 * ks + 8 * qp) * 2);
#pragma unroll
                for (int nt = 0; nt < 8; ++nt) {
                    const bf16x8_t bv = *(const bf16x8_t*)(PWT + (size_t)g * 16384 + (16 * nt + r) * 128 + 32 * ks + 8 * qp);
                    acc[nt] = __builtin_amdgcn_mfma_f32_16x16x32_bf16(a, bv, acc[nt], 0, 0, 0);
                }
            }
#pragma unroll
            for (int j = 0; j < 4; ++j) {
                bf16_t* yp = Yo + (size_t)(tok0 + 16 * wave + 4 * qp + j) * 1024 + g * 128 + r;
#pragma unroll
                for (int nt = 0; nt < 8; ++nt) yp[16 * nt] = f2bf(acc[nt][j]);
            }
        }
    }
    __syncthreads();
}
#define PHASE_IDS() const int tid = opaque_tid(), lane = tid & 63, wave = tid >> 6; const int gw = blockIdx.x * 8 + wave, nw = gridDim.x * 8; const int gt = blockIdx.x * 512 + tid, nt = gridDim.x * 512; (void)lane; (void)gw; (void)nw; (void)gt; (void)nt;
#include <vector>

#define XB_TMO      128
#define XB_XCNT(j)  (256  + 64 * (j))
#define XB_XSUB(j)  (1280 + 64 * (j))
#define XB_XGEN(j)  (2304 + 64 * (j))
#define XB_TOP      3328
#define XB_TOPGEN   3392
#define XCD_BAR_WORDS 3456
#define XB_SPIN_CAP (1u << 18)

__device__ __forceinline__ unsigned xb_ld(unsigned* p)              { return __hip_atomic_load(p, __ATOMIC_RELAXED, __HIP_MEMORY_SCOPE_AGENT); }
__device__ __forceinline__ unsigned xb_add(unsigned* p, unsigned v) { return __hip_atomic_fetch_add(p, v, __ATOMIC_RELAXED, __HIP_MEMORY_SCOPE_AGENT); }
__device__ __forceinline__ unsigned xb_xcc_id() { return (unsigned)__builtin_amdgcn_s_getreg((3 << 11) | 20) & 0xFu; }
#define XB_SPIN(cond, bar) do { unsigned _sp = 0; while (cond) { __builtin_amdgcn_s_sleep(1); \
    if ((++_sp & 255u) == 0u) { if (xb_ld(&(bar)[XB_TMO])) break; if (_sp > XB_SPIN_CAP) { atomicAdd(&(bar)[XB_TMO], 1u); break; } } } } while (0)

struct XcdBarrier {
    unsigned* bar; unsigned x;
    volatile LAS unsigned* st;
};

__device__ __forceinline__ XcdBarrier xcd_barrier_post(unsigned* bar, volatile LAS unsigned* st) {
    XcdBarrier b; b.bar = bar; b.x = xb_xcc_id(); b.st = st;
    if (threadIdx.x == 0) (void)xb_add(&bar[XB_XCNT(b.x)], 1u);
    return b;
}
__device__ __forceinline__ void xcd_barrier_complete(unsigned* bar, unsigned x, unsigned& nloc, unsigned& nx) {
    const unsigned G = gridDim.x * gridDim.y * gridDim.z;
    unsigned sum, cnt, mine, sp = 0u;
    for (;;) {
        sum = 0u; cnt = 0u; mine = 0u;
#pragma unroll
        for (unsigned j = 0; j < 16; ++j) { const unsigned c = xb_ld(&bar[XB_XCNT(j)]); sum += c; cnt += (c > 0u) ? 1u : 0u; mine = (j == x) ? c : mine; }
        if (sum == G) break;
        __builtin_amdgcn_s_sleep(1);
        if ((++sp & 255u) == 0u) { if (xb_ld(&bar[XB_TMO])) break; if (sp > XB_SPIN_CAP) { atomicAdd(&bar[XB_TMO], 1u); break; } }
    }
    nloc = mine > 0u ? mine : 1u; nx = cnt > 0u ? cnt : 1u;
}

__device__ __forceinline__ void xcd_barrier(const XcdBarrier& b) {
    asm volatile("s_waitcnt vmcnt(0)" ::: "memory");
    __syncthreads();
    if (threadIdx.x == 0) {
        unsigned* bar = b.bar;
        __builtin_amdgcn_s_waitcnt(0);
        unsigned nloc = b.st[0], nx = b.st[1];
        if (nloc == 0u) { xcd_barrier_complete(bar, b.x, nloc, nx); b.st[0] = nloc; b.st[1] = nx; }
        const unsigned old = xb_add(&bar[XB_XSUB(b.x)], 1u);
        const unsigned gen = old / nloc;
        if (old + 1u == (gen + 1u) * nloc) {
            __builtin_amdgcn_fence(__ATOMIC_RELEASE, "agent");
            asm volatile("s_waitcnt vmcnt(0)" ::: "memory");
            const unsigned og = xb_add(&bar[XB_TOP], 1u);
            const unsigned tg = og / nx;
            if (og + 1u == (tg + 1u) * nx) xb_add(&bar[XB_TOPGEN], 1u);
            else XB_SPIN(xb_ld(&bar[XB_TOPGEN]) == tg, bar);
            __builtin_amdgcn_fence(__ATOMIC_ACQUIRE, "agent");
            xb_add(&bar[XB_XGEN(b.x)], 1u);
            asm volatile("s_waitcnt vmcnt(0)" ::: "memory");
        } else {
            XB_SPIN(xb_ld(&bar[XB_XGEN(b.x)]) == gen, bar);
            __builtin_amdgcn_fence(__ATOMIC_ACQUIRE, "agent");
            asm volatile("s_waitcnt vmcnt(0)" ::: "memory");
        }
    }
    __syncthreads();
}


#ifndef REP_GEMM
#define REP_GEMM 1
#endif
#ifndef REP_EM
#define REP_EM 1
#endif
#ifndef REP_DIL
#define REP_DIL 1
#endif
#ifndef REP_R1
#define REP_R1 1
#endif
#ifndef REP_R3
#define REP_R3 1
#endif
#ifndef REP_PRO
#define REP_PRO 1
#endif
#ifndef REP_SYNC
#define REP_SYNC 1
#endif
#define GSYNC() do { for (int rep_ = 0; rep_ < REP_SYNC; ++rep_) xcd_barrier(xb); } while (0)
constexpr int LDS_BYTES = 144 * 1024;

__global__ void __launch_bounds__(512) fwd_mega(Params p) {
    __shared__ __attribute__((aligned(16))) unsigned char lds_raw[LDS_BYTES];
    LAS unsigned char* lds = (LAS unsigned char*)lds_raw;
    cg::grid_group grid = cg::this_grid();
    __shared__ uint4 xb_words;
    if (threadIdx.x == 0) xb_words = make_uint4(0u, 0u, 0u, 0u);
    __syncthreads();
    const XcdBarrier xb = xcd_barrier_post((unsigned*)(p.ws + WS_BAR), (volatile LAS unsigned*)&xb_words);
    const float* x = p.in[0]; const float* mem = p.in[1];
    const float* even_mix_norm = p.in[2]; const float* even_w_in = p.in[3]; const float* pool_w = p.in[4]; const float* pool_scale = p.in[5];
    const float* sgu_norm = p.in[6]; const float* sgu_w = p.in[7]; const float* sgu_b = p.in[8]; const float* even_w_out = p.in[9];
    const float* odd_mix_norm = p.in[10]; const float* odd_w_in = p.in[11]; const float* odd_w_out = p.in[12];
    const float* xattn_norm = p.in[13]; const float* mem_norm = p.in[14]; const float* xattn_wq = p.in[15]; const float* xattn_wkv = p.in[16]; const float* xattn_wo = p.in[17];
    const float* ffn_norm = p.in[18]; const float* ffn_w_gate_up = p.in[19]; const float* ffn_w_down = p.in[20]; const float* final_norm = p.in[21];
    float* H = p.out;
    bf16_t* HB = (bf16_t*)(p.ws + WS_HB); bf16_t* Z = (bf16_t*)(p.ws + WS_Z); bf16_t* Y = (bf16_t*)(p.ws + WS_Y); bf16_t* WB = (bf16_t*)(p.ws + WS_W);
    bf16_t* MEMN = (bf16_t*)(p.ws + WS_MEMN); bf16_t* KV = (bf16_t*)(p.ws + WS_KV); float* SS = (float*)(p.ws + WS_SS); float* TAB = (float*)(p.ws + WS_TAB); float* SD = (float*)(p.ws + WS_SIDE); bf16_t* RET = (bf16_t*)(p.ws + WS_RET); LAS float* sred = (LAS float*)lds;

    for (int rep_ = 0; rep_ < REP_PRO; ++rep_) {
        LAS float* tile = (LAS float*)lds;
        conv_weight(even_w_in, even_mix_norm, WB + W_EIN, 1024, EVEN_IN, EVEN_IN, 0, tile);
        conv_weight(even_w_out, nullptr, WB + W_EOUT, 1024, 1024, 1024, 0, tile);
        conv_weight(odd_w_in, odd_mix_norm, WB + W_OIN, 1024, ODD_IN, ODD_IN, 1, tile);
        conv_weight(odd_w_out, nullptr, WB + W_OOUT, 1024, 1024, 1024, 0, tile);
        for (int l = 0; l < 2; ++l) {
            bf16_t* wl = WB + W_L0 + (size_t)l * WL_SIZE;
            conv_weight(xattn_wq + (size_t)l * 1024 * 1024, xattn_norm + l * 1024, wl + WL_Q, 1024, 1024, 1024, 2, tile);
            conv_weight(xattn_wkv + (size_t)l * 1024 * 2048, nullptr, wl + WL_KV, 1024, 2048, 2048, 0, tile);
            conv_weight(xattn_wo + (size_t)l * 1024 * 1024, nullptr, wl + WL_O, 1024, 1024, 1024, 0, tile);
            conv_weight(ffn_w_gate_up + (size_t)l * 1024 * GU, ffn_norm + l * 1024, wl + WL_GU, 1024, GU, GU, 3, tile);
            conv_weight(ffn_w_down + (size_t)l * DFF * 1024, nullptr, wl + WL_DN, DFF, 1024, 1024, 0, tile);
        }
        PHASE_IDS();
        for (int row0 = gw * 4; row0 < T; row0 += nw * 4) {
            float4 v[4][4];
#pragma unroll
            for (int rr = 0; rr < 4; ++rr)
#pragma unroll
                for (int i = 0; i < 4; ++i) v[rr][i] = ((const float4*)(x + (size_t)(row0 + rr) * 1024))[lane + 64 * i];
#pragma unroll
            for (int rr = 0; rr < 4; ++rr) {
                float s = 0.f;
#pragma unroll
                for (int i = 0; i < 4; ++i) {
                    const float4 q = v[rr][i];
                    s += (q.x * q.x + q.y * q.y) + (q.z * q.z + q.w * q.w);
                    uint2 w; w.x = cvt_pk_bf16(q.x, q.y); w.y = cvt_pk_bf16(q.z, q.w);
                    *(uint2*)(HB + (size_t)(row0 + rr) * 1024 + 4 * (lane + 64 * i)) = w;
                }
                s = wave_sum(s);
                if (lane < 4) SS[(size_t)(row0 + rr) * 16 + lane] = (lane == 0) ? s : 0.f;
            }
        }
        {
            float4 gn[2][4];
#pragma unroll
            for (int l = 0; l < 2; ++l)
#pragma unroll
                for (int i = 0; i < 4; ++i) gn[l][i] = *(const float4*)(mem_norm + l * 1024 + 4 * (lane + 64 * i));
            for (int row0 = gw * 2; row0 < MROWS; row0 += nw * 2) {
                float4 v[2][4];
#pragma unroll
                for (int rr = 0; rr < 2; ++rr)
#pragma unroll
                    for (int i = 0; i < 4; ++i) v[rr][i] = ((const float4*)(mem + (size_t)(row0 + rr) * 1024))[lane + 64 * i];
#pragma unroll
                for (int rr = 0; rr < 2; ++rr) {
                    float sq = 0.f;
#pragma unroll
                    for (int i = 0; i < 4; ++i) sq += (v[rr][i].x * v[rr][i].x + v[rr][i].y * v[rr][i].y) + (v[rr][i].z * v[rr][i].z + v[rr][i].w * v[rr][i].w);
                    sq = wave_sum(sq);
                    const float rs = rsqrtf(sq * (1.0f / 1024.0f) + 1e-6f);
#pragma unroll
                    for (int l = 0; l < 2; ++l)
#pragma unroll
                        for (int i = 0; i < 4; ++i) {
                            const float4 g = gn[l][i];
                            uint2 w; w.x = cvt_pk_bf16(v[rr][i].x * rs * g.x, v[rr][i].y * rs * g.y); w.y = cvt_pk_bf16(v[rr][i].z * rs * g.z, v[rr][i].w * rs * g.w);
                            *(uint2*)(MEMN + (size_t)l * MROWS * 1024 + (size_t)(row0 + rr) * 1024 + 4 * (lane + 64 * i)) = w;
                        }
                }
            }
        }
        for (int i = gt; i < 32 * 1024; i += nt) { const int b = i >> 10, k = i & 1023; SD[SD_H + k * 32 + b] = x[(size_t)b * 2048 * 1024 + k]; }
        {
            bf16_t* WSBw = (bf16_t*)(p.ws + WS_TAB + TABB_WSB); bf16_t* PWTw = (bf16_t*)(p.ws + WS_TAB + TABB_PWT);
            for (int i = gt; i < 4 * 128 * 128; i += nt) {
                const int g = i >> 14, a = (i >> 7) & 127, c = i & 127;
                WSBw[i] = f2bf(c <= a ? sgu_w[i] : 0.f);
                PWTw[i] = f2bf(pool_w[(size_t)g * 16384 + c * 128 + a] * pool_scale[g * 128 + a]);
            }
        }
        for (int i = gt; i < 2048 * 8; i += nt) { float s, c; sincos_d((double)(i >> 3) * p.inv_dil[i & 7], s, c); TAB[TAB_DC + i] = c; TAB[TAB_DS + i] = s; }
        for (int i = gt; i < 2048 * 64; i += nt) { float s, c; sincos_d((double)(i >> 6) * p.inv_ret[i & 63], s, c); TAB[TAB_RC + i] = c; TAB[TAB_RS + i] = s; }
    }
    grid.sync();

    {
        side_rstd(SD + SD_H, 1024, 1.0f / 1024.0f, sred);
        InPlain in{SD + SD_H, even_mix_norm}; EpStore ep{SD + SD_Z, sred + SRED_RSTD, 1.0f, 1};
        side_gemv(even_w_in + 512, EVEN_IN, 1024, 1024, in, ep, sred);
    }
    for (int g4 = 0; g4 < 4; ++g4) {
        const int l = g4 >> 1, isv = g4 & 1;
        const bf16_t* mn = MEMN + (size_t)l * MROWS * 1024; const bf16_t* wk = WB + W_L0 + (size_t)l * WL_SIZE + WL_KV;
        Epi<EP_PLAIN> E{KV + (size_t)l * MROWS * 2048 + (size_t)isv * MROWS * 1024, isv ? MROWS : 1024, nullptr, 0, nullptr, nullptr, nullptr};
        for (int rep_ = 0; rep_ < REP_GEMM; ++rep_) run_gemm<EP_PLAIN>(lds, isv ? wk + (size_t)1024 * 1024 : mn, isv ? mn : wk, isv ? 1024 : MROWS, isv ? MROWS : 1024, 1024, E, isv ? (int)(gridDim.x >> 1) : 0);
    }

    for (int layer = 0; layer < 2; ++layer) {
        const bf16_t* wl = WB + W_L0 + (size_t)layer * WL_SIZE;
        float* ss_base = SS + (size_t)(layer * 3 + 2) * SS_STRIDE;
        const float* ss_prev = (layer == 0) ? SS : SS + (size_t)4 * SS_STRIDE;
        const int ns_prev = (layer == 0) ? 4 : 16;
        if (layer == 0) {
            { Epi<EP_EVEN_IN> E{Z, EVEN_IN, ss_prev, ns_prev, nullptr, nullptr, SS + SS_STRIDE};
              for (int rep_ = 0; rep_ < REP_GEMM; ++rep_) run_gemm<EP_EVEN_IN>(lds, HB, WB + W_EIN, T, EVEN_IN, 1024, E); }
            GSYNC();
            {
                side_rstd(SD + SD_Z + 512 * 32, 512, 1.0f / 512.0f, sred);
                InSgu in{SD + SD_Z, sgu_w, sgu_b, sgu_norm, sred + SRED_RSTD};
                side_gemv_ks(even_w_out + (size_t)512 * 1024, 1024, 512, 1024, in, SD + SD_H, sred);
            }
            for (int rep_ = 0; rep_ < REP_EM; ++rep_) even_mix_units(lds, Z, SS + SS_STRIDE, (const bf16_t*)(p.ws + WS_TAB + TABB_WSB), (const bf16_t*)(p.ws + WS_TAB + TABB_PWT), sgu_norm, sgu_b, Y);
            GSYNC();
        } else {
            {
                side_rstd(SD + SD_H, 1024, 1.0f / 1024.0f, sred);
                InPlain in{SD + SD_H, ffn_norm}; EpStore ep{SD + SD_Z, sred + SRED_RSTD, 1.0f, 0};
                side_gemv(ffn_w_gate_up, GU, 1024, GU, in, ep, sred);
            }
            { Epi<EP_ODD_IN> E{Z, ODD_IN, ss_prev, ns_prev, nullptr, nullptr, nullptr};
              for (int rep_ = 0; rep_ < REP_GEMM; ++rep_) run_gemm<EP_ODD_IN>(lds, HB, WB + W_OIN, T, ODD_IN, 1024, E); }
            GSYNC();
            {
                InSwiglu in{SD + SD_Z};
                side_gemv_ks(ffn_w_down, 1024, DFF, 1024, in, SD + SD_H, sred);
            }
            for (int rep_ = 0; rep_ < REP_R1; ++rep_) ret_r1(lds, Z, TAB, RET);
            for (int rep_ = 0; rep_ < REP_DIL; ++rep_) dil_units(lds, Z, TAB, (bf16_t*)H, Y, SS + (size_t)6 * SS_STRIDE);
            GSYNC();
            {
                side_rstd(SD + SD_H, 1024, 1.0f / 1024.0f, sred);
                InPlain in{SD + SD_H, odd_mix_norm}; EpStore ep{SD + SD_Z, sred + SRED_RSTD, 1.0f, 0};
                side_gemv(odd_w_in + 1536, ODD_IN, 1024, 1024, in, ep, sred);
            }
            dil_combine((const bf16_t*)H, Y, SS + (size_t)6 * SS_STRIDE);
            ret_r2(RET);
            GSYNC();
            for (int rep_ = 0; rep_ < REP_R3; ++rep_) ret_r3(lds, Z, TAB, RET, SD + SD_Z, Y);
            GSYNC();
        }

        for (int sub = 0; sub < 3; ++sub) {
            const bf16_t* A = Y; const bf16_t* Bt = (layer == 0) ? (WB + W_EOUT) : (WB + W_OOUT); int K = 1024;
            if (sub == 1) {
                if (layer == 0) {
                PHASE_IDS();
                for (int item = gw; item < 4096; item += nw) {
                    const int i = item >> 2, h = item & 3;
                    const float4 w = *(const float4*)(xattn_wkv + (size_t)i * 2048 + h * 256 + lane * 4);
                    const float* qb = SD + SD_Q + (size_t)(h * 256 + lane * 4) * 32;
                    float mine = 0.f;
#pragma unroll
                    for (int b4 = 0; b4 < 8; ++b4) {
                        const float4 q0 = *(const float4*)(qb + b4 * 4), q1 = *(const float4*)(qb + 32 + b4 * 4), q2 = *(const float4*)(qb + 64 + b4 * 4), q3 = *(const float4*)(qb + 96 + b4 * 4);
                        const float s0 = wave_sum((w.x * q0.x + w.y * q1.x) + (w.z * q2.x + w.w * q3.x)), s1 = wave_sum((w.x * q0.y + w.y * q1.y) + (w.z * q2.y + w.w * q3.y));
                        const float s2 = wave_sum((w.x * q0.z + w.y * q1.z) + (w.z * q2.z + w.w * q3.z)), s3 = wave_sum((w.x * q0.w + w.y * q1.w) + (w.z * q2.w + w.w * q3.w));
                        if (lane == b4 * 4 + 0) mine = s0; if (lane == b4 * 4 + 1) mine = s1; if (lane == b4 * 4 + 2) mine = s2; if (lane == b4 * 4 + 3) mine = s3;
                    }
                    if (lane < 32) SD[SD_R + (size_t)(lane * 4 + h) * 1024 + i] = mine;
                }
            }
                { Epi<EP_SCALE> E{Y, 1024, ss_base, 16, nullptr, nullptr, nullptr};
                  for (int rep_ = 0; rep_ < REP_GEMM; ++rep_) run_gemm<EP_SCALE>(lds, HB, wl + WL_Q, T, 1024, 1024, E); }
                GSYNC();
                if (layer == 0) {
                    PHASE_IDS();
                    for (int item = gw; item < 8192; item += nw) {
                        const int b = item >> 8;
                        const float4* mr = (const float4*)(mem + (size_t)item * 1024);
                        float ssq = 0.f, a0 = 0.f, a1 = 0.f, a2 = 0.f, a3 = 0.f;
#pragma unroll
                        for (int q = 0; q < 4; ++q) {
                            const int idx = lane + 64 * q;
                            const float4 m = mr[idx], g = ((const float4*)mem_norm)[idx];
                            ssq += (m.x * m.x + m.y * m.y) + (m.z * m.z + m.w * m.w);
                            const float4 mg = make_float4(m.x * g.x, m.y * g.y, m.z * g.z, m.w * g.w);
                            const float4 r0 = ((const float4*)(SD + SD_R + (size_t)(b * 4 + 0) * 1024))[idx], r1 = ((const float4*)(SD + SD_R + (size_t)(b * 4 + 1) * 1024))[idx];
                            const float4 r2 = ((const float4*)(SD + SD_R + (size_t)(b * 4 + 2) * 1024))[idx], r3 = ((const float4*)(SD + SD_R + (size_t)(b * 4 + 3) * 1024))[idx];
                            a0 += (mg.x * r0.x + mg.y * r0.y) + (mg.z * r0.z + mg.w * r0.w); a1 += (mg.x * r1.x + mg.y * r1.y) + (mg.z * r1.z + mg.w * r1.w);
                            a2 += (mg.x * r2.x + mg.y * r2.y) + (mg.z * r2.z + mg.w * r2.w); a3 += (mg.x * r3.x + mg.y * r3.y) + (mg.z * r3.z + mg.w * r3.w);
                        }
                        ssq = wave_sum(ssq); a0 = wave_sum(a0); a1 = wave_sum(a1); a2 = wave_sum(a2); a3 = wave_sum(a3);
                        const float rs = rsqrtf(ssq * (1.0f / 1024.0f) + 1e-6f);
                        if (lane == 0) { const int j = item & 255; float* pp = SD + SD_P + (size_t)b * 4 * 256 + j; pp[0] = a0 * rs; pp[256] = a1 * rs; pp[512] = a2 * rs; pp[768] = a3 * rs; SD[SD_M + item] = rs; }
                    }
                }
                xattn_phase(lds, Y, KV + (size_t)layer * MROWS * 2048, KV + (size_t)layer * MROWS * 2048 + (size_t)MROWS * 1024);
                GSYNC();
                Bt = wl + WL_O;
            } else if (sub == 2) {
                if (layer == 0) {
                InHead in{SD + SD_T}; EpStore ep{SD + SD_O, nullptr, 1.0f, 0};
                side_gemv(xattn_wkv + 1024, 2048, 1024, 1024, in, ep, sred);
            }
                { Epi<EP_GU> E{Z, DFF, ss_base + SS_STRIDE, 16, nullptr, nullptr, nullptr};
                  for (int rep_ = 0; rep_ < REP_GEMM; ++rep_) run_gemm<EP_GU>(lds, HB, wl + WL_GU, T, GU, 1024, E); }
                GSYNC();
                A = Z; Bt = wl + WL_DN; K = DFF;
            }
            if (layer == 0 && sub == 0) {
                side_rstd(SD + SD_H, 1024, 1.0f / 1024.0f, sred);
                InPlain in{SD + SD_H, xattn_norm}; EpStore ep{SD + SD_Q, sred + SRED_RSTD, 0.0625f, 0};
                side_gemv(xattn_wq, 1024, 1024, 1024, in, ep, sred);
            }
            if (layer == 0 && sub == 1) {
                    PHASE_IDS();
                    LAS float* pl = sred; LAS float* prt = sred + 1024;
                    for (int item = blockIdx.x; item < 256; item += gridDim.x) {
                        const int b = item >> 3, il = tid & 127, i = (item & 7) * 128 + il, jg = tid >> 7;
                        if (wave < 4) {
                            const float* sp = SD + SD_P + (size_t)(b * 4 + wave) * 256;
                            float e0 = sp[lane], e1 = sp[lane + 64], e2 = sp[lane + 128], e3 = sp[lane + 192];
                            const float mx = wave_max(fmaxf(fmaxf(e0, e1), fmaxf(e2, e3)));
                            e0 = __expf(e0 - mx); e1 = __expf(e1 - mx); e2 = __expf(e2 - mx); e3 = __expf(e3 - mx);
                            const float inv = 1.0f / wave_sum((e0 + e1) + (e2 + e3));
                            const float* rm = SD + SD_M + b * 256;
                            pl[wave * 256 + lane] = e0 * inv * rm[lane]; pl[wave * 256 + lane + 64] = e1 * inv * rm[lane + 64];
                            pl[wave * 256 + lane + 128] = e2 * inv * rm[lane + 128]; pl[wave * 256 + lane + 192] = e3 * inv * rm[lane + 192];
                        }
                        __syncthreads();
                        float t0 = 0.f, t1 = 0.f, t2 = 0.f, t3 = 0.f;
                        const float* mc = mem + (size_t)b * 256 * 1024 + (size_t)(jg * 64) * 1024 + i;
#pragma unroll 16
                        for (int j = 0; j < 64; ++j) { const float m = mc[(size_t)j * 1024]; const int jj = jg * 64 + j; t0 += pl[jj] * m; t1 += pl[256 + jj] * m; t2 += pl[512 + jj] * m; t3 += pl[768 + jj] * m; }
                        prt[(jg * 4 + 0) * 128 + il] = t0; prt[(jg * 4 + 1) * 128 + il] = t1; prt[(jg * 4 + 2) * 128 + il] = t2; prt[(jg * 4 + 3) * 128 + il] = t3;
                        __syncthreads();
                        {
                            const int hh = tid >> 7;
                            const float tsum = (prt[(0 * 4 + hh) * 128 + il] + prt[(1 * 4 + hh) * 128 + il]) + (prt[(2 * 4 + hh) * 128 + il] + prt[(3 * 4 + hh) * 128 + il]);
                            SD[SD_T + ((size_t)hh * 1024 + i) * 32 + b] = tsum * mem_norm[i];
                        }
                        __syncthreads();
                    }
                }
            if (layer == 0 && sub == 2) {
                    InPlain in{SD + SD_O, nullptr};
                    side_gemv_ks(xattn_wo, 1024, 1024, 1024, in, SD + SD_H, sred);
                }
            { Epi<EP_RES> E{HB, 1024, nullptr, 0, HB, nullptr, ss_base + (size_t)sub * SS_STRIDE};
              run_gemm<EP_RES>(lds, A, Bt, T, 1024, K, E); }
            GSYNC();
        }
    }

    {
        const float* ssf = SS + (size_t)7 * SS_STRIDE;
        PHASE_IDS();
        for (int row = gw; row < T; row += nw) {
            const float sp = (lane < 16) ? ssf[(size_t)row * 16 + lane] : 0.f;
            const float rs = rsqrtf(wave_sum(sp) * (1.0f / 1024.0f) + 1e-6f);
            float4* hr = (float4*)(H + (size_t)row * 1024);
            const uint2* hb = (const uint2*)(HB + (size_t)row * 1024);
#pragma unroll
            for (int i = 0; i < 4; ++i) {
                const uint2 q = hb[lane + 64 * i];
                const float4 g = ((const float4*)final_norm)[lane + 64 * i];
                float4 v; v.x = bflo(q.x) * rs * g.x; v.y = bfhi(q.x) * rs * g.y; v.z = bflo(q.y) * rs * g.z; v.w = bfhi(q.y) * rs * g.w;
                hr[lane + 64 * i] = v;
            }
        }
    }
}

extern "C" void kernel_launch(void* const* d_in, const int* in_sizes, int n_in, void* d_out, int out_size, void* d_ws, size_t ws_size, hipStream_t stream) {
    static int grid_blocks = 0;
    if (grid_blocks == 0) {
        if (n_in != 22 || out_size != T * DM || ws_size < WS_END) { fprintf(stderr, "kernel_launch: unexpected shapes (n_in %d, out %d, ws %zu)\n", n_in, out_size, ws_size); grid_blocks = -1; return; }
        int dev = 0, cus = 0, per_cu = 0;
        hipGetDevice(&dev);
        hipDeviceGetAttribute(&cus, hipDeviceAttributeMultiprocessorCount, dev);
        hipOccupancyMaxActiveBlocksPerMultiprocessor(&per_cu, fwd_mega, 512, 0);
        if (per_cu < 1) per_cu = 1;
        if (per_cu > 1) per_cu = 1;
        grid_blocks = cus * per_cu;
    }
    if (grid_blocks < 0) return;
    Params p;
    memset(&p, 0, sizeof(p));
    for (int i = 0; i < 22; ++i) p.in[i] = (const float*)d_in[i];
    p.out = (float*)d_out; p.ws = (unsigned char*)d_ws;
    for (int i = 0; i < 8; ++i) p.inv_dil[i] = std::exp(-((double)i / 8.0) * std::log(500000.0));
    for (int i = 0; i < 64; ++i) p.inv_ret[i] = std::exp(-((double)i / 64.0) * std::log(10000.0));
    (void)hipMemsetAsync((char*)d_ws + WS_BAR, 0, XCD_BAR_WORDS * 4, stream);
    void* args[] = {&p};
    hipError_t e = hipLaunchCooperativeKernel((void*)fwd_mega, dim3(grid_blocks), dim3(512), args, 0, stream);
    if (e != hipSuccess) fprintf(stderr, "cooperative launch failed: %s (grid %d)\n", hipGetErrorString(e), grid_blocks);
}
```
